# Optimizing an MI355X kernel written in HIP

```python
import jax
import jax.numpy as jnp
from jax import lax
import numpy as np

D_MODEL = 1024
BATCH = 8
SEQ = 4096
DEPTH = 2

HEAD_DIM = 64
EPS = 1e-6
MLA_HEADS = 8
MLA_NOPE = 64
MLA_ROPE = 32
MLA_V = 64
Q_LORA = 384
KV_LORA = 256
ROPE_THETA = 10000.0
Q_BLOCK = 128
DIL_HEADS = 8
DIL_PATTERNS = ((128, 1), (512, 4), (2048, 16))
DIL_BLOCK = max(w // d for (w, d) in DIL_PATTERNS)
MOBA_HEADS = 16
MOBA_BLOCK = 256
MOBA_TOPK = 3
MOBA_QCHUNK = 16
D_FF = 4 * D_MODEL
PLE_DIM = 256
N_EVEN = (DEPTH + 1) // 2
N_ODD = DEPTH // 2
EVEN_IN = Q_LORA + KV_LORA + MLA_ROPE + 3 * DIL_HEADS * HEAD_DIM
EVEN_MIX = MLA_HEADS * MLA_V + DIL_HEADS * HEAD_DIM
ODD_MIX = MOBA_HEADS * HEAD_DIM

kernel_name = 'hybrid_mla_dilated_moba_trunk'


def rms_norm(x, g):
    xf = x.astype(jnp.float32)
    y = xf * lax.rsqrt(jnp.mean(xf * xf, axis=-1, keepdims=True) + EPS)
    return (y * g.astype(jnp.float32)).astype(x.dtype)


def alibi_slopes(n):
    return 2.0 ** (-8.0 * jnp.arange(1, n + 1, dtype=jnp.float32) / n)


def apply_rope(x, positions):
    half = x.shape[-1] // 2
    inv_freq = ROPE_THETA ** (-jnp.arange(half, dtype=jnp.float32) / half)
    ang = positions.astype(jnp.float32)[..., None] * inv_freq
    ang = ang.reshape(ang.shape[:2] + (1,) * (x.ndim - 3) + (half,))
    cos, sin = jnp.cos(ang), jnp.sin(ang)
    xf = x.astype(jnp.float32)
    x1, x2 = xf[..., :half], xf[..., half:]
    return jnp.concatenate([x1 * cos - x2 * sin, x1 * sin + x2 * cos], axis=-1).astype(x.dtype)


def causal_attention_blocks(q, k, v, scale):
    B, S, H, Dk = q.shape
    nq = S // Q_BLOCK
    qb = q.reshape(B, nq, Q_BLOCK, H, Dk).swapaxes(0, 1)
    kpos = jnp.arange(S)

    def one(args):
        qi, i = args
        s = jnp.einsum('bqhd,bkhd->bhqk', qi, k, preferred_element_type=jnp.float32) * scale
        qpos = i * Q_BLOCK + jnp.arange(Q_BLOCK)
        s = jnp.where(kpos[None, :] <= qpos[:, None], s, -jnp.inf)
        pr = jax.nn.softmax(s, axis=-1).astype(v.dtype)
        return jnp.einsum('bhqk,bkhd->bqhd', pr, v)

    out = lax.map(one, (qb, jnp.arange(nq)))
    return out.swapaxes(0, 1).reshape(B, S, H, v.shape[-1])


def dilated_branch(q, k, v, slopes, scale, window, dil):
    B, S, H, Dh = q.shape
    L = S // dil
    nb = -(-L // DIL_BLOCK)
    Lp = nb * DIL_BLOCK
    reach = window // dil

    def to_class(a):
        a = a.reshape(B, L, dil, H, Dh).transpose(0, 2, 1, 3, 4)
        a = jnp.pad(a, ((0, 0), (0, 0), (0, Lp - L), (0, 0), (0, 0)))
        return a.reshape(B, dil, nb, DIL_BLOCK, H, Dh)

    def with_prev(a):
        prev = jnp.pad(a, ((0, 0), (0, 0), (1, 0), (0, 0), (0, 0), (0, 0)))[:, :, :nb]
        return jnp.concatenate([prev, a], axis=3)

    qc = to_class(q)
    kk = with_prev(to_class(k))
    vv = with_prev(to_class(v))
    s = jnp.einsum('bgnqhd,bgnkhd->bghnqk', qc, kk, preferred_element_type=jnp.float32) * scale
    qi = jnp.arange(DIL_BLOCK)[:, None]
    ki = jnp.arange(2 * DIL_BLOCK)[None, :]
    step = DIL_BLOCK + qi - ki
    key_idx = jnp.arange(nb)[:, None, None] * DIL_BLOCK - DIL_BLOCK + ki[None]
    mask = (step >= 0) & (step <= reach) & (key_idx >= 0)
    bias = slopes[:, None, None, None] * (step * dil).astype(jnp.float32)
    s = jnp.where(mask, s - bias, -jnp.inf)
    m = jnp.max(s, axis=-1, keepdims=True)
    e = jnp.exp(s - m)
    den = jnp.sum(e, axis=-1, keepdims=True)
    o = jnp.einsum('bghnqk,bgnkhd->bgnqhd', (e / den).astype(v.dtype), vv)
    lse = (m + jnp.log(den))[..., 0]
    o = o.reshape(B, dil, Lp, H, Dh)[:, :, :L].transpose(0, 2, 1, 3, 4).reshape(B, S, H, Dh)
    lse = lse.reshape(B, dil, H, Lp)[..., :L].transpose(0, 3, 1, 2).reshape(B, S, H)
    return o, lse


def dilated_attention(q, k, v, slopes, scale):
    outs, lses = [], []
    for (w, d) in DIL_PATTERNS:
        o, l = dilated_branch(q, k, v, slopes, scale, w, d)
        outs.append(o)
        lses.append(l)
    wts = jax.nn.softmax(jnp.stack(lses, axis=0), axis=0)
    out = jnp.einsum('pbsh,pbshd->bshd', wts, jnp.stack(outs, axis=0).astype(jnp.float32))
    return out.astype(q.dtype)


def moba_attention(q, k, v, slopes, scale):
    B, S, H, Dh = q.shape
    nb = -(-S // MOBA_BLOCK)
    Sp = nb * MOBA_BLOCK

    def to_blocks(a):
        a = jnp.pad(a, ((0, 0), (0, Sp - S), (0, 0), (0, 0)))
        return a.reshape(B, nb, MOBA_BLOCK, H, Dh).transpose(0, 3, 1, 2, 4)

    kb, vb = to_blocks(k), to_blocks(v)
    k_mean = jnp.mean(kb.astype(jnp.float32), axis=3)
    t = jnp.arange(S)
    own = t // MOBA_BLOCK
    gate = jnp.einsum('bshd,bhnd->bshn', q.astype(jnp.float32), k_mean)
    fully_past = jnp.arange(nb)[None, :] < own[:, None]
    gate = jnp.where(fully_past[None, :, None, :], gate, -jnp.inf)
    n_sel = min(MOBA_TOPK, nb)
    _, sel = lax.top_k(gate, n_sel)
    sel_ok = sel < own[None, :, None, None]
    nc = S // MOBA_QCHUNK

    def chunk(a):
        return a.reshape((B, nc, MOBA_QCHUNK) + a.shape[2:]).swapaxes(0, 1)

    b_ix = jnp.arange(B)[:, None, None, None]
    h_ix = jnp.arange(H)[None, None, :, None]
    k_in = jnp.arange(MOBA_BLOCK)
    n_sel_keys = n_sel * MOBA_BLOCK

    def one(args):
        qi, si, oki, ti = args
        ob = ti[0] // MOBA_BLOCK
        k_own = lax.dynamic_index_in_dim(kb, ob, axis=2, keepdims=False)
        v_own = lax.dynamic_index_in_dim(vb, ob, axis=2, keepdims=False)
        k_sel = kb[b_ix, h_ix, si]
        v_sel = vb[b_ix, h_ix, si]
        s_sel = jnp.einsum('bqhd,bqhjkd->bqhjk', qi, k_sel, preferred_element_type=jnp.float32) * scale
        s_own = jnp.einsum('bqhd,bhkd->bqhk', qi, k_own, preferred_element_type=jnp.float32) * scale
        d_sel = (ti[None, :, None, None, None] - (si[..., None] * MOBA_BLOCK + k_in)).astype(jnp.float32)
        s_sel = jnp.where(oki[..., None], s_sel - slopes[:, None, None] * d_sel, -jnp.inf)
        d_own = ti[:, None] - (ob * MOBA_BLOCK + k_in)[None, :]
        s_own = jnp.where((d_own >= 0)[None, :, None, :],
                          s_own - slopes[None, None, :, None] * d_own.astype(jnp.float32)[None, :, None, :],
                          -jnp.inf)
        s_all = jnp.concatenate([s_sel.reshape(s_sel.shape[:3] + (n_sel_keys,)), s_own], axis=-1)
        probs = jax.nn.softmax(s_all, axis=-1).astype(v.dtype)
        p_sel = probs[..., :n_sel_keys].reshape(s_sel.shape)
        p_own = probs[..., n_sel_keys:]
        return (jnp.einsum('bqhjk,bqhjkd->bqhd', p_sel, v_sel)
                + jnp.einsum('bqhk,bhkd->bqhd', p_own, v_own))

    out = lax.map(one, (chunk(q), chunk(sel), chunk(sel_ok), t.reshape(nc, MOBA_QCHUNK)))
    return out.swapaxes(0, 1).reshape(B, S, H, Dh)


def even_mixer(hn, positions, w_in, cq_norm, ckv_norm, w_uq, w_ukv, qn_nope, qn_rope,
               kn_nope, kn_rope, dil_qn, dil_kn, w_out):
    B, S, _ = hn.shape
    z = hn @ w_in
    o1 = Q_LORA
    o2 = o1 + KV_LORA
    o3 = o2 + MLA_ROPE
    dw = DIL_HEADS * HEAD_DIM
    c_q = rms_norm(z[..., :o1], cq_norm)
    c_kv = rms_norm(z[..., o1:o2], ckv_norm)
    q = (c_q @ w_uq).reshape(B, S, MLA_HEADS, MLA_NOPE + MLA_ROPE)
    q_nope = rms_norm(q[..., :MLA_NOPE], qn_nope)
    q_rope = apply_rope(rms_norm(q[..., MLA_NOPE:], qn_rope), positions)
    kv = (c_kv @ w_ukv).reshape(B, S, MLA_HEADS, MLA_NOPE + MLA_V)
    k_nope = rms_norm(kv[..., :MLA_NOPE], kn_nope)
    v_a = kv[..., MLA_NOPE:]
    k_rope = apply_rope(rms_norm(z[..., o2:o3], kn_rope), positions)
    k_rope = jnp.broadcast_to(k_rope[:, :, None, :], (B, S, MLA_HEADS, MLA_ROPE))
    q_a = jnp.concatenate([q_nope, q_rope], axis=-1)
    k_a = jnp.concatenate([k_nope, k_rope], axis=-1)
    out_a = causal_attention_blocks(q_a, k_a, v_a, (MLA_NOPE + MLA_ROPE) ** -0.5)
    q_b = rms_norm(z[..., o3:o3 + dw].reshape(B, S, DIL_HEADS, HEAD_DIM), dil_qn)
    k_b = rms_norm(z[..., o3 + dw:o3 + 2 * dw].reshape(B, S, DIL_HEADS, HEAD_DIM), dil_kn)
    v_b = z[..., o3 + 2 * dw:o3 + 3 * dw].reshape(B, S, DIL_HEADS, HEAD_DIM)
    out_b = dilated_attention(q_b, k_b, v_b, alibi_slopes(DIL_HEADS), HEAD_DIM ** -0.5)
    mixed = jnp.concatenate([out_a.reshape(B, S, MLA_HEADS * MLA_V),
                             out_b.reshape(B, S, dw)], axis=-1)
    return mixed @ w_out


def odd_mixer(hn, w_in, qn, kn, w_out):
    B, S, _ = hn.shape
    z = (hn @ w_in).reshape(B, S, 3, MOBA_HEADS, HEAD_DIM)
    q = rms_norm(z[:, :, 0], qn)
    k = rms_norm(z[:, :, 1], kn)
    v = z[:, :, 2]
    o = moba_attention(q, k, v, alibi_slopes(MOBA_HEADS), HEAD_DIM ** -0.5)
    return o.reshape(B, S, ODD_MIX) @ w_out


def setup_inputs(seed: int = 0) -> dict:
    key = jax.random.key(seed)
    ks = iter(jax.random.split(key, 32))

    def w(shape, fan_in):
        return jax.random.normal(next(ks), shape, jnp.float32) * (fan_in ** -0.5)

    def gain(shape):
        return 1.0 + 0.05 * jax.random.normal(next(ks), shape, jnp.float32)

    x = jax.random.normal(next(ks), (BATCH, SEQ, D_MODEL), jnp.float32)
    p = jax.random.normal(next(ks), (DEPTH, BATCH, SEQ, PLE_DIM), jnp.float32)
    positions = jnp.broadcast_to(jnp.arange(SEQ, dtype=jnp.int32), (BATCH, SEQ))
    return {
        'x': x,
        'p': p,
        'positions': positions,
        'e_w_in': w((N_EVEN, D_MODEL, EVEN_IN), D_MODEL),
        'e_cq_norm': gain((N_EVEN, Q_LORA)),
        'e_ckv_norm': gain((N_EVEN, KV_LORA)),
        'e_w_uq': w((N_EVEN, Q_LORA, MLA_HEADS * (MLA_NOPE + MLA_ROPE)), Q_LORA),
        'e_w_ukv': w((N_EVEN, KV_LORA, MLA_HEADS * (MLA_NOPE + MLA_V)), KV_LORA),
        'e_qn_nope': gain((N_EVEN, MLA_NOPE)),
        'e_qn_rope': gain((N_EVEN, MLA_ROPE)),
        'e_kn_nope': gain((N_EVEN, MLA_NOPE)),
        'e_kn_rope': gain((N_EVEN, MLA_ROPE)),
        'e_dil_qn': gain((N_EVEN, HEAD_DIM)),
        'e_dil_kn': gain((N_EVEN, HEAD_DIM)),
        'e_w_out': w((N_EVEN, EVEN_MIX, D_MODEL), EVEN_MIX),
        'o_w_in': w((N_ODD, D_MODEL, 3 * ODD_MIX), D_MODEL),
        'o_qn': gain((N_ODD, HEAD_DIM)),
        'o_kn': gain((N_ODD, HEAD_DIM)),
        'o_w_out': w((N_ODD, ODD_MIX, D_MODEL), ODD_MIX),
        'mix_norm': gain((DEPTH, D_MODEL)),
        'ff_norm': gain((DEPTH, D_MODEL)),
        'w_ff1': w((DEPTH, D_MODEL, D_FF), D_MODEL),
        'w_ff2': w((DEPTH, D_FF, D_MODEL), D_FF),
        'ple_norm': gain((DEPTH, D_MODEL)),
        'w_ple_gate': w((DEPTH, D_MODEL, D_MODEL), D_MODEL),
        'w_ple_proj': w((DEPTH, PLE_DIM, D_MODEL), PLE_DIM),
    }


def reference(x, p, positions, e_w_in, e_cq_norm, e_ckv_norm, e_w_uq, e_w_ukv, e_qn_nope,
              e_qn_rope, e_kn_nope, e_kn_rope, e_dil_qn, e_dil_kn, e_w_out, o_w_in, o_qn,
              o_kn, o_w_out, mix_norm, ff_norm, w_ff1, w_ff2, ple_norm, w_ple_gate, w_ple_proj):
    h = x
    for i in range(DEPTH):
        j = i // 2
        hn = rms_norm(h, mix_norm[i])
        if i % 2 == 0:
            mix = even_mixer(hn, positions, e_w_in[j], e_cq_norm[j], e_ckv_norm[j], e_w_uq[j],
                             e_w_ukv[j], e_qn_nope[j], e_qn_rope[j], e_kn_nope[j], e_kn_rope[j],
                             e_dil_qn[j], e_dil_kn[j], e_w_out[j])
        else:
            mix = odd_mixer(hn, o_w_in[j], o_qn[j], o_kn[j], o_w_out[j])
        h = h + mix
        u = jax.nn.relu(rms_norm(h, ff_norm[i]) @ w_ff1[i])
        h = h + (u * u) @ w_ff2[i]
        g = jax.nn.sigmoid(rms_norm(h, ple_norm[i]) @ w_ple_gate[i])
        h = h + g * (p[i] @ w_ple_proj[i])
    return h
```

```cpp
#include <hip/hip_runtime.h>
#include <cstdio>
#include <cstdint>

#ifndef MK_ONE_LAUNCH
#define MK_ONE_LAUNCH 1
#endif
#ifndef USE_PG8
#define USE_PG8 1
#endif

#ifndef FAST_ATTN
#define FAST_ATTN 1
#endif

#ifndef PROBE_MASK
#define PROBE_MASK 0u
#endif

#ifndef ATT_PROBE
#define ATT_PROBE 0
#endif

#ifndef ATT_NOPRE
#define ATT_NOPRE 0
#endif

#ifndef GEMM_PROBE
#define GEMM_PROBE 0
#endif

#ifndef GEMM_SP2
#define GEMM_SP2 true
#endif

#ifndef DIL_STREAM
#define DIL_STREAM 1
#endif

#define LAS __attribute__((address_space(3)))
#define GAS __attribute__((address_space(1)))
#if USE_PG8
namespace pg8 {
#define PG8_LAS __attribute__((address_space(3)))
typedef unsigned short bf16_t;
typedef short bf16x8 __attribute__((ext_vector_type(8)));
typedef float f32x4 __attribute__((ext_vector_type(4)));
typedef unsigned u32x4 __attribute__((ext_vector_type(4)));
constexpr int BM = 256, BK = 64, HALF = 128, HTB = HALF * BK * 2  , STAGE_BYTES = 8 * HTB, NXCD = 8, WGM = 8;

__host__ __device__ __forceinline__ int lds_byte(int r, int c) { const int st = (r >> 4) * 2 + (c >> 5), rr = r & 15, cc = c & 31, ob = rr * 64 + cc * 2; return st * 1024 + (ob ^ (((ob >> 9) & 1) << 5)); }
__host__ __device__ __forceinline__ void stage_rc(int b, int& R, int& C) { const int st = b / 1024, sb = b % 1024, swz = sb ^ (((sb >> 9) & 1) << 5); R = (st >> 1) * 16 + swz / 64; C = (st & 1) * 32 + (swz % 64) / 2; }
__host__ __device__ __forceinline__ int perm32(int rho) { const int n = rho >> 4, i = rho & 15; return 8 * (i >> 2) + 4 * n + (i & 3); }

struct Unit { int pm, pn; };
struct Gemm { const bf16_t* A; const bf16_t* Bt; int M, N, K, lda; };

struct StaticOrder {
    int nM, nN, nwg, G, c;
    __host__ __device__ void init(int M, int N, int G_, int c_) { nM = M / BM; nN = N / BM; nwg = nM * nN; G = G_; c = c_; }
    __host__ __device__ bool next(int i, Unit& u) const {
        const long L = (long)i * G + c; if (L >= nwg) return false;
        int wgid = (int)L; { const int q = nwg / NXCD, r = nwg % NXCD, xcd = wgid % NXCD, off = wgid / NXCD; wgid = (xcd < r ? xcd * (q + 1) : r * (q + 1) + (xcd - r) * q) + off; }
        const int nig = WGM * nN, gid = wgid / nig, fm = gid * WGM, gsz = (nM - fm) < WGM ? (nM - fm) : WGM;
        u.pm = fm + ((wgid % nig) % gsz); u.pn = (wgid % nig) / gsz; return true;
    }
    __device__ __forceinline__ void a_ready(const Unit&) const {}
    __device__ __forceinline__ void done(const Unit&) const {}
};

template <class Epi, class Sched, bool ALIGN_EPI = false, bool SP2 = false>
__device__ __forceinline__ void gemm_phase(PG8_LAS unsigned char* lds, const Gemm g, const Sched& S, const Epi& E) {
    int tid_ = threadIdx.x; asm volatile("" : "+v"(tid_));
    const int tid = tid_, wid = __builtin_amdgcn_readfirstlane(tid >> 6), lane = tid & 63, wr = wid >> 2, wc = wid & 3, fr = lane & 15, fq = lane >> 4;
    const int K = g.K, nt = K / BK;
    unsigned voffA[2], voffB[2];
#pragma unroll
    for (int i = 0; i < 2; ++i) { int R, C; stage_rc(tid * 16 + i * 8192, R, C); const int Rb = Epi::PERM ? ((R & ~31) + perm32(R & 31)) : R;
        voffA[i] = (unsigned)(R * g.lda + C) * 2u; voffB[i] = (unsigned)(Rb * K + C) * 2u; }
    const size_t kstep = (size_t)(BK * 2);
    const size_t hstepA = (size_t)HALF * g.lda * 2, hstepB = (size_t)HALF * K * 2;
    const size_t tstepA = 2 * hstepA, tstepB = 2 * hstepB;
    const unsigned ldsw = (unsigned)wid * 1024u;
    const int aoff = lds_byte(wr * 64 + fr, fq * 8), boff = lds_byte(wc * 32 + fr, fq * 8);
#define PG8_SA(b, h) (((b) * 2 + (h)) * HTB)
#define PG8_SB(b, h) ((4 + (b) * 2 + (h)) * HTB)
#define PG8_STAGE(bufoff, gbase, voff) do { _Pragma("unroll") for (int _i = 0; _i < 2; ++_i) \
        __builtin_amdgcn_global_load_lds((const unsigned*)((const char*)(gbase) + (voff)[_i]), (PG8_LAS unsigned*)(lds + (bufoff) + ldsw + _i * 8192), 16, 0, 0); } while (0)
#define PG8_LDA(dst, b, h) do { _Pragma("unroll") for (int m = 0; m < 4; ++m) _Pragma("unroll") for (int k = 0; k < 2; ++k) dst[m][k] = *(const PG8_LAS bf16x8*)(lds + PG8_SA(b, h) + aoff + m * 2048 + k * 1024); } while (0)
#define PG8_LDB(dst, b, h) do { _Pragma("unroll") for (int n = 0; n < 2; ++n) _Pragma("unroll") for (int k = 0; k < 2; ++k) dst[n][k] = *(const PG8_LAS bf16x8*)(lds + PG8_SB(b, h) + boff + n * 2048 + k * 1024); } while (0)
#define PG8_MMA(ai, bj, At, Bt) do { __builtin_amdgcn_s_setprio(1); _Pragma("unroll") for (int m = 0; m < 4; ++m) _Pragma("unroll") for (int n = 0; n < 2; ++n) _Pragma("unroll") for (int k = 0; k < 2; ++k) \
        acc[ai][bj][m][n] = __builtin_amdgcn_mfma_f32_16x16x32_bf16(Bt[n][k], At[m][k], acc[ai][bj][m][n], 0, 0, 0); __builtin_amdgcn_s_setprio(0); } while (0)
#define PG8_WAIT_V(n) asm volatile("s_waitcnt vmcnt(" #n ")" ::: "memory")
#define PG8_WAIT_L(n) asm volatile("s_waitcnt lgkmcnt(" #n ")" ::: "memory")
#define PG8_BAR __builtin_amdgcn_s_barrier()
#define PG8_SCHED __builtin_amdgcn_sched_barrier(0)
    Unit cur, nxt; int ui = 0;
    if (!S.next(0, cur)) return;
    f32x4 acc[2][2][4][2];
#pragma unroll
    for (int a = 0; a < 2; ++a)
#pragma unroll
        for (int b = 0; b < 2; ++b)
#pragma unroll
            for (int m = 0; m < 4; ++m)
#pragma unroll
                for (int n = 0; n < 2; ++n) acc[a][b][m][n] = (f32x4){0.f, 0.f, 0.f, 0.f};
    bf16x8 At[4][2], B0[2][2], B1[2][2];
    const char* cA = (const char*)g.A + (size_t)cur.pm * tstepA; const char* cB = (const char*)g.Bt + (size_t)cur.pn * tstepB;
    S.a_ready(cur);
    if constexpr (SP2) {
        PG8_STAGE(PG8_SB(0, 0), cB, voffB); PG8_STAGE(PG8_SB(0, 1), cB + hstepB, voffB); PG8_STAGE(PG8_SA(0, 0), cA, voffA); PG8_STAGE(PG8_SA(0, 1), cA + hstepA, voffA);
        if (wr == 1) PG8_BAR;
        PG8_WAIT_V(2); PG8_BAR;
        PG8_STAGE(PG8_SB(1, 0), cB + kstep, voffB); PG8_STAGE(PG8_SA(1, 0), cA + kstep, voffA); PG8_STAGE(PG8_SB(1, 1), cB + hstepB + kstep, voffB);
        PG8_WAIT_V(6); PG8_BAR;
    } else {
        PG8_STAGE(PG8_SB(0, 0), cB, voffB); PG8_STAGE(PG8_SA(0, 0), cA, voffA); PG8_STAGE(PG8_SB(0, 1), cB + hstepB, voffB); PG8_STAGE(PG8_SA(0, 1), cA + hstepA, voffA);
        if (wr == 1) PG8_BAR;
        PG8_WAIT_V(4); PG8_BAR;
        PG8_STAGE(PG8_SB(1, 0), cB + kstep, voffB); PG8_STAGE(PG8_SA(1, 0), cA + kstep, voffA); PG8_STAGE(PG8_SB(1, 1), cB + hstepB + kstep, voffB);
        PG8_WAIT_V(6); PG8_BAR;
    }
    for (;;) {
        const bool has_next = S.next(ui + 1, nxt);
        const char* nA = has_next ? (const char*)g.A + (size_t)nxt.pm * tstepA : cA; const char* nB = has_next ? (const char*)g.Bt + (size_t)nxt.pn * tstepB : cB;
#pragma unroll 1
        for (int t = 0; t < nt; t += 2) {
            const bool last = (t == nt - 2);
            const char* a1 = cA + (size_t)(t + 1) * kstep;
            const char* a2 = last ? nA : cA + (size_t)(t + 2) * kstep; const char* b2 = last ? nB : cB + (size_t)(t + 2) * kstep;
            const char* a3 = a2 + kstep; const char* b3 = b2 + kstep;
            if (last && has_next) S.a_ready(nxt);
            if constexpr (SP2) {
            PG8_LDB(B0, 0, 0); PG8_LDB(B1, 0, 1); PG8_SCHED; PG8_LDA(At, 0, 0); PG8_STAGE(PG8_SA(1, 1), a1 + hstepA, voffA);
            PG8_WAIT_V(8); PG8_WAIT_L(0); PG8_BAR; PG8_MMA(0, 0, At, B0); PG8_MMA(0, 1, At, B1); PG8_BAR; PG8_SCHED;
            PG8_LDA(At, 0, 1); PG8_STAGE(PG8_SB(0, 0), b2, voffB); PG8_STAGE(PG8_SB(0, 1), b2 + hstepB, voffB); PG8_STAGE(PG8_SA(0, 0), a2, voffA);
            PG8_WAIT_V(8); PG8_WAIT_L(0); PG8_BAR; PG8_MMA(1, 0, At, B0); PG8_MMA(1, 1, At, B1); PG8_BAR; PG8_SCHED;
            PG8_LDB(B0, 1, 0); PG8_LDB(B1, 1, 1); PG8_SCHED; PG8_LDA(At, 1, 0); PG8_STAGE(PG8_SA(0, 1), a2 + hstepA, voffA);
            PG8_WAIT_V(8); PG8_WAIT_L(0); PG8_BAR; PG8_MMA(0, 0, At, B0); PG8_MMA(0, 1, At, B1); PG8_BAR; PG8_SCHED;
            PG8_LDA(At, 1, 1); PG8_STAGE(PG8_SB(1, 0), b3, voffB); PG8_STAGE(PG8_SB(1, 1), b3 + hstepB, voffB); PG8_STAGE(PG8_SA(1, 0), a3, voffA);
            PG8_WAIT_V(8); PG8_WAIT_L(0); PG8_BAR; PG8_MMA(1, 0, At, B0); PG8_MMA(1, 1, At, B1); PG8_BAR; PG8_SCHED;
            } else {
            PG8_LDB(B0, 0, 0); PG8_SCHED; PG8_LDA(At, 0, 0); PG8_STAGE(PG8_SA(1, 1), a1 + hstepA, voffA);
            PG8_WAIT_L(8); PG8_BAR; PG8_WAIT_L(0); PG8_MMA(0, 0, At, B0); PG8_BAR; PG8_SCHED;
            PG8_LDB(B1, 0, 1); PG8_STAGE(PG8_SB(0, 0), b2, voffB);
            PG8_BAR; PG8_WAIT_L(0); PG8_MMA(0, 1, At, B1); PG8_BAR;
            PG8_LDA(At, 0, 1); PG8_STAGE(PG8_SA(0, 0), a2, voffA);
            PG8_BAR; PG8_WAIT_L(0); PG8_MMA(1, 0, At, B0); PG8_BAR; PG8_SCHED;
            PG8_STAGE(PG8_SB(0, 1), b2 + hstepB, voffB);
            PG8_WAIT_V(6); PG8_BAR; PG8_MMA(1, 1, At, B1); PG8_BAR;
            PG8_LDB(B0, 1, 0); PG8_SCHED; PG8_LDA(At, 1, 0); PG8_STAGE(PG8_SA(0, 1), a2 + hstepA, voffA);
            PG8_WAIT_L(8); PG8_BAR; PG8_WAIT_L(0); PG8_MMA(0, 0, At, B0); PG8_BAR; PG8_SCHED;
            PG8_LDB(B1, 1, 1); PG8_STAGE(PG8_SB(1, 0), b3, voffB);
            PG8_BAR; PG8_WAIT_L(0); PG8_MMA(0, 1, At, B1); PG8_BAR;
            PG8_LDA(At, 1, 1); PG8_STAGE(PG8_SA(1, 0), a3, voffA);
            PG8_BAR; PG8_WAIT_L(0); PG8_MMA(1, 0, At, B0); PG8_BAR; PG8_SCHED;
            PG8_STAGE(PG8_SB(1, 1), b3 + hstepB, voffB);
            PG8_WAIT_V(6); PG8_BAR; PG8_MMA(1, 1, At, B1); PG8_BAR;
            }
        }
        if constexpr (ALIGN_EPI) { if (wr == 0) PG8_BAR; }
        if constexpr (!Epi::AFTER_DRAIN) { E(acc, cur, wr, wc, fr, fq); S.done(cur); }
        if (!has_next) break;
#pragma unroll
        for (int a = 0; a < 2; ++a)
#pragma unroll
            for (int b = 0; b < 2; ++b)
#pragma unroll
                for (int m = 0; m < 4; ++m)
#pragma unroll
                    for (int n = 0; n < 2; ++n) acc[a][b][m][n] = (f32x4){0.f, 0.f, 0.f, 0.f};
        cur = nxt; cA = nA; cB = nB; ++ui;
        if constexpr (ALIGN_EPI) { if (wr == 1) PG8_BAR; }
    }
    PG8_WAIT_V(0);
    if constexpr (!ALIGN_EPI) { if (wr == 0) PG8_BAR; }
    PG8_BAR;
    if constexpr (Epi::AFTER_DRAIN) { E.fused(acc, cur, wr, wc, fr, fq, lds, wid, lane); S.done(cur); }
#undef PG8_SA
#undef PG8_SB
#undef PG8_STAGE
#undef PG8_LDA
#undef PG8_LDB
#undef PG8_MMA
#undef PG8_WAIT_V
#undef PG8_WAIT_L
#undef PG8_BAR
#undef PG8_SCHED
}
}
#endif

constexpr int BATCH = 8, SEQ = 4096, M = BATCH * SEQ, DM = 1024, FF = 4096, PLE = 256;
constexpr int E_IN = 2208, E_INP = 2304;
constexpr int ZC_CQ = 0, ZC_CKV = 384, ZC_KR = 640, ZC_QB = 672, ZC_KB = 1184, ZC_VB = 1696;
constexpr int QA_N = 768, KVA_N = 1024, QKV_N = 3072;
constexpr float EPS = 1e-6f;
constexpr float LOG2E = 1.4426950408889634f;
constexpr float QS_A = 0.10206207261596575f * LOG2E;
constexpr float QS_B = 0.125f * LOG2E;
constexpr int NWAVES = 8, NTHR = 512;
constexpr int NPH = 24;

constexpr size_t MiB = 1u << 20;
constexpr size_t WS_CTL = 0, CTL_ZERO_BYTES = 65536;
constexpr size_t WS_ROPE = 1 * MiB;
constexpr size_t WS_KMEAN = 5 * MiB;
constexpr size_t WS_W = 6 * MiB;
constexpr size_t WS_SSA = 60 * MiB, WS_SSB = 62 * MiB;
constexpr size_t WS_Z = 64 * MiB, WS_U = 64 * MiB, WS_QKV = 64 * MiB;
constexpr size_t WS_QA = 208 * MiB, WS_KVA = 256 * MiB, WS_XM1 = 256 * MiB;
constexpr size_t WS_OB = 320 * MiB, WS_LSE = 416 * MiB;
constexpr size_t WS_XNA = 320 * MiB, WS_PB = 384 * MiB, WS_PP = 400 * MiB;
constexpr size_t WS_MIXED = 419 * MiB;
constexpr size_t WS_SSQ = 483 * MiB, WS_SSKV = 484 * MiB;
constexpr size_t WS_END = 485 * MiB;
constexpr size_t W_INE = 0, W_UQ = W_INE + (size_t)E_INP * DM, W_UKV = W_UQ + (size_t)QA_N * 384, W_OUTE = W_UKV + (size_t)KVA_N * 256,
                 W_INO = W_OUTE + (size_t)DM * DM, W_OUTO = W_INO + (size_t)QKV_N * DM, W_FF1 = W_OUTO + (size_t)DM * DM, W_FF2 = W_FF1 + 2 * (size_t)FF * DM,
                 W_G = W_FF2 + 2 * (size_t)FF * DM, W_P = W_G + 2 * (size_t)DM * DM, W_END = W_P + 2 * (size_t)DM * PLE;
static_assert(WS_W + W_END * 2 <= WS_SSA, "weights fit");
constexpr int CW_BAR = 4096;

constexpr int RING_BYTES = 131072, LDSCTL_OFF = RING_BYTES, MISC_OFF = LDSCTL_OFF + 320, LDS_BYTES = 147456;

typedef unsigned short bf16;
typedef unsigned u32x2 __attribute__((ext_vector_type(2)));
typedef unsigned u32x4 __attribute__((ext_vector_type(4)));
typedef float f32x4 __attribute__((ext_vector_type(4)));
typedef float f32x2 __attribute__((ext_vector_type(2)));
typedef GAS unsigned gu32;
#define RLX_AGENT __ATOMIC_RELAXED, __HIP_MEMORY_SCOPE_AGENT
#define LDS_WAIT() asm volatile("s_waitcnt lgkmcnt(0)" ::: "memory")
#define VM_WAIT() asm volatile("s_waitcnt vmcnt(0)" ::: "memory")

__device__ __forceinline__ float bf_lo(unsigned w) { return __uint_as_float(w << 16); }
__device__ __forceinline__ float bf_hi(unsigned w) { return __uint_as_float(w & 0xffff0000u); }
__device__ __forceinline__ float bf2f(bf16 h) { return __uint_as_float((unsigned)h << 16); }
typedef __bf16 bf16x2_hw __attribute__((ext_vector_type(2)));
__device__ __forceinline__ unsigned pk2(float lo, float hi) { const f32x2 v = {lo, hi}; return __builtin_bit_cast(unsigned, __builtin_convertvector(v, bf16x2_hw)); }
__device__ __forceinline__ unsigned f2bf(float f) { return pk2(f, 0.f) & 0xffffu; }
__device__ __forceinline__ float rsq(float x) { return __builtin_amdgcn_rsqf(x); }
template <class T> __device__ __forceinline__ T* as_global(T* p) {
#if defined(__HIP_DEVICE_COMPILE__)
    __builtin_assume(!__builtin_amdgcn_is_shared((const __attribute__((address_space(0))) void*)p)); __builtin_assume(!__builtin_amdgcn_is_private((const __attribute__((address_space(0))) void*)p));
#endif
    return p; }
__device__ __forceinline__ float ex2(float x) { return __builtin_amdgcn_exp2f(x); }
template <int XM> __device__ __forceinline__ float swz_xor(float v) { return __builtin_bit_cast(float, __builtin_amdgcn_ds_swizzle(__builtin_bit_cast(int, v), (XM << 10) | 0x1F)); }
__device__ __forceinline__ float sum_xor32(float v) { auto r = __builtin_amdgcn_permlane32_swap(__float_as_uint(v), __float_as_uint(v), false, false); return __uint_as_float(r[0]) + __uint_as_float(r[1]); }
__device__ __forceinline__ float sum_xor16(float v) { auto r = __builtin_amdgcn_permlane16_swap(__float_as_uint(v), __float_as_uint(v), false, false); return __uint_as_float(r[0]) + __uint_as_float(r[1]); }
__device__ __forceinline__ float get_xor32(float v, bool lo) { auto r = __builtin_amdgcn_permlane32_swap(__float_as_uint(v), __float_as_uint(v), false, false); return lo ? __uint_as_float(r[1]) : __uint_as_float(r[0]); }
__device__ __forceinline__ float wave_sum(float v) {
    v += swz_xor<1>(v); v += swz_xor<2>(v); v += swz_xor<4>(v); v += swz_xor<8>(v); v += swz_xor<16>(v);
    return sum_xor32(v);
}

#define XB_TMO      128
#define XB_XCNT(j)  (256  + 64 * (j))
#define XB_XSUB(j)  (1280 + 64 * (j))
#define XB_XGEN(j)  (2304 + 64 * (j))
#define XB_TOP      3328
#define XB_TOPGEN   3392
#define XCD_BAR_WORDS 3456
#define XB_SPIN_CAP (1u << 22)
__device__ __forceinline__ unsigned xb_ld(unsigned* p)              { return __hip_atomic_load(p, __ATOMIC_RELAXED, __HIP_MEMORY_SCOPE_AGENT); }
__device__ __forceinline__ unsigned xb_add(unsigned* p, unsigned v) { return __hip_atomic_fetch_add(p, v, __ATOMIC_RELAXED, __HIP_MEMORY_SCOPE_AGENT); }
__device__ __forceinline__ unsigned xb_xcc_id() { return (unsigned)__builtin_amdgcn_s_getreg((3 << 11) | 20) & 0xFu; }
#define XB_SPIN(cond, bar) do { unsigned _sp = 0; while (cond) { __builtin_amdgcn_s_sleep(1); \
    if ((++_sp & 255u) == 0u) { if (xb_ld(&(bar)[XB_TMO])) break; if (_sp > XB_SPIN_CAP) { atomicAdd(&(bar)[XB_TMO], 1u); break; } } } } while (0)
struct XcdBarrier { unsigned* bar; unsigned x; volatile LAS unsigned* st; };
__device__ __forceinline__ XcdBarrier xcd_barrier_post(unsigned* bar, volatile LAS unsigned* st) {
    XcdBarrier b; b.bar = bar; b.x = xb_xcc_id(); b.st = st;
    if (threadIdx.x == 0) (void)xb_add(&bar[XB_XCNT(b.x)], 1u);
    return b;
}
__device__ __forceinline__ void xcd_barrier_complete(unsigned* bar, unsigned x, unsigned& nloc, unsigned& nx) {
    const unsigned G = gridDim.x * gridDim.y * gridDim.z;
    unsigned sum, cnt, mine, sp = 0u;
    for (;;) {
        sum = 0u; cnt = 0u; mine = 0u;
#pragma unroll
        for (unsigned j = 0; j < 16; ++j) { const unsigned c = xb_ld(&bar[XB_XCNT(j)]); sum += c; cnt += (c > 0u) ? 1u : 0u; mine = (j == x) ? c : mine; }
        if (sum == G) break;
        __builtin_amdgcn_s_sleep(1);
        if ((++sp & 255u) == 0u) { if (xb_ld(&bar[XB_TMO])) break; if (sp > XB_SPIN_CAP) { atomicAdd(&bar[XB_TMO], 1u); break; } }
    }
    nloc = mine > 0u ? mine : 1u; nx = cnt > 0u ? cnt : 1u;
}
__device__ __forceinline__ void xcd_barrier(const XcdBarrier& b) {
    asm volatile("s_waitcnt vmcnt(0)" ::: "memory");
    __syncthreads();
    if (threadIdx.x == 0) {
        unsigned* bar = b.bar;
        __builtin_amdgcn_s_waitcnt(0);
        unsigned nloc = b.st[0], nx = b.st[1];
        if (nloc == 0u) { xcd_barrier_complete(bar, b.x, nloc, nx); b.st[0] = nloc; b.st[1] = nx; }
        const unsigned old = xb_add(&bar[XB_XSUB(b.x)], 1u);
        const unsigned gen = old / nloc;
        if (old + 1u == (gen + 1u) * nloc) {
            __builtin_amdgcn_fence(__ATOMIC_RELEASE, "agent");
            asm volatile("s_waitcnt vmcnt(0)" ::: "memory");
            const unsigned og = xb_add(&bar[XB_TOP], 1u);
            const unsigned tg = og / nx;
            if (og + 1u == (tg + 1u) * nx) xb_add(&bar[XB_TOPGEN], 1u);
            else XB_SPIN(xb_ld(&bar[XB_TOPGEN]) == tg, bar);
            __builtin_amdgcn_fence(__ATOMIC_ACQUIRE, "agent");
            xb_add(&bar[XB_XGEN(b.x)], 1u);
            asm volatile("s_waitcnt vmcnt(0)" ::: "memory");
        } else {
            XB_SPIN(xb_ld(&bar[XB_XGEN(b.x)]) == gen, bar);
            __builtin_amdgcn_fence(__ATOMIC_ACQUIRE, "agent");
            asm volatile("s_waitcnt vmcnt(0)" ::: "memory");
        }
    }
    __syncthreads();
}

struct Args { const void* in[26]; float* out; unsigned char* ws; int ph_lo, ph_hi; };
struct Frame {
    LAS unsigned char* lds; int tid, lane, wave, vcu, G;
    unsigned char* ws; float* H;
};
enum InIdx { I_X = 0, I_P, I_POS, I_EWIN, I_ECQN, I_ECKVN, I_EWUQ, I_EWUKV, I_EQNN, I_EQNR, I_EKNN, I_EKNR, I_EDQN, I_EDKN, I_EWOUT,
             I_OWIN, I_OQN, I_OKN, I_OWOUT, I_MIXN, I_FFN, I_WFF1, I_WFF2, I_PLEN, I_WG, I_WP };

__device__ __forceinline__ float red_fq(float s) { return sum_xor32(sum_xor16(s)); }
__device__ __forceinline__ float sumsq8(const f32x4& a, const f32x4& b) { return ((a[0] * a[0] + a[1] * a[1]) + (a[2] * a[2] + a[3] * a[3])) + ((b[0] * b[0] + b[1] * b[1]) + (b[2] * b[2] + b[3] * b[3])); }
__device__ __forceinline__ u32x4 pk8(const f32x4& a, const f32x4& b) { u32x4 w; w.x = pk2(a[0], a[1]); w.y = pk2(a[2], a[3]); w.z = pk2(b[0], b[1]); w.w = pk2(b[2], b[3]); return w; }
__device__ __forceinline__ float rstd_from(const float* ss, int n4, float inv_n) { f32x4 t = *(const GAS f32x4*)ss;
    for (int i = 1; i < n4; ++i) t += *(const GAS f32x4*)(ss + 4 * i);
    return rsq(((t[0] + t[1]) + (t[2] + t[3])) * inv_n + EPS); }
__device__ __forceinline__ void rope8(f32x4& y0, f32x4& y1, const float* ROPE, int row, int fq) {
    const GAS f32x4* cs = (const GAS f32x4*)(ROPE + ((size_t)row * 16 + 8 * (fq & 1)) * 2);
#pragma unroll
    for (int i = 0; i < 4; ++i) { const f32x4 t = cs[i >> 1]; const float c0 = (i & 1) ? t[2] : t[0], s0 = (i & 1) ? t[3] : t[1];
        const f32x4 u = cs[2 + (i >> 1)]; const float c1 = (i & 1) ? u[2] : u[0], s1 = (i & 1) ? u[3] : u[1];
        const float p0 = get_xor32(y0[i], fq < 2), p1 = get_xor32(y1[i], fq < 2);
        y0[i] = (fq < 2) ? (y0[i] * c0 - p0 * s0) : (p0 * s0 + y0[i] * c0);
        y1[i] = (fq < 2) ? (y1[i] * c1 - p1 * s1) : (p1 * s1 + y1[i] * c1); }
}

__device__ __forceinline__ u32x4 swap_adj(const u32x4 v) { u32x4 r;
#pragma unroll
    for (int e = 0; e < 4; ++e) r[e] = (unsigned)__builtin_amdgcn_mov_dpp((int)v[e], 0xB1, 0xF, 0xF, true);
    return r; }
template <bool NT> __device__ __forceinline__ void store_lines2(GAS char* own, size_t pitchB, int dist, int row, const u32x4 p0, const u32x4 p1) {
    const bool odd = (row & 1) != 0;
    const u32x4 rcv = swap_adj(odd ? p0 : p1);
    const u32x4 a = odd ? rcv : p0, b = odd ? p1 : rcv;
    GAS char* pa = odd ? own - pitchB + dist : own;
    GAS char* pb = odd ? own + dist : own + pitchB;
    if constexpr (NT) { __builtin_nontemporal_store(a, (GAS u32x4*)pa); __builtin_nontemporal_store(b, (GAS u32x4*)pb); }
    else { *(GAS u32x4*)pa = a; *(GAS u32x4*)pb = b; } }
template <bool NT> __device__ __forceinline__ void load_lines2(const GAS char* own, size_t pitchB, int dist, int row, u32x4& la, u32x4& lb) {
    const bool odd = (row & 1) != 0;
    const GAS char* pa = odd ? own - pitchB + dist : own; const GAS char* pb = odd ? own + dist : own + pitchB;
    if constexpr (NT) { la = __builtin_nontemporal_load((const GAS u32x4*)pa); lb = __builtin_nontemporal_load((const GAS u32x4*)pb); }
    else { la = *(const GAS u32x4*)pa; lb = *(const GAS u32x4*)pb; } }
__device__ __forceinline__ void unswap(int row, const u32x4 la, const u32x4 lb, u32x4& p0, u32x4& p1) {
    const bool odd = (row & 1) != 0; const u32x4 rcv = swap_adj(odd ? la : lb); p0 = odd ? rcv : la; p1 = odd ? lb : rcv; }
struct EpBf16R { bf16* O; int ldc;
    __device__ __forceinline__ void row(int row, int pn, int wc, int fq, const f32x4 (&a)[2][2]) const {
        store_lines2<true>((GAS char*)(O + (size_t)row * ldc + pn * 256 + wc * 64 + fq * 8), (size_t)ldc * 2, 64, row, pk8(a[0][0], a[0][1]), pk8(a[1][0], a[1][1])); } };
struct EpNull {
    __device__ __forceinline__ void row(int, int, int, int, const f32x4 (&a)[2][2]) const { asm volatile("" :: "v"(a[0][0]), "v"(a[0][1]), "v"(a[1][0]), "v"(a[1][1])); } };
__device__ __forceinline__ void unpk8(const u32x4 w, f32x4& a, f32x4& b) { a = (f32x4){bf_lo(w.x), bf_hi(w.x), bf_lo(w.y), bf_hi(w.y)}; b = (f32x4){bf_lo(w.z), bf_hi(w.z), bf_lo(w.w), bf_hi(w.w)}; }
template <bool XF> struct EpResNormT { const float* xf; const bf16* hb; bf16* Hb; float* SS;
    static constexpr int DEPTH = 3;
    struct Ops { f32x4 x[2][2]; };
    __device__ __forceinline__ void load(Ops& p, int row, int pn, int wc, int fq) const { const size_t o = (size_t)row * DM + pn * 256 + wc * 64 + fq * 8;
        u32x4 la, lb;
        if constexpr (XF) {
#pragma unroll
            for (int bj = 0; bj < 2; ++bj) { load_lines2<true>((const GAS char*)(xf + o + 32 * bj), (size_t)DM * 4, 16, row, la, lb); p.x[bj][0] = __builtin_bit_cast(f32x4, la); p.x[bj][1] = __builtin_bit_cast(f32x4, lb); } }
        else { load_lines2<false>((const GAS char*)(hb + o), (size_t)DM * 2, 64, row, la, lb); p.x[0][0] = __builtin_bit_cast(f32x4, la); p.x[1][0] = __builtin_bit_cast(f32x4, lb); p.x[0][1] = p.x[0][0]; p.x[1][1] = p.x[1][0]; } }
    __device__ __forceinline__ void fin(int row, int pn, int wc, int fq, const f32x4 (&a)[2][2], const Ops& p, float& ssr) const { float ss = 0.f; u32x4 w[2];
        u32x4 q[2][2];
        if constexpr (XF) {
#pragma unroll
            for (int bj = 0; bj < 2; ++bj) unswap(row, __builtin_bit_cast(u32x4, p.x[bj][0]), __builtin_bit_cast(u32x4, p.x[bj][1]), q[bj][0], q[bj][1]); }
        else { unswap(row, __builtin_bit_cast(u32x4, p.x[0][0]), __builtin_bit_cast(u32x4, p.x[1][0]), q[0][0], q[1][0]); q[0][1] = q[0][0]; q[1][1] = q[1][0]; }
#pragma unroll
        for (int bj = 0; bj < 2; ++bj) {
            f32x4 b0, b1; if constexpr (XF) { b0 = __builtin_bit_cast(f32x4, q[bj][0]); b1 = __builtin_bit_cast(f32x4, q[bj][1]); } else unpk8(q[bj][0], b0, b1);
            const f32x4 h0 = b0 + a[bj][0], h1 = b1 + a[bj][1];
            ss += sumsq8(h0, h1);
            w[bj] = pk8(h0, h1); }
        store_lines2<false>((GAS char*)(Hb + (size_t)row * DM + pn * 256 + wc * 64 + fq * 8), (size_t)DM * 2, 64, row, w[0], w[1]);
        ssr = red_fq(ss); }
    __device__ __forceinline__ void ss_out(int row, int pn, int wc, float v) const { ((GAS float*)SS)[(size_t)row * 16 + pn * 4 + wc] = v; } };
struct EpRelu2N { bf16* U; const float* SS;
    __device__ __forceinline__ float pre(int row, int fq) const { const f32x4 t = *(const GAS f32x4*)(SS + (size_t)row * 16 + 4 * fq); return rsq(red_fq((t[0] + t[1]) + (t[2] + t[3])) * (1.f / DM) + EPS); }
    __device__ __forceinline__ void row(int row, int pn, int wc, int fq, const f32x4 (&a)[2][2], float rs) const {
        u32x4 w[2];
#pragma unroll
        for (int bj = 0; bj < 2; ++bj) { f32x4 r0, r1;
#pragma unroll
            for (int e = 0; e < 4; ++e) { const float t0 = fmaxf(a[bj][0][e] * rs, 0.f), t1 = fmaxf(a[bj][1][e] * rs, 0.f); r0[e] = t0 * t0; r1[e] = t1 * t1; }
            w[bj] = pk8(r0, r1); }
        store_lines2<true>((GAS char*)(U + (size_t)row * FF + pn * 256 + wc * 64 + fq * 8), (size_t)FF * 2, 64, row, w[0], w[1]); } };
struct EpPleN { const bf16* hb; const bf16* PP; const float* SSi; bf16* Hb; float* SSo; float* OUT;
    static constexpr int DEPTH = 3;
    struct Ops { u32x4 pw[2], hw[2]; f32x4 sq; };
    __device__ __forceinline__ void load(Ops& p, int row, int pn, int wc, int fq) const { p.sq = *(const GAS f32x4*)(SSi + (size_t)row * 16 + 4 * fq);
        { const size_t o = (size_t)row * DM + pn * 256 + wc * 64 + fq * 8;
          load_lines2<false>((const GAS char*)(PP + o), (size_t)DM * 2, 64, row, p.pw[0], p.pw[1]); load_lines2<false>((const GAS char*)(hb + o), (size_t)DM * 2, 64, row, p.hw[0], p.hw[1]); } }
    __device__ __forceinline__ void fin(int row, int pn, int wc, int fq, const f32x4 (&a)[2][2], const Ops& p, float& ssr) const {
        const float rs = rsq(red_fq((p.sq[0] + p.sq[1]) + (p.sq[2] + p.sq[3])) * (1.f / DM) + EPS) * LOG2E; float ss = 0.f;
        u32x4 w[2], pwq[2], hwq[2]; unswap(row, p.pw[0], p.pw[1], pwq[0], pwq[1]); unswap(row, p.hw[0], p.hw[1], hwq[0], hwq[1]);
#pragma unroll
        for (int bj = 0; bj < 2; ++bj) { const int c = pn * 256 + wc * 64 + bj * 32 + fq * 8; const size_t o = (size_t)row * DM + c;
            const u32x4 pw = pwq[bj]; f32x4 h0, h1; unpk8(hwq[bj], h0, h1);
#pragma unroll
            for (int e = 0; e < 4; ++e) { const float g0 = __builtin_amdgcn_rcpf(1.f + ex2(-a[bj][0][e] * rs)), g1 = __builtin_amdgcn_rcpf(1.f + ex2(-a[bj][1][e] * rs));
                const unsigned w0 = pw[e >> 1], w1 = pw[2 + (e >> 1)];
                h0[e] += g0 * ((e & 1) ? bf_hi(w0) : bf_lo(w0)); h1[e] += g1 * ((e & 1) ? bf_hi(w1) : bf_lo(w1)); }
            if (OUT) store_lines2<true>((GAS char*)(OUT + o), (size_t)DM * 4, 16, row, __builtin_bit_cast(u32x4, h0), __builtin_bit_cast(u32x4, h1));
            else { ss += sumsq8(h0, h1); w[bj] = pk8(h0, h1); } }
        if (!OUT) { store_lines2<false>((GAS char*)(Hb + (size_t)row * DM + pn * 256 + wc * 64 + fq * 8), (size_t)DM * 2, 64, row, w[0], w[1]); ssr = red_fq(ss); } }
    __device__ __forceinline__ void ss_out(int row, int pn, int wc, float v) const { if (!OUT) ((GAS float*)SSo)[(size_t)row * 16 + pn * 4 + wc] = v; } };
struct Gains { f32x4 g[2][2]; };
__device__ __forceinline__ void load_gains64(Gains& G, const float* g, int fq) {
#pragma unroll
    for (int bj = 0; bj < 2; ++bj) { G.g[bj][0] = *(const GAS f32x4*)(g + 32 * bj + 8 * fq); G.g[bj][1] = *(const GAS f32x4*)(g + 32 * bj + 8 * fq + 4); } }
template <bool NT = true> __device__ __forceinline__ void head_norm_store(const f32x4 (&a)[2][2], float pre, const Gains& G, float sc, bf16* dst, int fq, int row, size_t pitchB, f32x4 (*colsum)[2] = nullptr) {
    f32x4 v[2][2]; u32x4 w[2];
#pragma unroll
    for (int bj = 0; bj < 2; ++bj) { v[bj][0] = a[bj][0] * pre; v[bj][1] = a[bj][1] * pre; }
    const float ss = red_fq(sumsq8(v[0][0], v[0][1]) + sumsq8(v[1][0], v[1][1])); const float rs = sc * rsq(ss * (1.f / 64.f) + EPS);
#pragma unroll
    for (int bj = 0; bj < 2; ++bj) { const f32x4 y0 = v[bj][0] * rs * G.g[bj][0], y1 = v[bj][1] * rs * G.g[bj][1];
        if (colsum) { colsum[bj][0] += y0; colsum[bj][1] += y1; }
        w[bj] = pk8(y0, y1); }
    store_lines2<NT>((GAS char*)(dst + 8 * fq), pitchB, 64, row, w[0], w[1]);
}
struct EpInE { bf16* Z; const float* ROPE; const float *g_cq, *g_ckv, *g_kr, *g_dq, *g_dk; float* SSQ; float* SSKV;
    __device__ __forceinline__ void gains(Gains& G, int pn, int wc, int fq) const {
        if (pn == 0 || pn == 2) { const float* g = pn ? g_ckv : g_cq;
#pragma unroll
            for (int bj = 0; bj < 2; ++bj) { const int c = bj * 128 + wc * 32 + fq * 8; G.g[bj][0] = *(const GAS f32x4*)(g + c); G.g[bj][1] = *(const GAS f32x4*)(g + c + 4); } }
        else if (pn == 1) { const int c = 256 + wc * 32 + fq * 8; G.g[0][0] = *(const GAS f32x4*)(g_cq + c); G.g[0][1] = *(const GAS f32x4*)(g_cq + c + 4);
            G.g[1][0] = *(const GAS f32x4*)(g_kr + 8 * fq); G.g[1][1] = *(const GAS f32x4*)(g_kr + 8 * fq + 4); }
        else load_gains64(G, (pn >= 5) ? g_dk : g_dq, fq); }
    __device__ __forceinline__ void row(int row, int pn, int wc, int fq, const f32x4 (&a)[2][2], const Gains& G) const { bf16* zr = Z + (size_t)row * E_INP;
        if (pn == 0) { float ss = 0.f;
#pragma unroll
            for (int bj = 0; bj < 2; ++bj) { const int c = bj * 128 + wc * 32 + fq * 8; ss += sumsq8(a[bj][0], a[bj][1]);
                __builtin_nontemporal_store(pk8(a[bj][0] * G.g[bj][0], a[bj][1] * G.g[bj][1]), (GAS u32x4*)(zr + ZC_CQ + c)); }
            ss = red_fq(ss); if (fq == 0) ((GAS float*)SSQ)[(size_t)row * 8 + wc] = ss;
        } else if (pn == 1) {
            { const int c = 256 + wc * 32 + fq * 8; const float ss = red_fq(sumsq8(a[0][0], a[0][1]));
              __builtin_nontemporal_store(pk8(a[0][0] * G.g[0][0], a[0][1] * G.g[0][1]), (GAS u32x4*)(zr + ZC_CQ + c));
              if (fq == 0) ((GAS float*)SSQ)[(size_t)row * 8 + 4 + wc] = ss; }
            if (wc == 0) { const float ss = red_fq(sumsq8(a[1][0], a[1][1])); const float rs = rsq(ss * (1.f / 32.f) + EPS);
                f32x4 y0 = a[1][0] * rs * G.g[1][0], y1 = a[1][1] * rs * G.g[1][1];
                rope8(y0, y1, ROPE, row, fq);
                __builtin_nontemporal_store(pk8(y0, y1), (GAS u32x4*)(zr + ZC_KR + 8 * fq)); }
        } else if (pn == 2) { float ss = 0.f;
#pragma unroll
            for (int bj = 0; bj < 2; ++bj) { const int c = bj * 128 + wc * 32 + fq * 8; ss += sumsq8(a[bj][0], a[bj][1]);
                __builtin_nontemporal_store(pk8(a[bj][0] * G.g[bj][0], a[bj][1] * G.g[bj][1]), (GAS u32x4*)(zr + ZC_CKV + c)); }
            ss = red_fq(ss); if (fq == 0) ((GAS float*)SSKV)[(size_t)row * 4 + wc] = ss;
        } else if (pn < 7) { const int which = (pn >= 5) ? 1 : 0, head = 4 * ((pn - 3) & 1) + wc;
            head_norm_store<false>(a, 1.f, G, which ? 1.f : QS_B, zr + (which ? ZC_KB : ZC_QB) + head * 64, fq, row, (size_t)E_INP * 2);
        } else { const int head = 4 * (pn - 7) + wc;
            store_lines2<false>((GAS char*)(zr + ZC_VB + head * 64 + 8 * fq), (size_t)E_INP * 2, 64, row, pk8(a[0][0], a[0][1]), pk8(a[1][0], a[1][1])); }
    } };
struct EpInE8 { EpInE e;
    __device__ __forceinline__ void gains(Gains& G, int pn, int wc, int fq) const { e.gains(G, 8, wc, fq); }
    __device__ __forceinline__ void row(int row, int pn, int wc, int fq, const f32x4 (&a)[2][2], const Gains& G) const { e.row(row, 8, wc, fq, a, G); } };
struct EpUq { bf16* QA; const float* ROPE; const float *g_qn, *g_qr; const float* SSQ;
    __device__ __forceinline__ float pre(int row, int fq) const { float s = 0.f; if (fq < 2) { const f32x4 t = *(const GAS f32x4*)(SSQ + (size_t)row * 8 + 4 * fq); s = (t[0] + t[1]) + (t[2] + t[3]); } return rsq(red_fq(s) * (1.f / 384.f) + EPS); }
    __device__ __forceinline__ void gains(Gains& G, int pn, int wc, int fq) const {
        if (pn < 2) load_gains64(G, g_qn, fq);
        else { G.g[0][0] = *(const GAS f32x4*)(g_qr + 8 * fq); G.g[0][1] = *(const GAS f32x4*)(g_qr + 8 * fq + 4); G.g[1][0] = G.g[0][0]; G.g[1][1] = G.g[0][1]; } }
    __device__ __forceinline__ void row(int row, int pn, int wc, int fq, const f32x4 (&a)[2][2], float pre, const Gains& G) const { bf16* qr = QA + (size_t)row * QA_N;
        if (pn < 2) head_norm_store(a, pre, G, QS_A, qr + (4 * pn + wc) * 96, fq, row, (size_t)QA_N * 2);
        else {
#pragma unroll
            for (int bj = 0; bj < 2; ++bj) { const f32x4 v0 = a[bj][0] * pre, v1 = a[bj][1] * pre; const float ss = red_fq(sumsq8(v0, v1)); const float rs = rsq(ss * (1.f / 32.f) + EPS);
                f32x4 y0 = v0 * rs * G.g[bj][0], y1 = v1 * rs * G.g[bj][1];
                rope8(y0, y1, ROPE, row, fq);
                __builtin_nontemporal_store(pk8(y0 * QS_A, y1 * QS_A), (GAS u32x4*)(qr + (4 * bj + wc) * 96 + 64 + 8 * fq)); } }
    } };
struct EpUkv { bf16* KVA; const float* g_kn; const float* SSKV;
    __device__ __forceinline__ float pre(int row, int fq) const { return rstd_from(SSKV + (size_t)row * 4, 1, 1.f / 256.f); }
    __device__ __forceinline__ void gains(Gains& G, int pn, int wc, int fq) const { load_gains64(G, g_kn, fq); }
    __device__ __forceinline__ void row(int row, int pn, int wc, int fq, const f32x4 (&a)[2][2], float pre, const Gains& G) const { bf16* kr = KVA + (size_t)row * KVA_N;
        if (pn < 2) head_norm_store(a, pre, G, 1.f, kr + (4 * pn + wc) * 128, fq, row, (size_t)KVA_N * 2);
        else { bf16* vp = kr + (4 * (pn - 2) + wc) * 128 + 64;
            store_lines2<true>((GAS char*)(vp + 8 * fq), (size_t)KVA_N * 2, 64, row, pk8(a[0][0] * pre, a[0][1] * pre), pk8(a[1][0] * pre, a[1][1] * pre)); }
    } };
struct EpInO { bf16* QKV; const float *g_q, *g_k; const float* SS; float* KMEAN;
    struct State { f32x4 cs[2][2]; };
    __device__ __forceinline__ void begin(State& st) const {
#pragma unroll
        for (int bj = 0; bj < 2; ++bj) { st.cs[bj][0] = (f32x4){0.f, 0.f, 0.f, 0.f}; st.cs[bj][1] = (f32x4){0.f, 0.f, 0.f, 0.f}; } }
    __device__ __forceinline__ float pre(int row, int fq) const { const f32x4 t = *(const GAS f32x4*)(SS + (size_t)row * 16 + 4 * fq); return rsq(red_fq((t[0] + t[1]) + (t[2] + t[3])) * (1.f / DM) + EPS); }
    __device__ __forceinline__ void gains(Gains& G, int pn, int wc, int fq) const { load_gains64(G, ((pn >> 2) == 1) ? g_k : g_q, fq); }
    __device__ __forceinline__ void row(int row, int pn, int wc, int fq, const f32x4 (&a)[2][2], State& st, float pre, const Gains& G) const {
        const int sec = pn >> 2, head = 4 * (pn & 3) + wc; bf16* dst = QKV + (size_t)row * QKV_N + sec * 1024 + head * 64;
        if (sec == 0) head_norm_store(a, pre, G, QS_B, dst, fq, row, (size_t)QKV_N * 2);
        else if (sec == 1) head_norm_store(a, pre, G, 1.f, dst, fq, row, (size_t)QKV_N * 2, st.cs);
        else {
            store_lines2<true>((GAS char*)(dst + 8 * fq), (size_t)QKV_N * 2, 64, row, pk8(a[0][0] * pre, a[0][1] * pre), pk8(a[1][0] * pre, a[1][1] * pre)); }
    }
    __device__ __forceinline__ void end(State& st, int pm, int pn, int wc, int fr, int fq) const {
        if ((pn >> 2) != 1) return;
        const int head = 4 * (pn & 3) + wc, b = pm >> 4, n = pm & 15;
        float* km = KMEAN + ((size_t)(b * 16 + head) * 16 + n) * 64;
#pragma unroll
        for (int bj = 0; bj < 2; ++bj)
#pragma unroll
            for (int q = 0; q < 2; ++q)
#pragma unroll
                for (int e = 0; e < 4; ++e) { float s = st.cs[bj][q][e]; s += swz_xor<1>(s); s += swz_xor<2>(s); s += swz_xor<4>(s); s += swz_xor<8>(s);
                    if (fr == 0) atomicAdd(km + 32 * bj + 8 * fq + 4 * q + e, s * (1.f / 256.f)); }
    } };

template <class Inner, class = void> struct HasState { static constexpr bool value = false; };
template <class Inner> struct HasState<Inner, decltype((void)sizeof(typename Inner::State))> { static constexpr bool value = true; };
template <class Inner, class = void> struct HasOps { static constexpr bool value = false; };
template <class Inner> struct HasOps<Inner, decltype((void)sizeof(typename Inner::Ops))> { static constexpr bool value = true; };
template <class Inner, class = void> struct HasGains { static constexpr bool value = false; };
template <class Inner> struct HasGains<Inner, decltype((void)&Inner::gains)> { static constexpr bool value = true; };
template <class Inner, class = void> struct HasPre { static constexpr bool value = false; };
template <class Inner> struct HasPre<Inner, decltype((void)&Inner::pre)> { static constexpr bool value = true; };
template <class Inner> struct EpiRow {
    static constexpr bool PERM = true, AFTER_DRAIN = false; Inner in;
    __device__ __forceinline__ void operator()(const pg8::f32x4 (&acc)[2][2][4][2], const pg8::Unit& u, int wr, int wc, int fr, int fq) const {
        if constexpr (HasState<Inner>::value) {
            typename Inner::State st; in.begin(st); Gains G; in.gains(G, u.pn, wc, fq);
            float rs[8];
#pragma unroll
            for (int g = 0; g < 8; ++g) rs[g] = in.pre(u.pm * 256 + (g >> 2) * 128 + wr * 64 + (g & 3) * 16 + fr, fq);
#pragma unroll
            for (int ai = 0; ai < 2; ++ai)
#pragma unroll
                for (int m = 0; m < 4; ++m) { const int row = u.pm * 256 + ai * 128 + wr * 64 + m * 16 + fr;
                    const f32x4 a[2][2] = {{acc[ai][0][m][0], acc[ai][0][m][1]}, {acc[ai][1][m][0], acc[ai][1][m][1]}};
                    in.row(row, u.pn, wc, fq, a, st, rs[ai * 4 + m], G);
                    asm volatile("" ::: "memory"); }
            in.end(st, u.pm, u.pn, wc, fr, fq);
        } else if constexpr (HasOps<Inner>::value) {
            constexpr int D = Inner::DEPTH; typename Inner::Ops ops[8]; float ssk = 0.f;
#define EPI_ROW(g) (u.pm * 256 + ((g) >> 2) * 128 + wr * 64 + ((g) & 3) * 16 + fr)
#pragma unroll
            for (int g = 0; g < D; ++g) in.load(ops[g], EPI_ROW(g), u.pn, wc, fq);
            asm volatile("" ::: "memory");
#pragma unroll
            for (int g = 0; g < 8; ++g) { const int ai = g >> 2, m = g & 3;
                const f32x4 a[2][2] = {{acc[ai][0][m][0], acc[ai][0][m][1]}, {acc[ai][1][m][0], acc[ai][1][m][1]}};
                float ssg = 0.f; in.fin(EPI_ROW(g), u.pn, wc, fq, a, ops[g], ssg);
                ssk = (fq == (g & 3)) ? ssg : ssk;
                if ((g & 3) == 3) in.ss_out(u.pm * 256 + (g >> 2) * 128 + wr * 64 + 16 * fq + fr, u.pn, wc, ssk);
                if (g + D < 8) in.load(ops[g + D], EPI_ROW(g + D), u.pn, wc, fq);
                asm volatile("" ::: "memory"); }
#undef EPI_ROW
        } else if constexpr (HasPre<Inner>::value) {
            float rs[8]; Gains G; if constexpr (HasGains<Inner>::value) in.gains(G, u.pn, wc, fq);
#pragma unroll
            for (int g = 0; g < 8; ++g) rs[g] = in.pre(u.pm * 256 + (g >> 2) * 128 + wr * 64 + (g & 3) * 16 + fr, fq);
#pragma unroll
            for (int ai = 0; ai < 2; ++ai)
#pragma unroll
                for (int m = 0; m < 4; ++m) { const int row = u.pm * 256 + ai * 128 + wr * 64 + m * 16 + fr;
                    const f32x4 a[2][2] = {{acc[ai][0][m][0], acc[ai][0][m][1]}, {acc[ai][1][m][0], acc[ai][1][m][1]}};
                    if constexpr (HasGains<Inner>::value) in.row(row, u.pn, wc, fq, a, rs[ai * 4 + m], G); else in.row(row, u.pn, wc, fq, a, rs[ai * 4 + m]);
                    asm volatile("" ::: "memory"); }
        } else {
            Gains G; if constexpr (HasGains<Inner>::value) in.gains(G, u.pn, wc, fq);
#pragma unroll
            for (int ai = 0; ai < 2; ++ai)
#pragma unroll
                for (int m = 0; m < 4; ++m) { const int row = u.pm * 256 + ai * 128 + wr * 64 + m * 16 + fr;
                    const f32x4 a[2][2] = {{acc[ai][0][m][0], acc[ai][0][m][1]}, {acc[ai][1][m][0], acc[ai][1][m][1]}};
                    if constexpr (HasGains<Inner>::value) in.row(row, u.pn, wc, fq, a, G); else in.row(row, u.pn, wc, fq, a);
                    asm volatile("" ::: "memory"); }
        }
    }
};
template <class Inner> __device__ __forceinline__ void run_gemm(const Frame& F, const bf16* A, int lda, const bf16* Bt, int N, int K, const Inner& in, int rot = 0) {
    int bid_ = blockIdx.x; asm volatile("" : "+s"(bid_));
    { int c_ = bid_ + rot; if (c_ >= F.G) c_ -= F.G; bid_ = c_; }
    pg8::Gemm g{A, Bt, M, N, K, lda}; pg8::StaticOrder S; S.init(M, N, F.G, bid_);
    EpiRow<Inner> E{in};
    pg8::gemm_phase<EpiRow<Inner>, pg8::StaticOrder, true, GEMM_SP2>(F.lds, g, S, E);
}

__device__ __forceinline__ int head_row(int tile, int h, int d) { return tile * 256 + 32 * (h & 3) + (d & 31) + 128 * (d >> 5); }
__device__ __forceinline__ int perm_ine(int n) {
    if (n < 384) return n;
    if (n < 640) return 512 + (n - 384);
    if (n < 672) return 384 + (n - 640);
    const int x = n - 672, sec = x >> 9, h = (x >> 6) & 7, d = x & 63; return head_row(3 + 2 * sec + (h >> 2), h, d);
}
__device__ __forceinline__ int perm_uq(int n) { const int h = n / 96, r = n - 96 * h; if (r < 64) return head_row(h >> 2, h, r); return 512 + 128 * (h >> 2) + 32 * (h & 3) + (r - 64); }
__device__ __forceinline__ int perm_ukv(int n) { const int h = n >> 7, part = (n >> 6) & 1, d = n & 63; return head_row(2 * part + (h >> 2), h, d); }
__device__ __forceinline__ int perm_ino(int n) { const int sec = n >> 10, h = (n >> 6) & 15, d = n & 63; return head_row(4 * sec + (h >> 2), h, d); }
struct RowId { __device__ __forceinline__ int operator()(int n) const { return n; } };
template <class RowMap> __device__ __forceinline__ void p0_transpose_item(const float* W, int K, int N, bf16* WT, LAS float* scr, int item, int lane, const RowMap& rm, const float* gk = nullptr) {
    const int nblk = N / 32, kb = item / nblk, nb = item % nblk, k0 = 64 * kb, n0 = 32 * nb;
    { const int r8 = lane >> 3, c4 = (lane & 7) * 4; f32x4 v[8]; float gs[8];
#pragma unroll
      for (int i = 0; i < 8; ++i) { const int kk = 8 * i + r8; v[i] = __builtin_nontemporal_load((const GAS f32x4*)((const GAS float*)W + (size_t)(k0 + kk) * N + n0 + c4)); gs[i] = gk ? ((const GAS float*)gk)[k0 + kk] : 1.f; }
#pragma unroll
      for (int i = 0; i < 8; ++i) { LAS float* d = scr + (8 * i + r8) * 33 + c4; d[0] = v[i][0] * gs[i]; d[1] = v[i][1] * gs[i]; d[2] = v[i][2] * gs[i]; d[3] = v[i][3] * gs[i]; } }
    LDS_WAIT(); asm volatile("" ::: "memory");
    const int c = lane & 7;
#pragma unroll
    for (int j = 0; j < 4; ++j) { const int n = (lane >> 3) + 8 * j; const LAS float* s = scr + (8 * c) * 33 + n;
        u32x4 o; o.x = pk2(s[0 * 33], s[1 * 33]); o.y = pk2(s[2 * 33], s[3 * 33]); o.z = pk2(s[4 * 33], s[5 * 33]); o.w = pk2(s[6 * 33], s[7 * 33]);
        *(GAS u32x4*)(WT + (size_t)rm(n0 + n) * K + k0 + 8 * c) = o; }
    LDS_WAIT(); asm volatile("" ::: "memory");
}
template <int NR> __device__ __forceinline__ void rms_rows_1024(const float* x0, size_t rstride, const float* g, bf16* o0, int lane) {
    const GAS f32x4* gr = (const GAS f32x4*)g + lane;
    f32x4 v[NR][4]; float s[NR];
#pragma unroll
    for (int r = 0; r < NR; ++r) { const GAS f32x4* xr = (const GAS f32x4*)(x0 + r * rstride) + lane; s[r] = 0.f;
#pragma unroll
        for (int j = 0; j < 4; ++j) v[r][j] = __builtin_nontemporal_load(xr + 64 * j); }
    f32x4 gg[4];
#pragma unroll
    for (int j = 0; j < 4; ++j) gg[j] = gr[64 * j];
#pragma unroll
    for (int r = 0; r < NR; ++r) {
#pragma unroll
        for (int j = 0; j < 4; ++j) s[r] += (v[r][j].x * v[r][j].x + v[r][j].y * v[r][j].y) + (v[r][j].z * v[r][j].z + v[r][j].w * v[r][j].w);
        const float rstd = rsq(wave_sum(s[r]) * (1.f / DM) + EPS);
        GAS u32x2* o8 = (GAS u32x2*)(o0 + r * rstride) + lane;
#pragma unroll
        for (int j = 0; j < 4; ++j) { u32x2 w; w.x = pk2(v[r][j].x * rstd * gg[j].x, v[r][j].y * rstd * gg[j].y); w.y = pk2(v[r][j].z * rstd * gg[j].z, v[r][j].w * rstd * gg[j].w); o8[64 * j] = w; } }
}
__device__ __forceinline__ void rms_rows_phase(const Frame& F, const float* src, const float* g, bf16* dst) {
    const int gw = F.vcu * NWAVES + F.wave, NGW = F.G * NWAVES;
    int m = gw;
    for (; m + 3 * NGW < M; m += 4 * NGW) rms_rows_1024<4>(src + (size_t)m * DM, (size_t)NGW * DM, g, dst + (size_t)m * DM, F.lane);
    for (; m < M; m += NGW) rms_rows_1024<1>(src + (size_t)m * DM, (size_t)NGW * DM, g, dst + (size_t)m * DM, F.lane);
}
__device__ __forceinline__ void pb_part(const Frame& F, const float* p, bf16* PB, int idx, int nwg) {
    const size_t n8 = (size_t)M * PLE / 8; const size_t gt = (size_t)idx * NTHR + F.tid, ngt = (size_t)nwg * NTHR;
    for (size_t i = gt; i < n8; i += ngt) { const f32x4 a = ((const GAS f32x4*)p)[2 * i], b = ((const GAS f32x4*)p)[2 * i + 1];
        u32x4 w; w.x = pk2(a.x, a.y); w.y = pk2(a.z, a.w); w.z = pk2(b.x, b.y); w.w = pk2(b.z, b.w); ((GAS u32x4*)PB)[i] = w; }
}
__device__ __forceinline__ void pb_phase(const Frame& F, const float* p, bf16* PB) {
    const size_t n8 = (size_t)M * PLE / 8; const size_t gt = (size_t)F.vcu * NTHR + F.tid, ngt = (size_t)F.G * NTHR;
    for (size_t i = gt; i < n8; i += ngt) { const f32x4 a = ((const GAS f32x4*)p)[2 * i], b = ((const GAS f32x4*)p)[2 * i + 1];
        u32x4 w; w.x = pk2(a.x, a.y); w.y = pk2(a.z, a.w); w.z = pk2(b.x, b.y); w.w = pk2(b.z, b.w); ((GAS u32x4*)PB)[i] = w; }
}
__constant__ double INVF4[4] = {1.0, 0.5623413251903491, 0.31622776601683794, 0.1778279410038923};
__constant__ double INVF10[4] = {1.0, 0.1, 0.01, 0.001};
__constant__ unsigned long long MOBA_OB[16] = {0x5fdc94e12a067b38ull, 0xe3ab421d5f6c9078ull, 0x64f81dc0e352ab79ull, 0xfa2b948ce756d013ull, 0x72cdb63954108feaull, 0xb46a83512cf09de7ull, 0x9bd32e6804ca5f17ull, 0x30186faec5794b2dull,
                                               0x97acdef8465b3012ull, 0xba12d0c5396874feull, 0x7e5c14af3d9b0268ull, 0x6a32450789b1dcefull, 0xfedc9b7864a51230ull, 0x31bfcd24e69a7850ull, 0x73c16b58d042ef9aull, 0x017563c4982fbedaull};

#define WITEMG(IDX, SUB, KK, NN, DST, RM, GK) { constexpr int cnt_ = ((KK) / 64) * ((NN) / 32); if (r < cnt_) { p0_transpose_item(as_global((const float*)AP->in[IDX]) + (SUB), (KK), (NN), Wb + (DST), scr, r, F.lane, RM, GK); continue; } r -= cnt_; }
#define WITEMP(IDX, SUB, KK, NN, DST, RM) WITEMG(IDX, SUB, KK, NN, DST, RM, (const float*)nullptr)
#define WITEM(IDX, SUB, KK, NN, DST) WITEMP(IDX, SUB, KK, NN, DST, RmPlain{})
struct RmPlain { __device__ __forceinline__ int operator()(int n) const { const int c = n & 255; return (n & ~255) + 128 * ((c >> 5) & 1) + 32 * (c >> 6) + (c & 31); } };
struct RmInE { __device__ __forceinline__ int operator()(int n) const { return perm_ine(n); } };
struct RmUq  { __device__ __forceinline__ int operator()(int n) const { return perm_uq(n); } };
struct RmUkv { __device__ __forceinline__ int operator()(int n) const { return perm_ukv(n); } };
struct RmInO { __device__ __forceinline__ int operator()(int n) const { return perm_ino(n); } };
constexpr int WITEMS_P0 = (1024 / 64) * (E_IN / 32) + (384 / 64) * (768 / 32) + (256 / 64) * (1024 / 32);
constexpr int WITEMS_TOTAL = (1024 / 64) * (E_IN / 32) + (384 / 64) * (768 / 32) + (256 / 64) * (1024 / 32) + (1024 / 64) * (1024 / 32) + (1024 / 64) * (3072 / 32) + (1024 / 64) * (1024 / 32)
                           + 2 * (1024 / 64) * (4096 / 32) + 2 * (4096 / 64) * (1024 / 32) + 2 * (1024 / 64) * (1024 / 32) + 2 * (256 / 64) * (1024 / 32);


namespace att {
typedef short bf16x8 __attribute__((ext_vector_type(8)));
typedef short s16x4 __attribute__((ext_vector_type(4)));
typedef float f32x16 __attribute__((ext_vector_type(16)));
typedef float f32x2_t __attribute__((ext_vector_type(2)));
typedef __bf16 bf16x2_t __attribute__((ext_vector_type(2)));
typedef LAS const char* lds_cptr;
constexpr int KSLOT_B = 12288, VSLOT_B = 8192;
constexpr int LDS_K = 0, LDS_V = 4 * KSLOT_B, LDS_WS = LDS_V + 3 * VSLOT_B, LDS_OST = LDS_WS + 8 * 256, LDS_ATT_BYTES = LDS_OST + 8 * 4096;
#define ATT_SBAR() __builtin_amdgcn_sched_barrier(0)
#if ATT_PROBE == 6
#define ATT_WAIT_BAR() asm volatile("s_waitcnt vmcnt(0) lgkmcnt(0)\n\ts_barrier\n\ts_barrier" ::: "memory")
#else
#define ATT_WAIT_BAR() asm volatile("s_waitcnt vmcnt(0) lgkmcnt(0)\n\ts_barrier" ::: "memory")
#endif
__device__ __forceinline__ void wait_bar_n(int n) {
    if (n <= 0)      asm volatile("s_waitcnt vmcnt(0) lgkmcnt(0)\n\ts_barrier" ::: "memory");
    else if (n == 1) asm volatile("s_waitcnt vmcnt(1) lgkmcnt(0)\n\ts_barrier" ::: "memory");
    else if (n == 2) asm volatile("s_waitcnt vmcnt(2) lgkmcnt(0)\n\ts_barrier" ::: "memory");
    else             asm volatile("s_waitcnt vmcnt(3) lgkmcnt(0)\n\ts_barrier" ::: "memory");
}
__device__ __forceinline__ int crow(int r, int hi) { return (r & 3) + 8 * (r >> 2) + 4 * hi; }
__device__ __forceinline__ void glds16(const void* gsrc, unsigned lds_dst) { unsigned keep;
    asm volatile("s_mov_b32 %0, m0\n\ts_mov_b32 m0, %2\n\ts_nop 0\n\tglobal_load_lds_dwordx4 %1, off\n\ts_mov_b32 m0, %0" : "=&s"(keep) : "v"(gsrc), "s"(lds_dst) : "memory"); }
__device__ __forceinline__ unsigned cvtpk(float lo, float hi) { f32x2_t v = {lo, hi}; bf16x2_t b = __builtin_convertvector(v, bf16x2_t); return __builtin_bit_cast(unsigned, b); }

template <int NKS> __device__ __forceinline__ void qk_tile(f32x16& p0, f32x16& p1, lds_cptr kslot, const bf16x8* qr, const f32x16& c0, const f32x16& c1, int r32, int hi) {
    lds_cptr kb = kslot + hi * 1024 + r32 * 16;
#pragma unroll
    for (int d0 = 0; d0 < NKS; ++d0) {
        const bf16x8 b0 = *(const LAS bf16x8*)(kb + d0 * 2048), b1 = *(const LAS bf16x8*)(kb + d0 * 2048 + 512);
        if (d0 == 0) { p0 = __builtin_amdgcn_mfma_f32_32x32x16_bf16(b0, qr[0], c0, 0, 0, 0); p1 = __builtin_amdgcn_mfma_f32_32x32x16_bf16(b1, qr[0], c1, 0, 0, 0); }
        else { p0 = __builtin_amdgcn_mfma_f32_32x32x16_bf16(b0, qr[d0], p0, 0, 0, 0); p1 = __builtin_amdgcn_mfma_f32_32x32x16_bf16(b1, qr[d0], p1, 0, 0, 0); }
#if ATT_PROBE == 2
        { static_assert(NKS >= 4, ""); if (d0 < 4) { f32x16 z0 = __builtin_amdgcn_mfma_f32_32x32x16_bf16(b1, qr[d0], c0, 0, 0, 0), z1 = __builtin_amdgcn_mfma_f32_32x32x16_bf16(b0, qr[d0], c1, 0, 0, 0); asm volatile("" :: "v"(z0), "v"(z1)); } }
#endif
    }
}
__device__ __forceinline__ void exp_pack(f32x16& p0, f32x16& p1, float& lsum, bf16x8 (&pa)[4]) {
    float s0 = 0.f, s1 = 0.f;
#pragma unroll
    for (int r = 0; r < 16; ++r) { p0[r] = __builtin_amdgcn_exp2f(p0[r]); p1[r] = __builtin_amdgcn_exp2f(p1[r]); s0 += p0[r]; s1 += p1[r]; }
    lsum += s0 + s1;
#if ATT_PROBE == 1
    { float dm = 0.f;
#pragma unroll
      for (int r = 0; r < 16; ++r) { dm += __builtin_amdgcn_exp2f(p0[r] * 0.5f); dm += __builtin_amdgcn_exp2f(p1[r] * 0.5f); }
      asm volatile("" :: "v"(dm)); }
#endif
    u32x4 w0, w1, w2, w3;
#pragma unroll
    for (int e = 0; e < 4; ++e) { w0[e] = cvtpk(p0[2 * e], p0[2 * e + 1]); w1[e] = cvtpk(p0[8 + 2 * e], p0[8 + 2 * e + 1]); w2[e] = cvtpk(p1[2 * e], p1[2 * e + 1]); w3[e] = cvtpk(p1[8 + 2 * e], p1[8 + 2 * e + 1]); }
    pa[0] = __builtin_bit_cast(bf16x8, w0); pa[1] = __builtin_bit_cast(bf16x8, w1); pa[2] = __builtin_bit_cast(bf16x8, w2); pa[3] = __builtin_bit_cast(bf16x8, w3);
}
struct VFrag { s16x4 lo[8], hi[8]; };
__device__ __forceinline__ void v_issue(VFrag& f, int vb) {
#pragma unroll
    for (int d0 = 0; d0 < 2; ++d0)
#pragma unroll
        for (int ks = 0; ks < 4; ++ks) {
            asm volatile("ds_read_b64_tr_b16 %0,%1 offset:%c2" : "=&v"(f.lo[d0 * 4 + ks]) : "v"(vb), "i"(d0 * 4096 + ks * 1024) : "memory");
            asm volatile("ds_read_b64_tr_b16 %0,%1 offset:%c2" : "=&v"(f.hi[d0 * 4 + ks]) : "v"(vb), "i"(d0 * 4096 + ks * 1024 + 512) : "memory"); }
}
__device__ __forceinline__ void pv_mfma(f32x16* o, VFrag& f, const bf16x8 (&pa)[4]) {
    asm volatile("s_waitcnt lgkmcnt(0)" : "+v"(f.lo[0]), "+v"(f.lo[1]), "+v"(f.lo[2]), "+v"(f.lo[3]), "+v"(f.lo[4]), "+v"(f.lo[5]), "+v"(f.lo[6]), "+v"(f.lo[7]),
                                          "+v"(f.hi[0]), "+v"(f.hi[1]), "+v"(f.hi[2]), "+v"(f.hi[3]), "+v"(f.hi[4]), "+v"(f.hi[5]), "+v"(f.hi[6]), "+v"(f.hi[7]) :: "memory");
    ATT_SBAR();
#define ATT_PK(k) (bf16x8){f.lo[k][0], f.lo[k][1], f.lo[k][2], f.lo[k][3], f.hi[k][0], f.hi[k][1], f.hi[k][2], f.hi[k][3]}
    __builtin_amdgcn_s_setprio(1);
    o[0] = __builtin_amdgcn_mfma_f32_32x32x16_bf16(pa[0], ATT_PK(0), o[0], 0, 0, 0);
    o[1] = __builtin_amdgcn_mfma_f32_32x32x16_bf16(pa[0], ATT_PK(4), o[1], 0, 0, 0);
    o[0] = __builtin_amdgcn_mfma_f32_32x32x16_bf16(pa[1], ATT_PK(1), o[0], 0, 0, 0);
    o[1] = __builtin_amdgcn_mfma_f32_32x32x16_bf16(pa[1], ATT_PK(5), o[1], 0, 0, 0);
    o[0] = __builtin_amdgcn_mfma_f32_32x32x16_bf16(pa[2], ATT_PK(2), o[0], 0, 0, 0);
    o[1] = __builtin_amdgcn_mfma_f32_32x32x16_bf16(pa[2], ATT_PK(6), o[1], 0, 0, 0);
    o[0] = __builtin_amdgcn_mfma_f32_32x32x16_bf16(pa[3], ATT_PK(3), o[0], 0, 0, 0);
    o[1] = __builtin_amdgcn_mfma_f32_32x32x16_bf16(pa[3], ATT_PK(7), o[1], 0, 0, 0);
    __builtin_amdgcn_s_setprio(0);
#undef ATT_PK
}
__device__ __forceinline__ void cmask(f32x16& p0, f32x16& p1, int kvb, int qrel, int hi) {
#pragma unroll
    for (int r = 0; r < 16; ++r) { const int kv = kvb + crow(r, hi); if (kv > qrel) p0[r] = -INFINITY; if (kv + 32 > qrel) p1[r] = -INFINITY; }
}
__device__ __forceinline__ void bmask(f32x16& p0, f32x16& p1, int kvb, int qrel, int hi) {
#pragma unroll
    for (int r = 0; r < 16; ++r) { const int d = qrel - (kvb + crow(r, hi)); if (d < 0 || d > 128) p0[r] = -INFINITY; if (d - 32 < 0 || d - 32 > 128) p1[r] = -INFINITY; }
}
#define ATT_PIN(x) asm volatile("" : "+v"(x))
__device__ __forceinline__ float pcat(const f32x16& P0, const f32x16& P1, int i) { return (i < 16) ? P0[i] : P1[i - 16]; }
__device__ __forceinline__ s16x4 vtr(lds_cptr p) { return __builtin_bit_cast(s16x4, __builtin_amdgcn_ds_read_tr16_b64_v4i16((LAS s16x4*)p)); }
__device__ __forceinline__ void kload2(bf16x8* kf, lds_cptr kp, int d0) { kf[2 * d0] = *(const LAS bf16x8*)(kp + d0 * 2048); kf[2 * d0 + 1] = *(const LAS bf16x8*)(kp + d0 * 2048 + 512); }
__device__ __forceinline__ void kload2s(bf16x8* kf, lds_cptr kb, const int* koff, int d0) { kf[2 * d0] = *(const LAS bf16x8*)(kb + koff[d0]); kf[2 * d0 + 1] = *(const LAS bf16x8*)(kb + koff[d0] + 4096); }
__device__ __forceinline__ void swz_dma_lane(int wid, int lane, int& row, int& chunk) { row = 8 * wid + (lane >> 3); chunk = (lane & 7) ^ (((lane >> 4) & 3) | ((wid & 1) << 2)); }
__device__ __forceinline__ void swz_koff(int r32, int hi, int (&koff)[4]) { const int t = ((r32 & 7) >> 1) | (((r32 >> 3) & 1) << 2), b = 128 * r32 + 16 * (hi ^ (t & 1)), x = 32 * (t >> 1);
#pragma unroll
    for (int d0 = 0; d0 < 4; ++d0) koff[d0] = b + (x ^ (32 * d0)); }
template <int NKS, bool HASPREV, bool DOQK, bool CZERO, bool MASKED, bool SWZ = false>
__device__ __forceinline__ void att_pa(f32x16& C0, f32x16& C1, const f32x16& P0, const f32x16& P1, float& lsum, bf16x8* kf, lds_cptr kcp, s16x4* vlo, s16x4* vhi, u32x4* pw, lds_cptr vp,
                                       const bf16x8* qr, int jb, int qrel, int hi, const int* roff = nullptr) {
    float sacc = 0.f;
    ATT_SBAR();
#pragma unroll
    for (int i = 0; i < (DOQK ? 2 * NKS : 8); ++i) {
        if constexpr (HASPREV) { if (i < 8) { const int f = (i >> 1) + 4 * (i & 1); vlo[f] = vtr(vp + (f >> 2) * 4096 + (f & 3) * 1024); vhi[f] = vtr(vp + (f >> 2) * 4096 + (f & 3) * 1024 + 512); ATT_SBAR(); } }
        if constexpr (DOQK) { const int d0 = i >> 1;
            if (i >= 4 && i + 4 < 2 * NKS) {
                if constexpr (SWZ) kf[i + 4] = *(const LAS bf16x8*)(kcp + roff[((i + 4) >> 1) - 4] + ((i + 4) & 1) * 2048);
                else kf[i + 4] = *(const LAS bf16x8*)(kcp + ((i + 4) >> 1) * 2048 + ((i + 4) & 1) * 512); }
            if (i & 1) { if (CZERO && d0 == 0) C1 = __builtin_amdgcn_mfma_f32_32x32x16_bf16(kf[i], qr[d0], f32x16{}, 0, 0, 0); else C1 = __builtin_amdgcn_mfma_f32_32x32x16_bf16(kf[i], qr[d0], C1, 0, 0, 0); }
            else         { if (CZERO && d0 == 0) C0 = __builtin_amdgcn_mfma_f32_32x32x16_bf16(kf[i], qr[d0], f32x16{}, 0, 0, 0); else C0 = __builtin_amdgcn_mfma_f32_32x32x16_bf16(kf[i], qr[d0], C0, 0, 0, 0); } }
        if constexpr (HASPREV) { if (i < 8) {
#pragma unroll
            for (int k = 0; k < 4; ++k) sacc += pcat(P0, P1, 4 * i + k);
            ATT_PIN(sacc);
#pragma unroll
            for (int k = 0; k < 2; ++k) { const int j = 2 * i + k; pw[j >> 2][j & 3] = cvtpk(pcat(P0, P1, 2 * j), pcat(P0, P1, 2 * j + 1)); }
            ATT_PIN(pw[(2 * i) >> 2]); } }
        ATT_SBAR();
    }
    lsum += sacc;
    if constexpr (DOQK && MASKED) cmask(C0, C1, 64 * jb, qrel, hi);
    ATT_SBAR();
}
#define ATT_FMK(d, CR, sl, base) asm volatile("v_fmamk_f32 %0, %1, %2, %3" : "=v"(d) : "v"(sl), "n"(__builtin_bit_cast(unsigned, (float)(CR))), "v"(base))
template <int NKS, bool HASPREV, bool DOQK, bool BIASNEXT, bool GL, int I, bool SWZ>
__device__ __forceinline__ void att_pb_gap(f32x16& C0, f32x16& C1, f32x16& P0, f32x16& P1, f32x16* o, bf16x8* kf, const s16x4* vlo, const s16x4* vhi, const u32x4* pw, lds_cptr knp,
                                           float sl, float basen, float base32, const int* koff) {
#define ATT_PK(k) (bf16x8){vlo[k][0], vlo[k][1], vlo[k][2], vlo[k][3], vhi[k][0], vhi[k][1], vhi[k][2], vhi[k][3]}
    constexpr int G0 = 2;
    if constexpr (GL && I >= G0 && I < G0 + 4) { if constexpr (SWZ) kload2s(kf, knp, koff, I - G0); else kload2(kf, knp, I - G0); ATT_SBAR(); }
    if constexpr (HASPREV) { constexpr int ks = I >> 1, d0 = I & 1; o[d0] = __builtin_amdgcn_mfma_f32_32x32x16_bf16(__builtin_bit_cast(bf16x8, pw[ks]), ATT_PK(d0 * 4 + ks), o[d0], 0, 0, 0); }
    if constexpr (DOQK) {
        if constexpr (I < 4) {
#pragma unroll
            for (int k = 0; k < 4; ++k) C0[4 * I + k] = __builtin_amdgcn_exp2f(C0[4 * I + k]);
            ATT_PIN(C0); }
        else {
#pragma unroll
            for (int k = 0; k < 4; ++k) C1[4 * (I - 4) + k] = __builtin_amdgcn_exp2f(C1[4 * (I - 4) + k]);
            ATT_PIN(C1); } }
    if constexpr (BIASNEXT) {
        if constexpr (I < 4) { float d0_, d1_, d2_, d3_;
            ATT_FMK(d0_, 8 * I + 0, sl, basen); ATT_FMK(d1_, 8 * I + 1, sl, basen); ATT_FMK(d2_, 8 * I + 2, sl, basen); ATT_FMK(d3_, 8 * I + 3, sl, basen);
            P0[4 * I + 0] = d0_; P0[4 * I + 1] = d1_; P0[4 * I + 2] = d2_; P0[4 * I + 3] = d3_; ATT_PIN(P0); }
        else { constexpr int J = I - 4; float d0_, d1_, d2_, d3_;
            ATT_FMK(d0_, 8 * J + 0, sl, base32); ATT_FMK(d1_, 8 * J + 1, sl, base32); ATT_FMK(d2_, 8 * J + 2, sl, base32); ATT_FMK(d3_, 8 * J + 3, sl, base32);
            P1[4 * J + 0] = d0_; P1[4 * J + 1] = d1_; P1[4 * J + 2] = d2_; P1[4 * J + 3] = d3_; ATT_PIN(P1); } }
    ATT_SBAR();
#undef ATT_PK
}
template <int NKS, bool HASPREV, bool DOQK, bool BIASNEXT, bool GL, bool SWZ = false>
__device__ __forceinline__ void att_pb(f32x16& C0, f32x16& C1, f32x16& P0, f32x16& P1, f32x16* o, bf16x8* kf, const s16x4* vlo, const s16x4* vhi, const u32x4* pw, lds_cptr knp,
                                       float sl, float basen, float step32, const int* koff = nullptr) {
    const float base32 = basen + step32;
#define ATT_GAPB(I) att_pb_gap<NKS, HASPREV, DOQK, BIASNEXT, GL, I, SWZ>(C0, C1, P0, P1, o, kf, vlo, vhi, pw, knp, sl, basen, base32, koff)
    ATT_GAPB(0); ATT_GAPB(1); ATT_GAPB(2); ATT_GAPB(3); ATT_GAPB(4); ATT_GAPB(5); ATT_GAPB(6); ATT_GAPB(7);
#undef ATT_GAPB
}
#define ATT_WAITN(n) do { if ((n) <= 0) asm volatile("s_waitcnt vmcnt(0) lgkmcnt(0)\n\ts_barrier" ::: "memory"); else if ((n) == 1) asm volatile("s_waitcnt vmcnt(1) lgkmcnt(0)\n\ts_barrier" ::: "memory"); \
        else if ((n) == 2) asm volatile("s_waitcnt vmcnt(2) lgkmcnt(0)\n\ts_barrier" ::: "memory"); else asm volatile("s_waitcnt vmcnt(3) lgkmcnt(0)\n\ts_barrier" ::: "memory"); } while (0)
__device__ __forceinline__ float finish_l(float lsum) { return sum_xor32(lsum); }
template <class RowPtr> __device__ __forceinline__ void store_o2(const f32x16* o, float ltot, LAS unsigned char* wsb, LAS unsigned char* ostb, int wid, int lane, const RowPtr& orow) {
    const int r32 = lane & 31, hi = lane >> 5;
    LAS float* wsf = (LAS float*)wsb + wid * 64;
    if (hi == 0) wsf[r32] = ltot;
    asm volatile("s_waitcnt lgkmcnt(0)" ::: "memory");
    float rli[16];
#pragma unroll
    for (int r = 0; r < 16; ++r) rli[r] = __builtin_amdgcn_rcpf(wsf[crow(r, hi)]);
    LAS bf16* stg = (LAS bf16*)ostb + wid * 2048;
#pragma unroll
    for (int r = 0; r < 16; ++r) { const int orw = crow(r, hi);
#pragma unroll
        for (int d0 = 0; d0 < 2; ++d0) stg[orw * 64 + d0 * 32 + r32] = (bf16)f2bf(o[d0][r] * rli[r]); }
    asm volatile("s_waitcnt lgkmcnt(0)" ::: "memory");
#pragma unroll
    for (int i = 0; i < 4; ++i) { const int row = i * 8 + (lane >> 3), ch = lane & 7; const u32x4 v = *(const LAS u32x4*)(stg + row * 64 + ch * 8); __builtin_nontemporal_store(v, (GAS u32x4*)(orow(row) + ch * 8)); }
}
template <class RowPtr> __device__ __forceinline__ void store_o(const f32x16* o, float ltot, LAS unsigned char* shm, int wid, int lane, const RowPtr& orow) { store_o2(o, ltot, shm + LDS_WS, shm + LDS_OST, wid, lane, orow); }
template <class RowPtrB, class RowPtrO, class RowIdx>
__device__ __forceinline__ void store_merge2(const f32x16* o, float ltot, LAS unsigned char* wsb, LAS unsigned char* ostb, int wid, int lane, const RowPtrB& ob1, const RowPtrB& ob2, const float* l1p, const float* l2p,
                                            const RowIdx& lrow, const RowPtrO& orow) {
    const int r32 = lane & 31, hi = lane >> 5;
    LAS float* wsf = (LAS float*)wsb + wid * 64;
    if (hi == 0) wsf[r32] = ltot;
    LAS float* stg = (LAS float*)ostb + wid * 1024;
#pragma unroll
    for (int d0 = 0; d0 < 2; ++d0) {
#pragma unroll
        for (int r = 0; r < 16; ++r) stg[crow(r, hi) * 32 + r32] = o[d0][r];
        asm volatile("s_waitcnt lgkmcnt(0)" ::: "memory");
#pragma unroll
        for (int i = 0; i < 2; ++i) { const int row = i * 16 + (lane >> 2), ch = lane & 3, col = d0 * 32 + ch * 8;
            const f32x4 a0 = *(const LAS f32x4*)(stg + row * 32 + ch * 8), a1 = *(const LAS f32x4*)(stg + row * 32 + ch * 8 + 4);
            const float l3 = wsf[row], l1 = ((const GAS float*)l1p)[lrow(row)], l2 = ((const GAS float*)l2p)[lrow(row)];
            const u32x4 w1 = *(const GAS u32x4*)(ob1(row) + col), w2 = *(const GAS u32x4*)(ob2(row) + col);
            const float rl = __builtin_amdgcn_rcpf(l1 + l2 + l3); u32x4 ow;
#pragma unroll
            for (int e = 0; e < 4; ++e) { const float x0 = (e < 2 ? a0[2 * e] : a1[2 * e - 4]), x1 = (e < 2 ? a0[2 * e + 1] : a1[2 * e - 3]);
                ow[e] = pk2((l1 * bf_lo(w1[e]) + l2 * bf_lo(w2[e]) + x0) * rl, (l1 * bf_hi(w1[e]) + l2 * bf_hi(w2[e]) + x1) * rl); }
            *(GAS u32x4*)(orow(row) + col) = ow; }
        asm volatile("s_waitcnt lgkmcnt(0)" ::: "memory");
    }
}
struct MergeOps { u32x4 w1[4], w2[4]; float l1[4], l2[4]; };
template <class RowPtrB, class RowIdx>
__device__ __forceinline__ void merge_load(MergeOps& m, int lane, const RowPtrB& ob1, const RowPtrB& ob2, const float* l1p, const float* l2p, const RowIdx& lrow) {
#pragma unroll
    for (int i = 0; i < 4; ++i) { const int row = i * 8 + (lane >> 3), col = (lane & 7) * 8;
        m.l1[i] = ((const GAS float*)l1p)[lrow(row)]; m.l2[i] = ((const GAS float*)l2p)[lrow(row)];
        m.w1[i] = *(const GAS u32x4*)(ob1(row) + col); m.w2[i] = *(const GAS u32x4*)(ob2(row) + col); }
}
template <class RowPtrO>
__device__ __forceinline__ void merge_finish(const f32x16* o, float ltot, LAS unsigned char* wsb, LAS unsigned char* ostb, int wid, int lane, const MergeOps& m, const RowPtrO& orow) {
    const int r32 = lane & 31, hi = lane >> 5;
    LAS float* wsf = (LAS float*)wsb + wid * 64;
    if (hi == 0) wsf[r32] = ltot;
    asm volatile("s_waitcnt lgkmcnt(0)" ::: "memory");
    float rli[16];
#pragma unroll
    for (int r = 0; r < 16; ++r) rli[r] = __builtin_amdgcn_rcpf(wsf[crow(r, hi)]);
    LAS bf16* stg = (LAS bf16*)ostb + wid * 2048;
#pragma unroll
    for (int r = 0; r < 16; ++r) { const int orw = crow(r, hi);
#pragma unroll
        for (int d0 = 0; d0 < 2; ++d0) stg[orw * 64 + d0 * 32 + r32] = (bf16)f2bf(o[d0][r] * rli[r]); }
    asm volatile("s_waitcnt lgkmcnt(0)" ::: "memory");
#pragma unroll
    for (int i = 0; i < 4; ++i) { const int row = i * 8 + (lane >> 3), ch = lane & 7;
        const u32x4 v = *(const LAS u32x4*)(stg + row * 64 + ch * 8); const float l3 = wsf[row], l1 = m.l1[i], l2 = m.l2[i];
        const u32x4 w1 = m.w1[i], w2 = m.w2[i];
        const float rl = __builtin_amdgcn_rcpf(l1 + l2 + l3); u32x4 ow;
#pragma unroll
        for (int e = 0; e < 4; ++e) ow[e] = pk2((l1 * bf_lo(w1[e]) + l2 * bf_lo(w2[e]) + l3 * bf_lo(v[e])) * rl, (l1 * bf_hi(w1[e]) + l2 * bf_hi(w2[e]) + l3 * bf_hi(v[e])) * rl);
        *(GAS u32x4*)(orow(row) + ch * 8) = ow; }
}
template <class RowPtrB, class RowPtrO, class RowIdx>
__device__ __forceinline__ void store_merge(const f32x16* o, float ltot, LAS unsigned char* shm, int wid, int lane, const RowPtrB& ob1, const RowPtrB& ob2, const float* l1p, const float* l2p,
                                            const RowIdx& lrow, const RowPtrO& orow) { store_merge2(o, ltot, shm + LDS_WS, shm + LDS_OST, wid, lane, ob1, ob2, l1p, l2p, lrow, orow); }
}


namespace att {
struct RowLin { bf16* base; size_t pitch; __device__ __forceinline__ bf16* operator()(int i) const { return base + (size_t)i * pitch; } };
#define ATT_RFL(x) ((unsigned)__builtin_amdgcn_readfirstlane((int)(x)))

__device__ __forceinline__ void mla_unit(LAS unsigned char* shm, int b, int h, int qb, const bf16* QA, const bf16* KVA, const bf16* Z, bf16* MIXED, int tid_in) {
    int tid = tid_in; asm volatile("" : "+v"(tid));
    const int lane = tid & 63, r32 = lane & 31, hi = lane >> 5; const int wid = __builtin_amdgcn_readfirstlane(tid >> 6);
    const unsigned lds0 = (unsigned)(uintptr_t)shm;
    const size_t rowbase = (size_t)b * SEQ; const int q0 = qb * 256;
    int dl_row, dl_chunk; swz_dma_lane(wid, lane, dl_row, dl_chunk); int koff[4]; swz_koff(r32, hi, koff);
    int roff[2]; { const int t_ = (r32 >> 2) & 3; roff[0] = 8192 + 64 * r32 + 16 * (hi ^ t_); roff[1] = 8192 + 64 * r32 + 16 * ((2 + hi) ^ t_); }
    const bf16* ksrcN = KVA + (rowbase + dl_row) * KVA_N + h * 128 + dl_chunk * 8;
    const bf16* ksrcR = Z + (rowbase + 16 * (wid & 3) + (lane >> 2)) * E_INP + ZC_KR + ((lane & 3) ^ ((lane >> 4) & 3)) * 8;
    const bf16* vsrc = KVA + (rowbase + 16 * (wid & 3) + (lane >> 2)) * KVA_N + h * 128 + 64 + (wid >> 2) * 32 + (lane & 3) * 8;
#define MLA_DMAK(t, slot) do { glds16(ksrcN + (size_t)(t) * 64 * KVA_N, ATT_RFL(lds0 + LDS_K + (slot) * KSLOT_B + wid * 1024)); \
        if (wid < 4) glds16(ksrcR + (size_t)(t) * 64 * E_INP, ATT_RFL(lds0 + LDS_K + (slot) * KSLOT_B + (8 + wid) * 1024)); } while (0)
#define MLA_DMAV(t, slot) glds16(vsrc + (size_t)(t) * 64 * KVA_N, ATT_RFL(lds0 + LDS_V + (slot) * VSLOT_B + wid * 1024))
    MLA_DMAK(0, 0); MLA_DMAK(1, 1); MLA_DMAV(0, 0); MLA_DMAK(2, 2);
    const bf16* Qw = QA + (rowbase + q0 + wid * 32 + r32) * QA_N + h * 96 + hi * 8;
    bf16x8 qr[6];
#pragma unroll
    for (int d0 = 0; d0 < 6; ++d0) qr[d0] = *(const GAS bf16x8*)(Qw + d0 * 16);
    f32x16 o[2]; o[0] = f32x16{}; o[1] = f32x16{}; float lsum = 0.f;
    const int NT = 4 * qb + 4, qrel = wid * 32 + r32;
    const lds_cptr vp0 = (lds_cptr)(shm + LDS_V) + ((lane >> 4) & 1) * 32 + (lane & 3) * 8 + (4 * hi + ((lane & 15) >> 2)) * 64;
    const lds_cptr ks0 = (lds_cptr)(shm + LDS_K);
    f32x16 pA0, pA1, pB0, pB1; bf16x8 kf[12]; s16x4 vlo[8], vhi[8]; u32x4 pw[4];
    const int kper = (wid < 4) ? 2 : 1;
    int sc = 0, sn = KSLOT_B, sf = 2 * KSLOT_B, sg = 3 * KSLOT_B;
    int vp = 2 * VSLOT_B, vc = 0, vn = VSLOT_B;
    ATT_WAIT_BAR();
#pragma unroll
    for (int d0 = 0; d0 < 4; ++d0) kload2s(kf, ks0, koff, d0);
#define MLA_STEP(C0, C1, P0, P1, t, HP, MSK, GK, GV, GL) do { \
        att_pa<6, HP, true, true, MSK, true>(C0, C1, P0, P1, lsum, kf, ks0 + sc, vlo, vhi, pw, vp0 + vp, qr, (t) - (NT - 4), qrel, hi, roff); \
        if (GK) MLA_DMAK((t) + 3, sg / KSLOT_B); if (GV) MLA_DMAV((t) + 1, vn / VSLOT_B); \
        att_pb<6, HP, true, false, GL, true>(C0, C1, P0, P1, o, kf, vlo, vhi, pw, ks0 + sn, 0.f, 0.f, 0.f, koff); \
        { const int n_ = ((GK) ? kper : 0) + ((GV) ? 1 : 0); ATT_WAITN(n_); } \
        { const int s_ = sc; sc = sn; sn = sf; sf = sg; sg = s_; const int v_ = vp; vp = vc; vc = vn; vn = v_; } } while (0)
    MLA_STEP(pA0, pA1, pB0, pB1, 0, false, true, true, true, true);
    int t = 1;
    for (; t + 5 < NT; t += 2) { MLA_STEP(pB0, pB1, pA0, pA1, t, true, false, true, true, true); MLA_STEP(pA0, pA1, pB0, pB1, t + 1, true, false, true, true, true); }
    for (; t + 1 < NT; t += 2) { MLA_STEP(pB0, pB1, pA0, pA1, t, true, true, (t + 3 < NT), true, true); MLA_STEP(pA0, pA1, pB0, pB1, t + 1, true, true, (t + 4 < NT), true, true); }
    MLA_STEP(pB0, pB1, pA0, pA1, NT - 1, true, true, false, false, false);
    att_pa<6, true, false, true, false, true>(pA0, pA1, pB0, pB1, lsum, kf, ks0 + sc, vlo, vhi, pw, vp0 + vp, qr, -1, qrel, hi, roff);
    att_pb<6, true, false, false, false, true>(pA0, pA1, pB0, pB1, o, kf, vlo, vhi, pw, ks0, 0.f, 0.f, 0.f, koff);
#undef MLA_STEP
#undef MLA_DMAK
#undef MLA_DMAV
    const float ltot = finish_l(lsum);
    store_o(o, ltot, shm, wid, lane, RowLin{MIXED + (rowbase + q0 + wid * 32) * DM + h * 64, (size_t)DM});
    asm volatile("s_waitcnt lgkmcnt(0)\n\ts_barrier" ::: "memory");
}

struct RowCLin { const bf16* base; size_t pitch; __device__ __forceinline__ const bf16* operator()(int i) const { return base + (size_t)i * pitch; } };
struct RowIdxLin { size_t base, pitch; __device__ __forceinline__ size_t operator()(int i) const { return base + (size_t)i * pitch; } };
__device__ __forceinline__ void dil_unit(LAS unsigned char* shm, int b, int h, int br, int rcls, int qb, const bf16* Z, bf16* OB, float* LSE, bf16* MIXED, int tid_in) {
    int tid = tid_in; asm volatile("" : "+v"(tid));
    const int lane = tid & 63, r32 = lane & 31, hi = lane >> 5; const int wid = __builtin_amdgcn_readfirstlane(tid >> 6);
    const unsigned lds0 = (unsigned)(uintptr_t)shm;
    const int dil = 1 << (2 * br);
    const long rowbase = (long)b * SEQ + rcls; const int q0 = qb * 256, kt0 = q0 - 128;
    const bf16* ksrc = Z + (rowbase + (long)dil * (kt0 + lane)) * E_INP + ZC_KB + h * 64 + wid * 8;
    const bf16* vsrc = Z + (rowbase + (long)dil * (kt0 + 16 * (wid & 3) + (lane >> 2))) * E_INP + ZC_VB + h * 64 + (wid >> 2) * 32 + (lane & 3) * 8;
    const long tstep = (long)dil * 64 * E_INP;
#define DIL_DMA(t, slot) do { glds16(ksrc + (long)(t) * tstep, ATT_RFL(lds0 + LDS_K + (slot) * KSLOT_B + wid * 1024)); \
        glds16(vsrc + (long)(t) * tstep, ATT_RFL(lds0 + LDS_V + (slot) * VSLOT_B + wid * 1024)); } while (0)
    const int tstart = (qb == 0) ? 2 : 0;
    DIL_DMA(tstart, tstart & 1);
    const bf16* Qw = Z + (rowbase + (long)dil * (q0 + wid * 32 + r32)) * E_INP + ZC_QB + h * 64 + hi * 8;
    bf16x8 qr[4];
#pragma unroll
    for (int d0 = 0; d0 < 4; ++d0) qr[d0] = *(const GAS bf16x8*)(Qw + d0 * 16);
    f32x16 o[2]; o[0] = f32x16{}; o[1] = f32x16{}; float lsum = 0.f;
    const float sd = __builtin_amdgcn_exp2f(-(float)(h + 1)) * LOG2E * (float)dil;
    f32x16 av;
#pragma unroll
    for (int r = 0; r < 16; ++r) av[r] = sd * (float)crow(r, hi);
    const int qrel = wid * 32 + r32;
    const int vb0 = (int)(lds0 + LDS_V) + ((lane >> 4) & 1) * 32 + (lane & 3) * 8 + (4 * hi + ((lane & 15) >> 2)) * 64;
    for (int t = tstart; t < 6; ++t) {
        ATT_WAIT_BAR();
        if (t + 1 < 6) DIL_DMA(t + 1, (t + 1) & 1);
        const int tl = wid >> 1;
        if (t >= tl && t <= tl + 2) {
            const int kvb = 64 * t - 128; const float base0 = sd * (float)(kvb - qrel);
            f32x16 c0, c1;
#pragma unroll
            for (int r = 0; r < 16; ++r) { c0[r] = av[r] + base0; c1[r] = c0[r] + 32.f * sd; }
            f32x16 p0, p1; qk_tile<4>(p0, p1, (lds_cptr)(shm + LDS_K + (t & 1) * KSLOT_B), qr, c0, c1, r32, hi);
            VFrag vf; v_issue(vf, vb0 + (t & 1) * VSLOT_B);
            bmask(p0, p1, kvb, qrel, hi);
            bf16x8 pa[4]; exp_pack(p0, p1, lsum, pa);
            pv_mfma(o, vf, pa);
        }
    }
#undef DIL_DMA
    const float ltot = finish_l(lsum);
    const long orow0 = rowbase + (long)dil * (q0 + wid * 32);
    if (br < 2) {
        store_o(o, ltot, shm, wid, lane, RowLin{OB + (size_t)br * M * 512 + (size_t)orow0 * 512 + h * 64, (size_t)dil * 512});
        if (hi == 0) ((GAS float*)LSE)[(size_t)br * M * 8 + (size_t)(orow0 + (long)dil * r32) * 8 + h] = ltot;
    } else {
        store_merge(o, ltot, shm, wid, lane, RowCLin{OB + (size_t)orow0 * 512 + h * 64, (size_t)dil * 512}, RowCLin{OB + (size_t)M * 512 + (size_t)orow0 * 512 + h * 64, (size_t)dil * 512},
                    LSE, LSE + (size_t)M * 8, RowIdxLin{(size_t)orow0 * 8 + h, (size_t)dil * 8}, RowLin{MIXED + (size_t)orow0 * DM + 512 + h * 64, (size_t)dil * DM});
    }
    asm volatile("s_waitcnt lgkmcnt(0)\n\ts_barrier" ::: "memory");
}

constexpr int DSLOT_B = 24576, DLDS_OST = 4 * DSLOT_B, DLDS_WS = 135168;
struct DilS { int b, h, br, rcls, R0, R1; };
__device__ __forceinline__ bool dil_get(int list, int u, DilS& d) {
    if (list == 0) { if (u >= 512) return false;
        if (u < 256) { d.b = u >> 5; d.h = (u >> 2) & 7; d.br = 0; d.rcls = 0; d.R0 = 16 * (u & 3); d.R1 = d.R0 + 16; }
        else { const int v = u - 256; d.b = v >> 5; d.h = (v >> 2) & 7; d.br = 1; d.rcls = v & 3; d.R0 = 0; d.R1 = 16; } }
    else { if (u >= 1024) return false; d.b = u >> 7; d.h = (u >> 4) & 7; d.br = 2; d.rcls = u & 15; d.R0 = 0; d.R1 = 4; }
    return true;
}
#define DIL_WAITN(n) do { const int n_ = (n); \
        if (n_ <= 0) asm volatile("s_waitcnt vmcnt(0) lgkmcnt(0)\n\ts_barrier" ::: "memory"); else if (n_ == 1) asm volatile("s_waitcnt vmcnt(1) lgkmcnt(0)\n\ts_barrier" ::: "memory"); \
        else if (n_ == 2) asm volatile("s_waitcnt vmcnt(2) lgkmcnt(0)\n\ts_barrier" ::: "memory"); else if (n_ == 3) asm volatile("s_waitcnt vmcnt(3) lgkmcnt(0)\n\ts_barrier" ::: "memory"); \
        else if (n_ == 4) asm volatile("s_waitcnt vmcnt(4) lgkmcnt(0)\n\ts_barrier" ::: "memory"); else if (n_ == 5) asm volatile("s_waitcnt vmcnt(5) lgkmcnt(0)\n\ts_barrier" ::: "memory"); \
        else asm volatile("s_waitcnt vmcnt(6) lgkmcnt(0)\n\ts_barrier" ::: "memory"); } while (0)
__device__ __forceinline__ void dil_stream(LAS unsigned char* shm, int list, int vcu, int G, const bf16* Z, bf16* OB, float* LSE, bf16* MIXED, int tid_in) {
    int tid = tid_in; asm volatile("" : "+v"(tid));
    const int lane = tid & 63, r32 = lane & 31, hi = lane >> 5; const int wid = __builtin_amdgcn_readfirstlane(tid >> 6);
    const int pr = wid >> 1, sub = wid & 1;
    const unsigned lds0 = (unsigned)(uintptr_t)shm;
    DilS Dp; int kp = 0; bool okp = dil_get(list, vcu, Dp); int Tp = Dp.R0 - 2;
    if (!okp) return;
    DilS Dc = Dp; int kc = 0; bool okc = true; int Tc = Tp;
    const int dl_row = 8 * wid + (lane >> 3), dl_chunk = (lane & 7) ^ (((lane >> 4) & 3) | ((wid & 1) << 2));
    int koff[4];
    { const int t_ = ((r32 & 7) >> 1) | (((r32 >> 3) & 1) << 2), b_ = 128 * r32 + 16 * (hi ^ (t_ & 1)), x_ = 32 * (t_ >> 1);
#pragma unroll
      for (int d0 = 0; d0 < 4; ++d0) koff[d0] = b_ + (x_ ^ (32 * d0)); }
#define DIL_ISSUE(slot_, pcs_) do { pcs_ = 0; if (okp) { const int dil_ = 1 << (2 * Dp.br); const long rb_ = (long)Dp.b * SEQ + Dp.rcls; const unsigned sb_ = lds0 + (slot_) * DSLOT_B + wid * 1024; \
            if (Tp >= 0) { glds16(Z + (rb_ + (long)dil_ * (64 * Tp + dl_row)) * E_INP + ZC_KB + Dp.h * 64 + dl_chunk * 8, ATT_RFL(sb_)); \
                           glds16(Z + (rb_ + (long)dil_ * (64 * Tp + 16 * (wid & 3) + (lane >> 2))) * E_INP + ZC_VB + Dp.h * 64 + (wid >> 2) * 32 + (lane & 3) * 8, ATT_RFL(sb_ + 8192)); pcs_ += 2; } \
            if (Tp + 2 < Dp.R1) { glds16(Z + (rb_ + (long)dil_ * (64 * (Tp + 2) + dl_row)) * E_INP + ZC_QB + Dp.h * 64 + dl_chunk * 8, ATT_RFL(sb_ + 16384)); pcs_ += 1; } \
            if (++Tp >= Dp.R1) { ++kp; okp = dil_get(list, vcu + kp * G, Dp); Tp = Dp.R0 - 2; } } } while (0)
    int pc0, pc1, pc2; DIL_ISSUE(0, pc0); DIL_ISSUE(1, pc1); DIL_ISSUE(2, pc2); (void)pc0;
    bf16x8 qr[4]; f32x16 o[2]; float lsum = 0.f, sd = 0.f;
#pragma unroll
    for (int d0 = 0; d0 < 4; ++d0) qr[d0] = bf16x8{};
    o[0] = f32x16{}; o[1] = f32x16{};
    bool pend = false; int eb = 0, eh = 0, ebr = 0, ercls = 0, eR = 0;
    MergeOps mo;
#pragma unroll
    for (int i = 0; i < 4; ++i) { mo.w1[i] = u32x4{}; mo.w2[i] = u32x4{}; mo.l1[i] = 0.f; mo.l2[i] = 0.f; }
    const int vb0 = (int)lds0 + 8192 + ((lane >> 4) & 1) * 32 + (lane & 3) * 8 + (4 * hi + ((lane & 15) >> 2)) * 64;
#define DIL_EPI() do { const float ltot = finish_l(lsum); const int dil_ = 1 << (2 * ebr); const long orow0 = (long)eb * SEQ + ercls + (long)dil_ * (64 * eR + 32 * sub); \
        if (ebr < 2) { store_o2(o, ltot, shm + DLDS_WS, shm + DLDS_OST, wid, lane, RowLin{OB + (size_t)ebr * M * 512 + (size_t)orow0 * 512 + eh * 64, (size_t)dil_ * 512}); \
            if (hi == 0) ((GAS float*)LSE)[(size_t)ebr * M * 8 + (size_t)(orow0 + (long)dil_ * r32) * 8 + eh] = ltot; } \
        else merge_finish(o, ltot, shm + DLDS_WS, shm + DLDS_OST, wid, lane, mo, RowLin{MIXED + (size_t)orow0 * DM + 512 + eh * 64, (size_t)dil_ * DM}); \
        pend = false; } while (0)
    int slot = 0;
    while (okc) {
        DIL_WAITN(pc1 + pc2);
        const int T = Tc, dd = (pr - T) & 3, R = T + dd;
        const bool act = (dd <= 2) && (R >= Dc.R0) && (R < Dc.R1);
        if (pend && (!act || dd == 2)) { DIL_EPI(); int pc3; DIL_ISSUE((slot + 3) & 3, pc3); pc1 = pc2; pc2 = pc3; }
        else { int pc3; DIL_ISSUE((slot + 3) & 3, pc3); pc1 = pc2; pc2 = pc3; }
        if (act) {
            LAS unsigned char* const sl_ = shm + slot * DSLOT_B;
            if (dd == 2) {
                lds_cptr qp = (lds_cptr)(sl_ + 16384) + 4096 * sub;
#pragma unroll
                for (int d0 = 0; d0 < 4; ++d0) qr[d0] = *(const LAS bf16x8*)(qp + koff[d0]);
                o[0] = f32x16{}; o[1] = f32x16{}; lsum = 0.f;
                sd = __builtin_amdgcn_exp2f(-(float)(Dc.h + 1)) * LOG2E * (float)(1 << (2 * Dc.br)); }
            if (dd == 0 && Dc.br == 2) {
                const int dil_ = 16; const long orow0 = (long)Dc.b * SEQ + Dc.rcls + (long)dil_ * (64 * R + 32 * sub);
                merge_load(mo, lane, RowCLin{OB + (size_t)orow0 * 512 + Dc.h * 64, (size_t)dil_ * 512}, RowCLin{OB + (size_t)M * 512 + (size_t)orow0 * 512 + Dc.h * 64, (size_t)dil_ * 512},
                           LSE, LSE + (size_t)M * 8, RowIdxLin{(size_t)orow0 * 8 + Dc.h, (size_t)dil_ * 8}); }
            if (T >= 0) {
                const int qrel = 64 * dd + 32 * sub + r32; const float base0 = -sd * (float)qrel;
                f32x16 c0, c1;
#pragma unroll
                for (int r = 0; r < 16; ++r) { c0[r] = __builtin_fmaf(sd, (float)crow(r, hi), base0); c1[r] = c0[r] + 32.f * sd; }
                f32x16 p0, p1;
#pragma unroll
                for (int d0 = 0; d0 < 4; ++d0) { const bf16x8 b0 = *(const LAS bf16x8*)((lds_cptr)sl_ + koff[d0]), b1 = *(const LAS bf16x8*)((lds_cptr)sl_ + koff[d0] + 4096);
                    if (d0 == 0) { p0 = __builtin_amdgcn_mfma_f32_32x32x16_bf16(b0, qr[0], c0, 0, 0, 0); p1 = __builtin_amdgcn_mfma_f32_32x32x16_bf16(b1, qr[0], c1, 0, 0, 0); }
                    else { p0 = __builtin_amdgcn_mfma_f32_32x32x16_bf16(b0, qr[d0], p0, 0, 0, 0); p1 = __builtin_amdgcn_mfma_f32_32x32x16_bf16(b1, qr[d0], p1, 0, 0, 0); } }
                VFrag vf; v_issue(vf, vb0 + slot * DSLOT_B);
                if (dd != 1) bmask(p0, p1, 0, qrel, hi);
                bf16x8 pa[4]; exp_pack(p0, p1, lsum, pa);
                pv_mfma(o, vf, pa);
            }
            if (dd == 0) { pend = true; eb = Dc.b; eh = Dc.h; ebr = Dc.br; ercls = Dc.rcls; eR = R; }
        }
        if (++Tc >= Dc.R1) { ++kc; okc = dil_get(list, vcu + kc * G, Dc); Tc = Dc.R0 - 2; }
        slot = (slot + 1) & 3;
    }
    if (pend) DIL_EPI();
    asm volatile("s_waitcnt vmcnt(0) lgkmcnt(0)\n\ts_barrier" ::: "memory");
#undef DIL_ISSUE
#undef DIL_EPI
}

__device__ __forceinline__ float moba_bound(const float* g_q, const float* g_k, int tid) {
    const int lane = tid & 63;
    float gq = __builtin_fabsf(((const GAS float*)g_q)[lane]), gk = __builtin_fabsf(((const GAS float*)g_k)[lane]);
#define MOBA_WMAX(v) do { v = __builtin_fmaxf(v, swz_xor<1>(v)); v = __builtin_fmaxf(v, swz_xor<2>(v)); v = __builtin_fmaxf(v, swz_xor<4>(v)); v = __builtin_fmaxf(v, swz_xor<8>(v)); v = __builtin_fmaxf(v, swz_xor<16>(v)); v = __builtin_fmaxf(v, get_xor32(v, lane < 32)); } while (0)
    MOBA_WMAX(gq); MOBA_WMAX(gk);
#undef MOBA_WMAX
    return 96.f + 2.f * (8.f * gq * gk * LOG2E);
}
__device__ __forceinline__ int moba_ts(int h, int ob, float dnum) {
    const float sl = __builtin_amdgcn_exp2f(-0.5f * (float)(h + 1)) * LOG2E, dskip = dnum / sl;
    const float tf = __builtin_floorf(((float)(256 * ob - 63) - dskip) * (1.f / 64.f)) + 1.f;
    int t0 = (tf > 0.f) ? (int)tf : 0; t0 &= ~1;
#if ATT_PROBE == 7
    t0 = 0;
#endif
    return __builtin_amdgcn_readfirstlane(t0);
}
struct Ring { int sc, sn, sf, sg, vp, vc, vn; };
__device__ __forceinline__ void moba_unit(LAS unsigned char* shm, int b, int h, int ob, const bf16* QKV, const float* KMEAN, bf16* MIXED, float dnum, int tid_in, Ring& rg, bool pre, bool hasn, int nb, int nh, int nob) {
    int tid = tid_in; asm volatile("" : "+v"(tid));
    const int lane = tid & 63, r32 = lane & 31, hi = lane >> 5; const int wid = __builtin_amdgcn_readfirstlane(tid >> 6);
    const unsigned lds0 = (unsigned)(uintptr_t)shm;
    const size_t rowbase = (size_t)b * SEQ; const int q0 = ob * 256;
    int dl_row, dl_chunk; swz_dma_lane(wid, lane, dl_row, dl_chunk); int koff[4]; swz_koff(r32, hi, koff);
    const bf16* ksrc = QKV + (rowbase + dl_row) * QKV_N + 1024 + h * 64 + dl_chunk * 8;
    const bf16* vsrc = QKV + (rowbase + 16 * (wid & 3) + (lane >> 2)) * QKV_N + 2048 + h * 64 + (wid >> 2) * 32 + (lane & 3) * 8;
#if ATT_PROBE == 5
#define MOBA_DMAK(t, slot) do { glds16(ksrc + (size_t)(t) * 64 * QKV_N, ATT_RFL(lds0 + LDS_K + (slot) * KSLOT_B + wid * 1024)); glds16(ksrc + (size_t)(t) * 64 * QKV_N, ATT_RFL(lds0 + LDS_K + (slot) * KSLOT_B + wid * 1024)); } while (0)
#else
#define MOBA_DMAK(t, slot) glds16(ksrc + (size_t)(t) * 64 * QKV_N, ATT_RFL(lds0 + LDS_K + (slot) * KSLOT_B + wid * 1024))
#endif
#define MOBA_DMAV(t, slot) glds16(vsrc + (size_t)(t) * 64 * QKV_N, ATT_RFL(lds0 + LDS_V + (slot) * VSLOT_B + wid * 1024))
    const float sl = __builtin_amdgcn_exp2f(-0.5f * (float)(h + 1)) * LOG2E;
    const int ts = moba_ts(h, ob, dnum);
    int sc, sn, sf, sg, vp, vc, vn;
    if (pre) { sc = rg.sc; sn = rg.sn; sf = rg.sf; sg = rg.sg; vp = rg.vp; vc = rg.vc; vn = rg.vn; }
    else { sc = 0; sn = KSLOT_B; sf = 2 * KSLOT_B; sg = 3 * KSLOT_B; vp = 2 * VSLOT_B; vc = 0; vn = VSLOT_B;
           MOBA_DMAK(ts, 0); MOBA_DMAK(ts + 1, 1); MOBA_DMAV(ts, 0); MOBA_DMAK(ts + 2, 2); }
    const int tsn = hasn ? moba_ts(nh, nob, dnum) : 0;
    const bf16* ksrcn = QKV + ((size_t)nb * SEQ + dl_row) * QKV_N + 1024 + nh * 64 + dl_chunk * 8;
    const bf16* vsrcn = QKV + ((size_t)nb * SEQ + 16 * (wid & 3) + (lane >> 2)) * QKV_N + 2048 + nh * 64 + (wid >> 2) * 32 + (lane & 3) * 8;
#define MOBA_DMAKN(tt, slot) glds16(ksrcn + (size_t)(tt) * 64 * QKV_N, ATT_RFL(lds0 + LDS_K + (slot) * KSLOT_B + wid * 1024))
#define MOBA_DMAVN(tt, slot) glds16(vsrcn + (size_t)(tt) * 64 * QKV_N, ATT_RFL(lds0 + LDS_V + (slot) * VSLOT_B + wid * 1024))
    f32x4 kma[4], kmb[4];
    if (ob > 0) { const float* km = KMEAN + ((size_t)(b * 16 + h) * 16 + (r32 & 15)) * 64 + 8 * hi;
#pragma unroll
        for (int d0 = 0; d0 < 4; ++d0) { kma[d0] = *(const GAS f32x4*)(km + 16 * d0); kmb[d0] = *(const GAS f32x4*)(km + 16 * d0 + 4); } }
    const int qst = (wid < 4) ? (LDS_K + wid * KSLOT_B + 8192) : (LDS_ATT_BYTES + (wid - 4) * 4096);
    bf16x8 qr[4];
    if (pre) { asm volatile("s_waitcnt vmcnt(0)" ::: "memory");
#pragma unroll
        for (int d0 = 0; d0 < 4; ++d0) qr[d0] = *(const LAS bf16x8*)((lds_cptr)shm + qst + koff[d0]); }
    else { const bf16* Qw = QKV + (rowbase + q0 + wid * 32 + r32) * QKV_N + h * 64 + hi * 8;
#pragma unroll
        for (int d0 = 0; d0 < 4; ++d0) qr[d0] = *(const GAS bf16x8*)(Qw + d0 * 16); }
    unsigned selmask = 0u;
#if ATT_PROBE == 8
    for (int rep_ = 0; rep_ < 2; ++rep_)
#endif
    if (ob > 0) {
        f32x16 gt = f32x16{};
#pragma unroll
        for (int d0 = 0; d0 < 4; ++d0) { const f32x4 ka = kma[d0], kb = kmb[d0]; u32x4 wh, wl;
            wh[0] = pk2(ka[0], ka[1]); wh[1] = pk2(ka[2], ka[3]); wh[2] = pk2(kb[0], kb[1]); wh[3] = pk2(kb[2], kb[3]);
            wl[0] = pk2(ka[0] - bf_lo(wh[0]), ka[1] - bf_hi(wh[0])); wl[1] = pk2(ka[2] - bf_lo(wh[1]), ka[3] - bf_hi(wh[1]));
            wl[2] = pk2(kb[0] - bf_lo(wh[2]), kb[1] - bf_hi(wh[2])); wl[3] = pk2(kb[2] - bf_lo(wh[3]), kb[3] - bf_hi(wh[3]));
            gt = __builtin_amdgcn_mfma_f32_32x32x16_bf16(__builtin_bit_cast(bf16x8, wh), qr[d0], gt, 0, 0, 0);
            gt = __builtin_amdgcn_mfma_f32_32x32x16_bf16(__builtin_bit_cast(bf16x8, wl), qr[d0], gt, 0, 0, 0); }
        float G[16];
#pragma unroll
        for (int r = 0; r < 8; ++r) { auto rr = __builtin_amdgcn_permlane32_swap(__float_as_uint(gt[r]), __float_as_uint(gt[r]), false, false);
            G[(r & 3) + 8 * (r >> 2)] = __uint_as_float(rr[0]); G[(r & 3) + 8 * (r >> 2) + 4] = __uint_as_float(rr[1]); }
        float v0 = -INFINITY, v1 = -INFINITY, v2 = -INFINITY; int i0 = -1, i1 = -1, i2 = -1;
#pragma unroll
        for (int n = 0; n < 15; ++n) if (n < ob) { const float g = G[n];
            if (g > v0) { v2 = v1; i2 = i1; v1 = v0; i1 = i0; v0 = g; i0 = n; } else if (g > v1) { v2 = v1; i2 = i1; v1 = g; i1 = n; } else if (g > v2) { v2 = g; i2 = n; } }
        selmask = 0u; if (i0 >= 0) selmask |= 1u << i0; if (i1 >= 0) selmask |= 1u << i1; if (i2 >= 0) selmask |= 1u << i2;
#if ATT_PROBE == 8
        asm volatile("" : "+v"(selmask), "+v"(qr[0]), "+v"(qr[1]), "+v"(qr[2]), "+v"(qr[3]));
#endif
    }
    f32x16 o[2]; o[0] = f32x16{}; o[1] = f32x16{}; float lsum = 0.f;
    const int NT = 4 * ob + 4, qrel = wid * 32 + r32, tq = q0 + qrel;
    const lds_cptr vp0 = (lds_cptr)(shm + LDS_V) + ((lane >> 4) & 1) * 32 + (lane & 3) * 8 + (4 * hi + ((lane & 15) >> 2)) * 64;
    const lds_cptr kp0 = (lds_cptr)(shm + LDS_K) + hi * 1024 + r32 * 16, ks0 = (lds_cptr)(shm + LDS_K);
    f32x16 pA0, pA1, pB0, pB1; bf16x8 kf[8]; s16x4 vlo[8], vhi[8]; u32x4 pw[4];
#define MOBA_BASE(tt) ((((tt) >= NT - 4) || (((selmask >> ((tt) >> 2)) & 1u) != 0u)) ? 0.f : -INFINITY) + sl * (float)(64 * (tt) - tq + 4 * hi)
    { const float b0_ = MOBA_BASE(ts);
#pragma unroll
      for (int r = 0; r < 16; ++r) { pA0[r] = __builtin_fmaf(sl, (float)crow(r, 0), b0_); pA1[r] = pA0[r] + 32.f * sl; } }
    ATT_WAIT_BAR();
#pragma unroll
    for (int d0 = 0; d0 < 4; ++d0) kload2s(kf, ks0 + sc, koff, d0);
#define MOBA_STEP(C0, C1, P0, P1, t, HP, MSK, GK, GV, GL) do { \
        att_pa<4, HP, true, false, MSK>(C0, C1, P0, P1, lsum, kf, kp0 + sc, vlo, vhi, pw, vp0 + vp, qr, (t) - (NT - 4), qrel, hi); \
        int n_ = 0; \
        if (GK) { MOBA_DMAK((t) + 3, sg / KSLOT_B); n_ += 1; } else if (hasn) { MOBA_DMAKN(tsn + ((t) + 3 - NT), sg / KSLOT_B); n_ += 1; } \
        if (GV) { MOBA_DMAV((t) + 1, vn / VSLOT_B); n_ += 1; } else if (hasn) { MOBA_DMAVN(tsn, vn / VSLOT_B); n_ += 1; } \
        { const float bn_ = MOBA_BASE((t) + 1); \
          att_pb<4, HP, true, true, GL, true>(C0, C1, P0, P1, o, kf, vlo, vhi, pw, ks0 + sn, sl, bn_, 32.f * sl, koff); } \
        ATT_WAITN(n_); \
        { const int s_ = sc; sc = sn; sn = sf; sf = sg; sg = s_; const int v_ = vp; vp = vc; vc = vn; vn = v_; } } while (0)
    MOBA_STEP(pA0, pA1, pB0, pB1, ts, false, true, true, true, true);
    int t = ts + 1;
#if ATT_PROBE != 9
    for (; t + 5 < NT; t += 2) { MOBA_STEP(pB0, pB1, pA0, pA1, t, true, false, true, true, true); MOBA_STEP(pA0, pA1, pB0, pB1, t + 1, true, false, true, true, true); }
#endif
    for (; t + 1 < NT; t += 2) { MOBA_STEP(pB0, pB1, pA0, pA1, t, true, true, (t + 3 < NT), true, true); MOBA_STEP(pA0, pA1, pB0, pB1, t + 1, true, true, (t + 4 < NT), true, true); }
    MOBA_STEP(pB0, pB1, pA0, pA1, NT - 1, true, true, false, false, false);
    if (hasn) { const bf16* qn = QKV + ((size_t)nb * SEQ + 256 * nob + wid * 32 + (lane >> 3)) * QKV_N + nh * 64;
#pragma unroll
        for (int j = 0; j < 4; ++j) { const int ch = (lane & 7) ^ (((lane >> 4) & 3) | ((j & 1) << 2)); glds16(qn + (size_t)(8 * j) * QKV_N + ch * 8, ATT_RFL(lds0 + qst + j * 1024)); } }
    att_pa<4, true, false, false, false>(pA0, pA1, pB0, pB1, lsum, kf, kp0 + sc, vlo, vhi, pw, vp0 + vp, qr, -1, qrel, hi);
    att_pb<4, true, false, false, false, true>(pA0, pA1, pB0, pB1, o, kf, vlo, vhi, pw, ks0, 0.f, 0.f, 0.f, koff);
    rg.sc = sc; rg.sn = sn; rg.sf = sf; rg.sg = sg; rg.vp = vp; rg.vc = vc; rg.vn = vn;
#undef MOBA_BASE
#undef MOBA_STEP
#undef MOBA_DMAK
#undef MOBA_DMAV
#undef MOBA_DMAKN
#undef MOBA_DMAVN
    const float ltot = finish_l(lsum);
    store_o(o, ltot, shm, wid, lane, RowLin{MIXED + (rowbase + q0 + wid * 32) * DM + h * 64, (size_t)DM});
    asm volatile("s_waitcnt lgkmcnt(0)\n\ts_barrier" ::: "memory");
}
}

constexpr unsigned PH_ACTIVE = (1u << 0) | (1u << 1) | (1u << 3) | (1u << 5) | (1u << 6) | (1u << 7) | (1u << 9) | (1u << 10) | (1u << 12) | (1u << 14) | (1u << 17) | (1u << 18) | (1u << 20) | (1u << 21) | (1u << 23);
__global__ void __launch_bounds__(NTHR, 2) trunk_fwd(Args args) {
    extern __shared__ __attribute__((aligned(16))) unsigned char lds_raw[];
    Frame F;
    F.lds = (LAS unsigned char*)lds_raw;
    F.tid = threadIdx.x; F.lane = F.tid & 63; F.wave = __builtin_amdgcn_readfirstlane(F.tid >> 6);
    F.G = gridDim.x; { const int bx = blockIdx.x; F.vcu = (F.G % 8 == 0) ? (bx % 8) * (F.G / 8) + bx / 8 : bx; }
    F.ws = args.ws; F.H = args.out;
    gu32* const ctl = (gu32*)(args.ws + WS_CTL);
    volatile LAS unsigned* MISC = (volatile LAS unsigned*)(F.lds + MISC_OFF);
    for (int u = F.tid; u < (LDS_BYTES - LDSCTL_OFF) / 4; u += NTHR) ((LAS unsigned*)(F.lds + LDSCTL_OFF))[u] = 0u;
    __syncthreads();
#if MK_ONE_LAUNCH
    XcdBarrier bar = xcd_barrier_post((unsigned*)ctl + CW_BAR, MISC + 8);
#define GRID_BAR() xcd_barrier(bar)
#else
    (void)MISC; (void)ctl;
#define GRID_BAR() do {} while (0)
#endif
    bool first = true; const int lo = args.ph_lo, hi = args.ph_hi;
#define PHASE_ROOTS \
        { int t_ = threadIdx.x; asm volatile("" : "+v"(t_)); F.tid = t_; F.lane = t_ & 63; F.wave = __builtin_amdgcn_readfirstlane(t_ >> 6); \
          int v_ = F.vcu; asm volatile("" : "+s"(v_)); F.vcu = v_; } \
        const int gw = F.vcu * NWAVES + F.wave, NGW = F.G * NWAVES; \
        typedef const __attribute__((address_space(4))) Args CArgs; CArgs* AP = (CArgs*)__builtin_amdgcn_kernarg_segment_ptr(); asm volatile("" : "+s"(AP)); \
        unsigned char* ws = AP->ws; asm volatile("" : "+s"(ws)); ws = as_global(ws); \
        bf16* const Wb = (bf16*)(ws + WS_W); \
        float* const ROPE = (float*)(ws + WS_ROPE); \
        float* const KMEAN = (float*)(ws + WS_KMEAN); \
        float* const SSA = (float*)(ws + WS_SSA); float* const SSB = (float*)(ws + WS_SSB); \
        float* const SSQ = (float*)(ws + WS_SSQ); float* const SSKV = (float*)(ws + WS_SSKV); \
        bf16* const XNA = (bf16*)(ws + WS_XNA); bf16* const XM1 = (bf16*)(ws + WS_XM1); bf16* const MIXED = (bf16*)(ws + WS_MIXED); \
        bf16* const PB = (bf16*)(ws + WS_PB); bf16* const PP = (bf16*)(ws + WS_PP); \
        bf16* const Z = (bf16*)(ws + WS_Z); bf16* const QA = (bf16*)(ws + WS_QA); bf16* const KVA = (bf16*)(ws + WS_KVA); \
        bf16* const U = (bf16*)(ws + WS_U); bf16* const QKV = (bf16*)(ws + WS_QKV); \
        float* const H = as_global((float*)AP->out); \
        const float* const X = as_global((const float*)AP->in[I_X]);
#if PROBE_MASK
#define PHASE_ENTER(k) if (!first) GRID_BAR(); first = false; for (int rep_ = (((PROBE_MASK >> (k)) & 1u) ? 2 : 1); rep_ > 0; --rep_) { if (rep_ == 1 && ((PROBE_MASK >> (k)) & 1u)) GRID_BAR(); PHASE_ROOTS
#define PHASE_LEAVE }
#else
#define PHASE_ENTER(k) if (!first) GRID_BAR(); first = false; { PHASE_ROOTS
#define PHASE_LEAVE }
#endif
    if (lo <= 0 && 0 < hi) { PHASE_ENTER(0)
        {{
            LAS float* scr = (LAS float*)(F.lds + F.wave * 16384);
            for (int it = gw; it < WITEMS_P0; it += NGW) {
                int r = it;
                WITEMP(I_EWIN, 0, 1024, E_IN, W_INE, RmInE{})
                WITEMP(I_EWUQ, 0, 384, 768, W_UQ, RmUq{})
                WITEMP(I_EWUKV, 0, 256, 1024, W_UKV, RmUkv{})
            }
            { const size_t n16 = (size_t)96 * DM * 2 / 16; GAS u32x4* zp = (GAS u32x4*)(Wb + W_INE + (size_t)416 * DM);
              for (size_t i = (size_t)F.vcu * NTHR + F.tid; i < n16; i += (size_t)F.G * NTHR) zp[i] = (u32x4){0u, 0u, 0u, 0u}; }
            { GAS u32x4* kz = (GAS u32x4*)KMEAN; for (int i = F.vcu * NTHR + F.tid; i < BATCH * 16 * 16 * 64 / 4; i += F.G * NTHR) kz[i] = (u32x4){0u, 0u, 0u, 0u}; }
            { const GAS int* pos = (const GAS int*)AP->in[I_POS];
              for (int i = F.vcu * NTHR + F.tid; i < M * 16; i += F.G * NTHR) { const int m = i >> 4, f = i & 15;
                  const double ang = (double)pos[m] * (INVF10[f >> 2] * INVF4[f & 3]); double rev = ang * 0.15915494309189535; rev -= __builtin_rint(rev);
                  ((GAS f32x2*)ROPE)[i] = (f32x2){__builtin_amdgcn_cosf((float)rev), __builtin_amdgcn_sinf((float)rev)}; } }
            rms_rows_phase(F, X, as_global((const float*)AP->in[I_MIXN]), XNA);
        }}
    PHASE_LEAVE }
    if (lo <= 1 && 1 < hi) { PHASE_ENTER(1)
        {{ run_gemm(F, XNA, DM, Wb + W_INE, E_INP - 256, DM, EpInE{Z, ROPE, as_global((const float*)AP->in[I_ECQN]), as_global((const float*)AP->in[I_ECKVN]), as_global((const float*)AP->in[I_EKNR]),
                                                                     as_global((const float*)AP->in[I_EDQN]), as_global((const float*)AP->in[I_EDKN]), SSQ, SSKV}); }}
    PHASE_LEAVE }
    if (lo <= 3 && 3 < hi) { PHASE_ENTER(3)
        {{ run_gemm(F, Z + ZC_CQ, E_INP, Wb + W_UQ, QA_N, 384, EpUq{QA, ROPE, as_global((const float*)AP->in[I_EQNN]), as_global((const float*)AP->in[I_EQNR]), SSQ});
                  { constexpr int UQ_TILES = (M / 256) * (QA_N / 256);
                    run_gemm(F, XNA, DM, Wb + W_INE + (size_t)(E_INP - 256) * DM, 256, DM, EpInE8{EpInE{Z, ROPE, as_global((const float*)AP->in[I_ECQN]), as_global((const float*)AP->in[I_ECKVN]), as_global((const float*)AP->in[I_EKNR]),
                                                                     as_global((const float*)AP->in[I_EDQN]), as_global((const float*)AP->in[I_EDKN]), SSQ, SSKV}}, (F.G - UQ_TILES % F.G) % F.G); }
                  run_gemm(F, Z + ZC_CKV, E_INP, Wb + W_UKV, KVA_N, 256, EpUkv{KVA, as_global((const float*)AP->in[I_EKNN]), SSKV});
                  { constexpr int UQ_TILES = (M / 256) * (QA_N / 256); const int nlong = UQ_TILES % F.G; int bid1 = blockIdx.x; asm volatile("" : "+s"(bid1));
                    if (nlong > 0) { if (bid1 < nlong) pb_part(F, as_global((const float*)AP->in[I_P]), PB, bid1, nlong); }
                    else pb_part(F, as_global((const float*)AP->in[I_P]), PB, bid1, F.G); } }}
    PHASE_LEAVE }
    if (lo <= 5 && 5 < hi) { PHASE_ENTER(5)
        {{
            bf16* const OB = (bf16*)(ws + WS_OB); float* const LSE = (float*)(ws + WS_LSE);
#if GEMM_PROBE == 7
            for (int su = F.vcu; su < 256; su += F.G) { const int bh = su >> 2, s = su & 3;
                for (int k = 0; k < 4; ++k) { const int qb = (k == 0) ? 15 - s : (k == 1) ? 8 + s : (k == 2) ? 7 - s : s; att::mla_unit(F.lds, bh >> 3, bh & 7, qb, QA, KVA, Z, MIXED, F.tid); } }
#endif
#pragma unroll 1
            for (int s_ = 0; s_ < 2; ++s_) {
                if ((s_ ^ (F.vcu & 1)) == 0) {
                    for (int su = F.vcu; su < 256; su += F.G) { const int bh = su >> 2, s = su & 3;
                        for (int k = 0; k < 4; ++k) { const int qb = (k == 0) ? 15 - s : (k == 1) ? 8 + s : (k == 2) ? 7 - s : s; att::mla_unit(F.lds, bh >> 3, bh & 7, qb, QA, KVA, Z, MIXED, F.tid); } }
                } else {
#if DIL_STREAM
                    att::dil_stream(F.lds, 0, F.vcu, F.G, Z, OB, LSE, MIXED, F.tid);
#else
                    for (int br = 0; br < 2; ++br)
                        for (int u = F.vcu; u < 1024; u += F.G) { const int bh = u >> 4, x = u & 15, dil = 1 << (2 * br); att::dil_unit(F.lds, bh >> 3, bh & 7, br, x & (dil - 1), x >> (2 * br), Z, OB, LSE, MIXED, F.tid); }
#endif
                }
                if (s_ == 0) {
                    LAS float* scr = (LAS float*)(F.lds + F.wave * 16384);
                    for (int it = gw; it < WITEMS_TOTAL - WITEMS_P0; it += NGW) {
                        int r = it;
                    WITEM(I_EWOUT, 0, 1024, 1024, W_OUTE)
                    WITEMG(I_OWIN, 0, 1024, 3072, W_INO, RmInO{}, as_global((const float*)AP->in[I_MIXN]) + DM)
                    WITEM(I_OWOUT, 0, 1024, 1024, W_OUTO)
                    WITEMG(I_WFF1, 0, 1024, 4096, W_FF1, RmPlain{}, as_global((const float*)AP->in[I_FFN]))
                    WITEMG(I_WFF1, (size_t)DM * FF, 1024, 4096, W_FF1 + (size_t)FF * DM, RmPlain{}, as_global((const float*)AP->in[I_FFN]) + DM)
                    WITEM(I_WFF2, 0, 4096, 1024, W_FF2)
                    WITEM(I_WFF2, (size_t)DM * FF, 4096, 1024, W_FF2 + (size_t)FF * DM)
                    WITEMG(I_WG, 0, 1024, 1024, W_G, RmPlain{}, as_global((const float*)AP->in[I_PLEN]))
                    WITEMG(I_WG, (size_t)DM * DM, 1024, 1024, W_G + (size_t)DM * DM, RmPlain{}, as_global((const float*)AP->in[I_PLEN]) + DM)
                    WITEM(I_WP, 0, 256, 1024, W_P)
                    WITEM(I_WP, (size_t)PLE * DM, 256, 1024, W_P + (size_t)PLE * DM)
                    }
                    asm volatile("s_waitcnt vmcnt(0) lgkmcnt(0)\n\ts_barrier" ::: "memory");
                } }
        }}
    PHASE_LEAVE }
    if (lo <= 6 && 6 < hi) { PHASE_ENTER(6)
        {{
            bf16* const OB = (bf16*)(ws + WS_OB); float* const LSE = (float*)(ws + WS_LSE);
#if DIL_STREAM
            att::dil_stream(F.lds, 1, F.vcu, F.G, Z, OB, LSE, MIXED, F.tid);
#else
            for (int u = F.vcu; u < 1024; u += F.G) { const int bh = u >> 4, x = u & 15; att::dil_unit(F.lds, bh >> 3, bh & 7, 2, x, 0, Z, OB, LSE, MIXED, F.tid); }
#endif
        }}
    PHASE_LEAVE }
    if (lo <= 7 && 7 < hi) { PHASE_ENTER(7)
        { {
#if GEMM_PROBE == 3
            run_gemm(F, MIXED, DM, Wb + W_OUTE, DM, DM, EpResNormT<true>{X, nullptr, XM1, SSB}); GRID_BAR();
#elif GEMM_PROBE == 4
            run_gemm(F, MIXED, DM, Wb + W_OUTE, DM, DM, EpNull{}); GRID_BAR();
#endif
            run_gemm(F, MIXED, DM, Wb + W_OUTE, DM, DM, EpResNormT<true>{X, nullptr, XNA, SSA}); }}
    PHASE_LEAVE }
    if (lo <= 9 && 9 < hi) { PHASE_ENTER(9)
        {{
#if GEMM_PROBE == 1
            run_gemm(F, XNA, DM, Wb + W_FF1, FF, DM, EpRelu2N{U, SSA}); GRID_BAR();
#elif GEMM_PROBE == 2
            run_gemm(F, XNA, DM, Wb + W_FF1, FF, DM, EpNull{}); GRID_BAR();
#endif
            const int L = (9 == 9) ? 0 : 1;
#pragma unroll 1
            for (int s_ = 0; s_ < 2; ++s_) {
                if ((s_ ^ (F.vcu & 1)) == 0) run_gemm(F, XNA, DM, Wb + W_FF1 + (size_t)L * FF * DM, FF, DM, EpRelu2N{U, L ? SSB : SSA});
                else run_gemm(F, PB, PLE, Wb + W_P + (size_t)L * DM * PLE, DM, PLE, EpBf16R{PP, DM}); } }}
    PHASE_LEAVE }
    if (lo <= 10 && 10 < hi) { PHASE_ENTER(10)
        {{ run_gemm(F, U, FF, Wb + W_FF2, DM, FF, EpResNormT<false>{nullptr, XNA, XNA, SSB}); }}
    PHASE_LEAVE }
    if (lo <= 12 && 12 < hi) { PHASE_ENTER(12)
        {{ run_gemm(F, XNA, DM, Wb + W_G, DM, DM, EpPleN{XNA, PP, SSB, XM1, SSA, nullptr}); }}
    PHASE_LEAVE }
    if (lo <= 14 && 14 < hi) { PHASE_ENTER(14)
        {{ run_gemm(F, XM1, DM, Wb + W_INO, QKV_N, DM, EpInO{QKV, as_global((const float*)AP->in[I_OQN]), as_global((const float*)AP->in[I_OKN]), SSA, KMEAN}); }}
    PHASE_LEAVE }
    if (lo <= 17 && 17 < hi) { PHASE_ENTER(17)
        {{
            const float dnum = att::moba_bound(as_global((const float*)AP->in[I_OQN]), as_global((const float*)AP->in[I_OKN]), F.tid);
            att::Ring rg{}; bool pre = false;
            int b, h, ob; bool ok;
#define MOBA_UNIT(k_, b_, h_, ob_, ok_) do { const int su_ = F.vcu + ((k_) >> 3) * F.G; ok_ = su_ < 256; const int i_ = 7 - ((k_) & 7), j_ = su_ & 31, p_ = j_ & 1, jj_ = j_ >> 1; \
                b_ = su_ >> 5; h_ = 2 * i_ + (p_ ^ (i_ & 1)); ob_ = (int)((MOBA_OB[h_] >> (4 * jj_)) & 15ull); } while (0)
            MOBA_UNIT(0, b, h, ob, ok);
            for (int k = 0; ok; ++k) { int nb, nh, nob; bool nok; MOBA_UNIT(k + 1, nb, nh, nob, nok);
                att::moba_unit(F.lds, b, h, ob, QKV, KMEAN, MIXED, dnum, F.tid, rg, pre, nok, nb, nh, nob);
                pre = true; b = nb; h = nh; ob = nob; ok = nok; }
#undef MOBA_UNIT
        }}
    PHASE_LEAVE }
    if (lo <= 18 && 18 < hi) { PHASE_ENTER(18)
        {{
#pragma unroll 1
            for (int s_ = 0; s_ < 2; ++s_) {
                if ((s_ ^ (F.vcu & 1)) == 0) run_gemm(F, MIXED, DM, Wb + W_OUTO, DM, DM, EpResNormT<false>{nullptr, XM1, XNA, SSB});
                else pb_phase(F, as_global((const float*)AP->in[I_P]) + (size_t)M * PLE, PB); } }}
    PHASE_LEAVE }
    if (lo <= 20 && 20 < hi) { PHASE_ENTER(20)
        {{ const int L = (20 == 9) ? 0 : 1;
#pragma unroll 1
            for (int s_ = 0; s_ < 2; ++s_) {
                if ((s_ ^ (F.vcu & 1)) == 0) run_gemm(F, XNA, DM, Wb + W_FF1 + (size_t)L * FF * DM, FF, DM, EpRelu2N{U, L ? SSB : SSA});
                else run_gemm(F, PB, PLE, Wb + W_P + (size_t)L * DM * PLE, DM, PLE, EpBf16R{PP, DM}); } }}
    PHASE_LEAVE }
    if (lo <= 21 && 21 < hi) { PHASE_ENTER(21)
        {{ run_gemm(F, U, FF, Wb + W_FF2 + (size_t)FF * DM, DM, FF, EpResNormT<false>{nullptr, XNA, XNA, SSA}); }}
    PHASE_LEAVE }
    if (lo <= 23 && 23 < hi) { PHASE_ENTER(23)
        {{ run_gemm(F, XNA, DM, Wb + W_G + (size_t)DM * DM, DM, DM, EpPleN{XNA, PP, SSA, nullptr, nullptr, H}); }}
    PHASE_LEAVE }
}

extern "C" void kernel_launch(void* const* d_in, const int* in_sizes, int n_in, void* d_out, int out_size, void* d_ws, size_t ws_size, hipStream_t stream) {
    static int grid = 0;
    if (grid == 0) {
        if (n_in != 26 || out_size != M * DM || ws_size < WS_END) { fprintf(stderr, "kernel_launch: unexpected shapes (n_in %d, out %d, ws %zu); nothing launched\n", n_in, out_size, ws_size); grid = -1; return; }
        int dev = 0, cus = 0;
        if (hipGetDevice(&dev) != hipSuccess || hipDeviceGetAttribute(&cus, hipDeviceAttributeMultiprocessorCount, dev) != hipSuccess) { grid = -1; return; }
        if (hipFuncSetAttribute((const void*)trunk_fwd, hipFuncAttributeMaxDynamicSharedMemorySize, LDS_BYTES) != hipSuccess) { fprintf(stderr, "kernel_launch: hipFuncSetAttribute failed\n"); grid = -1; return; }
        (void)hipGetLastError();
        grid = cus;
    }
    if (grid < 0) return;
    Args a{};
    for (int i = 0; i < 26; ++i) a.in[i] = d_in[i];
    a.out = (float*)d_out; a.ws = (unsigned char*)d_ws;
#if MK_ONE_LAUNCH
    (void)hipMemsetAsync((char*)d_ws + WS_CTL, 0, CTL_ZERO_BYTES, stream);
    a.ph_lo = 0; a.ph_hi = NPH;
    hipLaunchKernelGGL(trunk_fwd, dim3(grid), dim3(NTHR), LDS_BYTES, stream, a);
#else
    for (int ph = 0; ph < NPH; ++ph) { if (!((PH_ACTIVE >> ph) & 1u)) continue; a.ph_lo = ph; a.ph_hi = ph + 1; hipLaunchKernelGGL(trunk_fwd, dim3(grid), dim3(NTHR), LDS_BYTES, stream, a); }
#endif
}
```

```cpp
#include <hip/hip_runtime.h>
#include <cstdio>
#include <cstdint>

#ifndef MK_ONE_LAUNCH
#define MK_ONE_LAUNCH 1
#endif
#ifndef USE_PG8
#define USE_PG8 1
#endif

#ifndef FAST_ATTN
#define FAST_ATTN 1
#endif

#ifndef PROBE_MASK
#define PROBE_MASK 0u
#endif

#ifndef ATT_PROBE
#define ATT_PROBE 0
#endif

#ifndef ATT_NOPRE
#define ATT_NOPRE 0
#endif

#ifndef GEMM_PROBE
#define GEMM_PROBE 0
#endif

#ifndef GEMM_SP2
#define GEMM_SP2 true
#endif

#ifndef DIL_STREAM
#define DIL_STREAM 1
#endif

#define LAS __attribute__((address_space(3)))
#define GAS __attribute__((address_space(1)))
#if USE_PG8
namespace pg8 {
#define PG8_LAS __attribute__((address_space(3)))
typedef unsigned short bf16_t;
typedef short bf16x8 __attribute__((ext_vector_type(8)));
typedef float f32x4 __attribute__((ext_vector_type(4)));
typedef unsigned u32x4 __attribute__((ext_vector_type(4)));
constexpr int BM = 256, BK = 64, HALF = 128, HTB = HALF * BK * 2  , STAGE_BYTES = 8 * HTB, NXCD = 8, WGM = 8;

__host__ __device__ __forceinline__ int lds_byte(int r, int c) { const int st = (r >> 4) * 2 + (c >> 5), rr = r & 15, cc = c & 31, ob = rr * 64 + cc * 2; return st * 1024 + (ob ^ (((ob >> 9) & 1) << 5)); }
__host__ __device__ __forceinline__ void stage_rc(int b, int& R, int& C) { const int st = b / 1024, sb = b % 1024, swz = sb ^ (((sb >> 9) & 1) << 5); R = (st >> 1) * 16 + swz / 64; C = (st & 1) * 32 + (swz % 64) / 2; }
__host__ __device__ __forceinline__ int perm32(int rho) { const int n = rho >> 4, i = rho & 15; return 8 * (i >> 2) + 4 * n + (i & 3); }

struct Unit { int pm, pn; };
struct Gemm { const bf16_t* A; const bf16_t* Bt; int M, N, K, lda; };

struct StaticOrder {
    int nM, nN, nwg, G, c;
    __host__ __device__ void init(int M, int N, int G_, int c_) { nM = M / BM; nN = N / BM; nwg = nM * nN; G = G_; c = c_; }
    __host__ __device__ bool next(int i, Unit& u) const {
        const long L = (long)i * G + c; if (L >= nwg) return false;
        int wgid = (int)L; { const int q = nwg / NXCD, r = nwg % NXCD, xcd = wgid % NXCD, off = wgid / NXCD; wgid = (xcd < r ? xcd * (q + 1) : r * (q + 1) + (xcd - r) * q) + off; }
        const int nig = WGM * nN, gid = wgid / nig, fm = gid * WGM, gsz = (nM - fm) < WGM ? (nM - fm) : WGM;
        u.pm = fm + ((wgid % nig) % gsz); u.pn = (wgid % nig) / gsz; return true;
    }
    __device__ __forceinline__ void a_ready(const Unit&) const {}
    __device__ __forceinline__ void done(const Unit&) const {}
};

template <class Epi, class Sched, bool ALIGN_EPI = false, bool SP2 = false>
__device__ __forceinline__ void gemm_phase(PG8_LAS unsigned char* lds, const Gemm g, const Sched& S, const Epi& E) {
    int tid_ = threadIdx.x; asm volatile("" : "+v"(tid_));
    const int tid = tid_, wid = __builtin_amdgcn_readfirstlane(tid >> 6), lane = tid & 63, wr = wid >> 2, wc = wid & 3, fr = lane & 15, fq = lane >> 4;
    const int K = g.K, nt = K / BK;
    unsigned voffA[2], voffB[2];
#pragma unroll
    for (int i = 0; i < 2; ++i) { int R, C; stage_rc(tid * 16 + i * 8192, R, C); const int Rb = Epi::PERM ? ((R & ~31) + perm32(R & 31)) : R;
        voffA[i] = (unsigned)(R * g.lda + C) * 2u; voffB[i] = (unsigned)(Rb * K + C) * 2u; }
    const size_t kstep = (size_t)(BK * 2);
    const size_t hstepA = (size_t)HALF * g.lda * 2, hstepB = (size_t)HALF * K * 2;
    const size_t tstepA = 2 * hstepA, tstepB = 2 * hstepB;
    const unsigned ldsw = (unsigned)wid * 1024u;
    const int aoff = lds_byte(wr * 64 + fr, fq * 8), boff = lds_byte(wc * 32 + fr, fq * 8);
#define PG8_SA(b, h) (((b) * 2 + (h)) * HTB)
#define PG8_SB(b, h) ((4 + (b) * 2 + (h)) * HTB)
#define PG8_STAGE(bufoff, gbase, voff) do { _Pragma("unroll") for (int _i = 0; _i < 2; ++_i) \
        __builtin_amdgcn_global_load_lds((const unsigned*)((const char*)(gbase) + (voff)[_i]), (PG8_LAS unsigned*)(lds + (bufoff) + ldsw + _i * 8192), 16, 0, 0); } while (0)
#define PG8_LDA(dst, b, h) do { _Pragma("unroll") for (int m = 0; m < 4; ++m) _Pragma("unroll") for (int k = 0; k < 2; ++k) dst[m][k] = *(const PG8_LAS bf16x8*)(lds + PG8_SA(b, h) + aoff + m * 2048 + k * 1024); } while (0)
#define PG8_LDB(dst, b, h) do { _Pragma("unroll") for (int n = 0; n < 2; ++n) _Pragma("unroll") for (int k = 0; k < 2; ++k) dst[n][k] = *(const PG8_LAS bf16x8*)(lds + PG8_SB(b, h) + boff + n * 2048 + k * 1024); } while (0)
#define PG8_MMA(ai, bj, At, Bt) do { __builtin_amdgcn_s_setprio(1); _Pragma("unroll") for (int m = 0; m < 4; ++m) _Pragma("unroll") for (int n = 0; n < 2; ++n) _Pragma("unroll") for (int k = 0; k < 2; ++k) \
        acc[ai][bj][m][n] = __builtin_amdgcn_mfma_f32_16x16x32_bf16(Bt[n][k], At[m][k], acc[ai][bj][m][n], 0, 0, 0); __builtin_amdgcn_s_setprio(0); } while (0)
#define PG8_WAIT_V(n) asm volatile("s_waitcnt vmcnt(" #n ")" ::: "memory")
#define PG8_WAIT_L(n) asm volatile("s_waitcnt lgkmcnt(" #n ")" ::: "memory")
#define PG8_BAR __builtin_amdgcn_s_barrier()
#define PG8_SCHED __builtin_amdgcn_sched_barrier(0)
    Unit cur, nxt; int ui = 0;
    if (!S.next(0, cur)) return;
    f32x4 acc[2][2][4][2];
#pragma unroll
    for (int a = 0; a < 2; ++a)
#pragma unroll
        for (int b = 0; b < 2; ++b)
#pragma unroll
            for (int m = 0; m < 4; ++m)
#pragma unroll
                for (int n = 0; n < 2; ++n) acc[a][b][m][n] = (f32x4){0.f, 0.f, 0.f, 0.f};
    bf16x8 At[4][2], B0[2][2], B1[2][2];
    const char* cA = (const char*)g.A + (size_t)cur.pm * tstepA; const char* cB = (const char*)g.Bt + (size_t)cur.pn * tstepB;
    S.a_ready(cur);
    if constexpr (SP2) {
        PG8_STAGE(PG8_SB(0, 0), cB, voffB); PG8_STAGE(PG8_SB(0, 1), cB + hstepB, voffB); PG8_STAGE(PG8_SA(0, 0), cA, voffA); PG8_STAGE(PG8_SA(0, 1), cA + hstepA, voffA);
        if (wr == 1) PG8_BAR;
        PG8_WAIT_V(2); PG8_BAR;
        PG8_STAGE(PG8_SB(1, 0), cB + kstep, voffB); PG8_STAGE(PG8_SA(1, 0), cA + kstep, voffA); PG8_STAGE(PG8_SB(1, 1), cB + hstepB + kstep, voffB);
        PG8_WAIT_V(6); PG8_BAR;
    } else {
        PG8_STAGE(PG8_SB(0, 0), cB, voffB); PG8_STAGE(PG8_SA(0, 0), cA, voffA); PG8_STAGE(PG8_SB(0, 1), cB + hstepB, voffB); PG8_STAGE(PG8_SA(0, 1), cA + hstepA, voffA);
        if (wr == 1) PG8_BAR;
        PG8_WAIT_V(4); PG8_BAR;
        PG8_STAGE(PG8_SB(1, 0), cB + kstep, voffB); PG8_STAGE(PG8_SA(1, 0), cA + kstep, voffA); PG8_STAGE(PG8_SB(1, 1), cB + hstepB + kstep, voffB);
        PG8_WAIT_V(6); PG8_BAR;
    }
    for (;;) {
        const bool has_next = S.next(ui + 1, nxt);
        const char* nA = has_next ? (const char*)g.A + (size_t)nxt.pm * tstepA : cA; const char* nB = has_next ? (const char*)g.Bt + (size_t)nxt.pn * tstepB : cB;
#pragma unroll 1
        for (int t = 0; t < nt; t += 2) {
            const bool last = (t == nt - 2);
            const char* a1 = cA + (size_t)(t + 1) * kstep;
            const char* a2 = last ? nA : cA + (size_t)(t + 2) * kstep; const char* b2 = last ? nB : cB + (size_t)(t + 2) * kstep;
            const char* a3 = a2 + kstep; const char* b3 = b2 + kstep;
            if (last && has_next) S.a_ready(nxt);
            if constexpr (SP2) {
            PG8_LDB(B0, 0, 0); PG8_LDB(B1, 0, 1); PG8_SCHED; PG8_LDA(At, 0, 0); PG8_STAGE(PG8_SA(1, 1), a1 + hstepA, voffA);
            PG8_WAIT_V(8); PG8_WAIT_L(0); PG8_BAR; PG8_MMA(0, 0, At, B0); PG8_MMA(0, 1, At, B1); PG8_BAR; PG8_SCHED;
            PG8_LDA(At, 0, 1); PG8_STAGE(PG8_SB(0, 0), b2, voffB); PG8_STAGE(PG8_SB(0, 1), b2 + hstepB, voffB); PG8_STAGE(PG8_SA(0, 0), a2, voffA);
            PG8_WAIT_V(8); PG8_WAIT_L(0); PG8_BAR; PG8_MMA(1, 0, At, B0); PG8_MMA(1, 1, At, B1); PG8_BAR; PG8_SCHED;
            PG8_LDB(B0, 1, 0); PG8_LDB(B1, 1, 1); PG8_SCHED; PG8_LDA(At, 1, 0); PG8_STAGE(PG8_SA(0, 1), a2 + hstepA, voffA);
            PG8_WAIT_V(8); PG8_WAIT_L(0); PG8_BAR; PG8_MMA(0, 0, At, B0); PG8_MMA(0, 1, At, B1); PG8_BAR; PG8_SCHED;
            PG8_LDA(At, 1, 1); PG8_STAGE(PG8_SB(1, 0), b3, voffB); PG8_STAGE(PG8_SB(1, 1), b3 + hstepB, voffB); PG8_STAGE(PG8_SA(1, 0), a3, voffA);
            PG8_WAIT_V(8); PG8_WAIT_L(0); PG8_BAR; PG8_MMA(1, 0, At, B0); PG8_MMA(1, 1, At, B1); PG8_BAR; PG8_SCHED;
            } else {
            PG8_LDB(B0, 0, 0); PG8_SCHED; PG8_LDA(At, 0, 0); PG8_STAGE(PG8_SA(1, 1), a1 + hstepA, voffA);
            PG8_WAIT_L(8); PG8_BAR; PG8_WAIT_L(0); PG8_MMA(0, 0, At, B0); PG8_BAR; PG8_SCHED;
            PG8_LDB(B1, 0, 1); PG8_STAGE(PG8_SB(0, 0), b2, voffB);
            PG8_BAR; PG8_WAIT_L(0); PG8_MMA(0, 1, At, B1); PG8_BAR;
            PG8_LDA(At, 0, 1); PG8_STAGE(PG8_SA(0, 0), a2, voffA);
            PG8_BAR; PG8_WAIT_L(0); PG8_MMA(1, 0, At, B0); PG8_BAR; PG8_SCHED;
            PG8_STAGE(PG8_SB(0, 1), b2 + hstepB, voffB);
            PG8_WAIT_V(6); PG8_BAR; PG8_MMA(1, 1, At, B1); PG8_BAR;
            PG8_LDB(B0, 1, 0); PG8_SCHED; PG8_LDA(At, 1, 0); PG8_STAGE(PG8_SA(0, 1), a2 + hstepA, voffA);
            PG8_WAIT_L(8); PG8_BAR; PG8_WAIT_L(0); PG8_MMA(0, 0, At, B0); PG8_BAR; PG8_SCHED;
            PG8_LDB(B1, 1, 1); PG8_STAGE(PG8_SB(1, 0), b3, voffB);
            PG8_BAR; PG8_WAIT_L(0); PG8_MMA(0, 1, At, B1); PG8_BAR;
            PG8_LDA(At, 1, 1); PG8_STAGE(PG8_SA(1, 0), a3, voffA);
            PG8_BAR; PG8_WAIT_L(0); PG8_MMA(1, 0, At, B0); PG8_BAR; PG8_SCHED;
            PG8_STAGE(PG8_SB(1, 1), b3 + hstepB, voffB);
            PG8_WAIT_V(6); PG8_BAR; PG8_MMA(1, 1, At, B1); PG8_BAR;
            }
        }
        if constexpr (ALIGN_EPI) { if (wr == 0) PG8_BAR; }
        if constexpr (!Epi::AFTER_DRAIN) { E(acc, cur, wr, wc, fr, fq); S.done(cur); }
        if (!has_next) break;
#pragma unroll
        for (int a = 0; a < 2; ++a)
#pragma unroll
            for (int b = 0; b < 2; ++b)
#pragma unroll
                for (int m = 0; m < 4; ++m)
#pragma unroll
                    for (int n = 0; n < 2; ++n) acc[a][b][m][n] = (f32x4){0.f, 0.f, 0.f, 0.f};
        cur = nxt; cA = nA; cB = nB; ++ui;
        if constexpr (ALIGN_EPI) { if (wr == 1) PG8_BAR; }
    }
    PG8_WAIT_V(0);
    if constexpr (!ALIGN_EPI) { if (wr == 0) PG8_BAR; }
    PG8_BAR;
    if constexpr (Epi::AFTER_DRAIN) { E.fused(acc, cur, wr, wc, fr, fq, lds, wid, lane); S.done(cur); }
#undef PG8_SA
#undef PG8_SB
#undef PG8_STAGE
#undef PG8_LDA
#undef PG8_LDB
#undef PG8_MMA
#undef PG8_WAIT_V
#undef PG8_WAIT_L
#undef PG8_BAR
#undef PG8_SCHED
}
}
#endif

constexpr int BATCH = 8, SEQ = 4096, M = BATCH * SEQ, DM = 1024, FF = 4096, PLE = 256;
constexpr int E_IN = 2208, E_INP = 2304;
constexpr int ZC_CQ = 0, ZC_CKV = 384, ZC_KR = 640, ZC_QB = 672, ZC_KB = 1184, ZC_VB = 1696;
constexpr int QA_N = 768, KVA_N = 1024, QKV_N = 3072;
constexpr float EPS = 1e-6f;
constexpr float LOG2E = 1.4426950408889634f;
constexpr float QS_A = 0.10206207261596575f * LOG2E;
constexpr float QS_B = 0.125f * LOG2E;
constexpr int NWAVES = 8, NTHR = 512;
constexpr int NPH = 24;

constexpr size_t MiB = 1u << 20;
constexpr size_t WS_CTL = 0, CTL_ZERO_BYTES = 65536;
constexpr size_t WS_ROPE = 1 * MiB;
constexpr size_t WS_KMEAN = 5 * MiB;
constexpr size_t WS_W = 6 * MiB;
constexpr size_t WS_SSA = 60 * MiB, WS_SSB = 62 * MiB;
constexpr size_t WS_Z = 64 * MiB, WS_U = 64 * MiB, WS_QKV = 64 * MiB;
constexpr size_t WS_QA = 208 * MiB, WS_KVA = 256 * MiB, WS_XM1 = 256 * MiB;
constexpr size_t WS_OB = 320 * MiB, WS_LSE = 416 * MiB;
constexpr size_t WS_XNA = 320 * MiB, WS_PB = 384 * MiB, WS_PP = 400 * MiB;
constexpr size_t WS_MIXED = 419 * MiB;
constexpr size_t WS_SSQ = 483 * MiB, WS_SSKV = 484 * MiB;
constexpr size_t WS_END = 485 * MiB;
constexpr size_t W_INE = 0, W_UQ = W_INE + (size_t)E_INP * DM, W_UKV = W_UQ + (size_t)QA_N * 384, W_OUTE = W_UKV + (size_t)KVA_N * 256,
                 W_INO = W_OUTE + (size_t)DM * DM, W_OUTO = W_INO + (size_t)QKV_N * DM, W_FF1 = W_OUTO + (size_t)DM * DM, W_FF2 = W_FF1 + 2 * (size_t)FF * DM,
                 W_G = W_FF2 + 2 * (size_t)FF * DM, W_P = W_G + 2 * (size_t)DM * DM, W_END = W_P + 2 * (size_t)DM * PLE;
static_assert(WS_W + W_END * 2 <= WS_SSA, "weights fit");
constexpr int CW_BAR = 4096;

constexpr int RING_BYTES = 131072, LDSCTL_OFF = RING_BYTES, MISC_OFF = LDSCTL_OFF + 320, LDS_BYTES = 147456;

typedef unsigned short bf16;
typedef unsigned u32x2 __attribute__((ext_vector_type(2)));
typedef unsigned u32x4 __attribute__((ext_vector_type(4)));
typedef float f32x4 __attribute__((ext_vector_type(4)));
typedef float f32x2 __attribute__((ext_vector_type(2)));
typedef GAS unsigned gu32;
#define RLX_AGENT __ATOMIC_RELAXED, __HIP_MEMORY_SCOPE_AGENT
#define LDS_WAIT() asm volatile("s_waitcnt lgkmcnt(0)" ::: "memory")
#define VM_WAIT() asm volatile("s_waitcnt vmcnt(0)" ::: "memory")

__device__ __forceinline__ float bf_lo(unsigned w) { return __uint_as_float(w << 16); }
__device__ __forceinline__ float bf_hi(unsigned w) { return __uint_as_float(w & 0xffff0000u); }
__device__ __forceinline__ float bf2f(bf16 h) { return __uint_as_float((unsigned)h << 16); }
typedef __bf16 bf16x2_hw __attribute__((ext_vector_type(2)));
__device__ __forceinline__ unsigned pk2(float lo, float hi) { const f32x2 v = {lo, hi}; return __builtin_bit_cast(unsigned, __builtin_convertvector(v, bf16x2_hw)); }
__device__ __forceinline__ unsigned f2bf(float f) { return pk2(f, 0.f) & 0xffffu; }
__device__ __forceinline__ float rsq(float x) { return __builtin_amdgcn_rsqf(x); }
template <class T> __device__ __forceinline__ T* as_global(T* p) {
#if defined(__HIP_DEVICE_COMPILE__)
    __builtin_assume(!__builtin_amdgcn_is_shared((const __attribute__((address_space(0))) void*)p)); __builtin_assume(!__builtin_amdgcn_is_private((const __attribute__((address_space(0))) void*)p));
#endif
    return p; }
__device__ __forceinline__ float ex2(float x) { return __builtin_amdgcn_exp2f(x); }
template <int XM> __device__ __forceinline__ float swz_xor(float v) { return __builtin_bit_cast(float, __builtin_amdgcn_ds_swizzle(__builtin_bit_cast(int, v), (XM << 10) | 0x1F)); }
__device__ __forceinline__ float sum_xor32(float v) { auto r = __builtin_amdgcn_permlane32_swap(__float_as_uint(v), __float_as_uint(v), false, false); return __uint_as_float(r[0]) + __uint_as_float(r[1]); }
__device__ __forceinline__ float sum_xor16(float v) { auto r = __builtin_amdgcn_permlane16_swap(__float_as_uint(v), __float_as_uint(v), false, false); return __uint_as_float(r[0]) + __uint_as_float(r[1]); }
__device__ __forceinline__ float get_xor32(float v, bool lo) { auto r = __builtin_amdgcn_permlane32_swap(__float_as_uint(v), __float_as_uint(v), false, false); return lo ? __uint_as_float(r[1]) : __uint_as_float(r[0]); }
__device__ __forceinline__ float wave_sum(float v) {
    v += swz_xor<1>(v); v += swz_xor<2>(v); v += swz_xor<4>(v); v += swz_xor<8>(v); v += swz_xor<16>(v);
    return sum_xor32(v);
}

#define XB_TMO      128
#define XB_XCNT(j)  (256  + 64 * (j))
#define XB_XSUB(j)  (1280 + 64 * (j))
#define XB_XGEN(j)  (2304 + 64 * (j))
#define XB_TOP      3328
#define XB_TOPGEN   3392
#define XCD_BAR_WORDS 3456
#define XB_SPIN_CAP (1u << 22)
__device__ __forceinline__ unsigned xb_ld(unsigned* p)              { return __hip_atomic_load(p, __ATOMIC_RELAXED, __HIP_MEMORY_SCOPE_AGENT); }
__device__ __forceinline__ unsigned xb_add(unsigned* p, unsigned v) { return __hip_atomic_fetch_add(p, v, __ATOMIC_RELAXED, __HIP_MEMORY_SCOPE_AGENT); }
__device__ __forceinline__ unsigned xb_xcc_id() { return (unsigned)__builtin_amdgcn_s_getreg((3 << 11) | 20) & 0xFu; }
#define XB_SPIN(cond, bar) do { unsigned _sp = 0; while (cond) { __builtin_amdgcn_s_sleep(1); \
    if ((++_sp & 255u) == 0u) { if (xb_ld(&(bar)[XB_TMO])) break; if (_sp > XB_SPIN_CAP) { atomicAdd(&(bar)[XB_TMO], 1u); break; } } } } while (0)
struct XcdBarrier { unsigned* bar; unsigned x; volatile LAS unsigned* st; };
__device__ __forceinline__ XcdBarrier xcd_barrier_post(unsigned* bar, volatile LAS unsigned* st) {
    XcdBarrier b; b.bar = bar; b.x = xb_xcc_id(); b.st = st;
    if (threadIdx.x == 0) (void)xb_add(&bar[XB_XCNT(b.x)], 1u);
    return b;
}
__device__ __forceinline__ void xcd_barrier_complete(unsigned* bar, unsigned x, unsigned& nloc, unsigned& nx) {
    const unsigned G = gridDim.x * gridDim.y * gridDim.z;
    unsigned sum, cnt, mine, sp = 0u;
    for (;;) {
        sum = 0u; cnt = 0u; mine = 0u;
#pragma unroll
        for (unsigned j = 0; j < 16; ++j) { const unsigned c = xb_ld(&bar[XB_XCNT(j)]); sum += c; cnt += (c > 0u) ? 1u : 0u; mine = (j == x) ? c : mine; }
        if (sum == G) break;
        __builtin_amdgcn_s_sleep(1);
        if ((++sp & 255u) == 0u) { if (xb_ld(&bar[XB_TMO])) break; if (sp > XB_SPIN_CAP) { atomicAdd(&bar[XB_TMO], 1u); break; } }
    }
    nloc = mine > 0u ? mine : 1u; nx = cnt > 0u ? cnt : 1u;
}
__device__ __forceinline__ void xcd_barrier(const XcdBarrier& b) {
    asm volatile("s_waitcnt vmcnt(0)" ::: "memory");
    __syncthreads();
    if (threadIdx.x == 0) {
        unsigned* bar = b.bar;
        __builtin_amdgcn_s_waitcnt(0);
        unsigned nloc = b.st[0], nx = b.st[1];
        if (nloc == 0u) { xcd_barrier_complete(bar, b.x, nloc, nx); b.st[0] = nloc; b.st[1] = nx; }
        const unsigned old = xb_add(&bar[XB_XSUB(b.x)], 1u);
        const unsigned gen = old / nloc;
        if (old + 1u == (gen + 1u) * nloc) {
            __builtin_amdgcn_fence(__ATOMIC_RELEASE, "agent");
            asm volatile("s_waitcnt vmcnt(0)" ::: "memory");
            const unsigned og = xb_add(&bar[XB_TOP], 1u);
            const unsigned tg = og / nx;
            if (og + 1u == (tg + 1u) * nx) xb_add(&bar[XB_TOPGEN], 1u);
            else XB_SPIN(xb_ld(&bar[XB_TOPGEN]) == tg, bar);
            __builtin_amdgcn_fence(__ATOMIC_ACQUIRE, "agent");
            xb_add(&bar[XB_XGEN(b.x)], 1u);
            asm volatile("s_waitcnt vmcnt(0)" ::: "memory");
        } else {
            XB_SPIN(xb_ld(&bar[XB_XGEN(b.x)]) == gen, bar);
            __builtin_amdgcn_fence(__ATOMIC_ACQUIRE, "agent");
            asm volatile("s_waitcnt vmcnt(0)" ::: "memory");
        }
    }
    __syncthreads();
}

struct Args { const void* in[26]; float* out; unsigned char* ws; int ph_lo, ph_hi; };
struct Frame {
    LAS unsigned char* lds; int tid, lane, wave, vcu, G;
    unsigned char* ws; float* H;
};
enum InIdx { I_X = 0, I_P, I_POS, I_EWIN, I_ECQN, I_ECKVN, I_EWUQ, I_EWUKV, I_EQNN, I_EQNR, I_EKNN, I_EKNR, I_EDQN, I_EDKN, I_EWOUT,
             I_OWIN, I_OQN, I_OKN, I_OWOUT, I_MIXN, I_FFN, I_WFF1, I_WFF2, I_PLEN, I_WG, I_WP };

__device__ __forceinline__ float red_fq(float s) { return sum_xor32(sum_xor16(s)); }
__device__ __forceinline__ float sumsq8(const f32x4& a, const f32x4& b) { return ((a[0] * a[0] + a[1] * a[1]) + (a[2] * a[2] + a[3] * a[3])) + ((b[0] * b[0] + b[1] * b[1]) + (b[2] * b[2] + b[3] * b[3])); }
__device__ __forceinline__ u32x4 pk8(const f32x4& a, const f32x4& b) { u32x4 w; w.x = pk2(a[0], a[1]); w.y = pk2(a[2], a[3]); w.z = pk2(b[0], b[1]); w.w = pk2(b[2], b[3]); return w; }
__device__ __forceinline__ float rstd_from(const float* ss, int n4, float inv_n) { f32x4 t = *(const GAS f32x4*)ss;
    for (int i = 1; i < n4; ++i) t += *(const GAS f32x4*)(ss + 4 * i);
    return rsq(((t[0] + t[1]) + (t[2] + t[3])) * inv_n + EPS); }
__device__ __forceinline__ void rope8(f32x4& y0, f32x4& y1, const float* ROPE, int row, int fq) {
    const GAS f32x4* cs = (const GAS f32x4*)(ROPE + ((size_t)row * 16 + 8 * (fq & 1)) * 2);
#pragma unroll
    for (int i = 0; i < 4; ++i) { const f32x4 t = cs[i >> 1]; const float c0 = (i & 1) ? t[2] : t[0], s0 = (i & 1) ? t[3] : t[1];
        const f32x4 u = cs[2 + (i >> 1)]; const float c1 = (i & 1) ? u[2] : u[0], s1 = (i & 1) ? u[3] : u[1];
        const float p0 = get_xor32(y0[i], fq < 2), p1 = get_xor32(y1[i], fq < 2);
        y0[i] = (fq < 2) ? (y0[i] * c0 - p0 * s0) : (p0 * s0 + y0[i] * c0);
        y1[i] = (fq < 2) ? (y1[i] * c1 - p1 * s1) : (p1 * s1 + y1[i] * c1); }
}

__device__ __forceinline__ u32x4 swap_adj(const u32x4 v) { u32x4 r;
#pragma unroll
    for (int e = 0; e < 4; ++e) r[e] = (unsigned)__builtin_amdgcn_mov_dpp((int)v[e], 0xB1, 0xF, 0xF, true);
    return r; }
template <bool NT> __device__ __forceinline__ void store_lines2(GAS char* own, size_t pitchB, int dist, int row, const u32x4 p0, const u32x4 p1) {
    const bool odd = (row & 1) != 0;
    const u32x4 rcv = swap_adj(odd ? p0 : p1);
    const u32x4 a = odd ? rcv : p0, b = odd ? p1 : rcv;
    GAS char* pa = odd ? own - pitchB + dist : own;
    GAS char* pb = odd ? own + dist : own + pitchB;
    if constexpr (NT) { __builtin_nontemporal_store(a, (GAS u32x4*)pa); __builtin_nontemporal_store(b, (GAS u32x4*)pb); }
    else { *(GAS u32x4*)pa = a; *(GAS u32x4*)pb = b; } }
template <bool NT> __device__ __forceinline__ void load_lines2(const GAS char* own, size_t pitchB, int dist, int row, u32x4& la, u32x4& lb) {
    const bool odd = (row & 1) != 0;
    const GAS char* pa = odd ? own - pitchB + dist : own; const GAS char* pb = odd ? own + dist : own + pitchB;
    if constexpr (NT) { la = __builtin_nontemporal_load((const GAS u32x4*)pa); lb = __builtin_nontemporal_load((const GAS u32x4*)pb); }
    else { la = *(const GAS u32x4*)pa; lb = *(const GAS u32x4*)pb; } }
__device__ __forceinline__ void unswap(int row, const u32x4 la, const u32x4 lb, u32x4& p0, u32x4& p1) {
    const bool odd = (row & 1) != 0; const u32x4 rcv = swap_adj(odd ? la : lb); p0 = odd ? rcv : la; p1 = odd ? lb : rcv; }
struct EpBf16R { bf16* O; int ldc;
    __device__ __forceinline__ void row(int row, int pn, int wc, int fq, const f32x4 (&a)[2][2]) const {
        store_lines2<true>((GAS char*)(O + (size_t)row * ldc + pn * 256 + wc * 64 + fq * 8), (size_t)ldc * 2, 64, row, pk8(a[0][0], a[0][1]), pk8(a[1][0], a[1][1])); } };
struct EpNull {
    __device__ __forceinline__ void row(int, int, int, int, const f32x4 (&a)[2][2]) const { asm volatile("" :: "v"(a[0][0]), "v"(a[0][1]), "v"(a[1][0]), "v"(a[1][1])); } };
__device__ __forceinline__ void unpk8(const u32x4 w, f32x4& a, f32x4& b) { a = (f32x4){bf_lo(w.x), bf_hi(w.x), bf_lo(w.y), bf_hi(w.y)}; b = (f32x4){bf_lo(w.z), bf_hi(w.z), bf_lo(w.w), bf_hi(w.w)}; }
template <bool XF> struct EpResNormT { const float* xf; const bf16* hb; bf16* Hb; float* SS;
    static constexpr int DEPTH = 3;
    struct Ops { f32x4 x[2][2]; };
    __device__ __forceinline__ void load(Ops& p, int row, int pn, int wc, int fq) const { const size_t o = (size_t)row * DM + pn * 256 + wc * 64 + fq * 8;
        u32x4 la, lb;
        if constexpr (XF) {
#pragma unroll
            for (int bj = 0; bj < 2; ++bj) { load_lines2<true>((const GAS char*)(xf + o + 32 * bj), (size_t)DM * 4, 16, row, la, lb); p.x[bj][0] = __builtin_bit_cast(f32x4, la); p.x[bj][1] = __builtin_bit_cast(f32x4, lb); } }
        else { load_lines2<false>((const GAS char*)(hb + o), (size_t)DM * 2, 64, row, la, lb); p.x[0][0] = __builtin_bit_cast(f32x4, la); p.x[1][0] = __builtin_bit_cast(f32x4, lb); p.x[0][1] = p.x[0][0]; p.x[1][1] = p.x[1][0]; } }
    __device__ __forceinline__ void fin(int row, int pn, int wc, int fq, const f32x4 (&a)[2][2], const Ops& p, float& ssr) const { float ss = 0.f; u32x4 w[2];
        u32x4 q[2][2];
        if constexpr (XF) {
#pragma unroll
            for (int bj = 0; bj < 2; ++bj) unswap(row, __builtin_bit_cast(u32x4, p.x[bj][0]), __builtin_bit_cast(u32x4, p.x[bj][1]), q[bj][0], q[bj][1]); }
        else { unswap(row, __builtin_bit_cast(u32x4, p.x[0][0]), __builtin_bit_cast(u32x4, p.x[1][0]), q[0][0], q[1][0]); q[0][1] = q[0][0]; q[1][1] = q[1][0]; }
#pragma unroll
        for (int bj = 0; bj < 2; ++bj) {
            f32x4 b0, b1; if constexpr (XF) { b0 = __builtin_bit_cast(f32x4, q[bj][0]); b1 = __builtin_bit_cast(f32x4, q[bj][1]); } else unpk8(q[bj][0], b0, b1);
            const f32x4 h0 = b0 + a[bj][0], h1 = b1 + a[bj][1];
            ss += sumsq8(h0, h1);
            w[bj] = pk8(h0, h1); }
        store_lines2<false>((GAS char*)(Hb + (size_t)row * DM + pn * 256 + wc * 64 + fq * 8), (size_t)DM * 2, 64, row, w[0], w[1]);
        ssr = red_fq(ss); }
    __device__ __forceinline__ void ss_out(int row, int pn, int wc, float v) const { ((GAS float*)SS)[(size_t)row * 16 + pn * 4 + wc] = v; } };
struct EpRelu2N { bf16* U; const float* SS;
    __device__ __forceinline__ float pre(int row, int fq) const { const f32x4 t = *(const GAS f32x4*)(SS + (size_t)row * 16 + 4 * fq); return rsq(red_fq((t[0] + t[1]) + (t[2] + t[3])) * (1.f / DM) + EPS); }
    __device__ __forceinline__ void row(int row, int pn, int wc, int fq, const f32x4 (&a)[2][2], float rs) const {
        u32x4 w[2];
#pragma unroll
        for (int bj = 0; bj < 2; ++bj) { f32x4 r0, r1;
#pragma unroll
            for (int e = 0; e < 4; ++e) { const float t0 = fmaxf(a[bj][0][e] * rs, 0.f), t1 = fmaxf(a[bj][1][e] * rs, 0.f); r0[e] = t0 * t0; r1[e] = t1 * t1; }
            w[bj] = pk8(r0, r1); }
        store_lines2<true>((GAS char*)(U + (size_t)row * FF + pn * 256 + wc * 64 + fq * 8), (size_t)FF * 2, 64, row, w[0], w[1]); } };
struct EpPleN { const bf16* hb; const bf16* PP; const float* SSi; bf16* Hb; float* SSo; float* OUT;
    static constexpr int DEPTH = 3;
    struct Ops { u32x4 pw[2], hw[2]; f32x4 sq; };
    __device__ __forceinline__ void load(Ops& p, int row, int pn, int wc, int fq) const { p.sq = *(const GAS f32x4*)(SSi + (size_t)row * 16 + 4 * fq);
        { const size_t o = (size_t)row * DM + pn * 256 + wc * 64 + fq * 8;
          load_lines2<false>((const GAS char*)(PP + o), (size_t)DM * 2, 64, row, p.pw[0], p.pw[1]); load_lines2<false>((const GAS char*)(hb + o), (size_t)DM * 2, 64, row, p.hw[0], p.hw[1]); } }
    __device__ __forceinline__ void fin(int row, int pn, int wc, int fq, const f32x4 (&a)[2][2], const Ops& p, float& ssr) const {
        const float rs = rsq(red_fq((p.sq[0] + p.sq[1]) + (p.sq[2] + p.sq[3])) * (1.f / DM) + EPS) * LOG2E; float ss = 0.f;
        u32x4 w[2], pwq[2], hwq[2]; unswap(row, p.pw[0], p.pw[1], pwq[0], pwq[1]); unswap(row, p.hw[0], p.hw[1], hwq[0], hwq[1]);
#pragma unroll
        for (int bj = 0; bj < 2; ++bj) { const int c = pn * 256 + wc * 64 + bj * 32 + fq * 8; const size_t o = (size_t)row * DM + c;
            const u32x4 pw = pwq[bj]; f32x4 h0, h1; unpk8(hwq[bj], h0, h1);
#pragma unroll
            for (int e = 0; e < 4; ++e) { const float g0 = __builtin_amdgcn_rcpf(1.f + ex2(-a[bj][0][e] * rs)), g1 = __builtin_amdgcn_rcpf(1.f + ex2(-a[bj][1][e] * rs));
                const unsigned w0 = pw[e >> 1], w1 = pw[2 + (e >> 1)];
                h0[e] += g0 * ((e & 1) ? bf_hi(w0) : bf_lo(w0)); h1[e] += g1 * ((e & 1) ? bf_hi(w1) : bf_lo(w1)); }
            if (OUT) store_lines2<true>((GAS char*)(OUT + o), (size_t)DM * 4, 16, row, __builtin_bit_cast(u32x4, h0), __builtin_bit_cast(u32x4, h1));
            else { ss += sumsq8(h0, h1); w[bj] = pk8(h0, h1); } }
        if (!OUT) { store_lines2<false>((GAS char*)(Hb + (size_t)row * DM + pn * 256 + wc * 64 + fq * 8), (size_t)DM * 2, 64, row, w[0], w[1]); ssr = red_fq(ss); } }
    __device__ __forceinline__ void ss_out(int row, int pn, int wc, float v) const { if (!OUT) ((GAS float*)SSo)[(size_t)row * 16 + pn * 4 + wc] = v; } };
struct Gains { f32x4 g[2][2]; };
__device__ __forceinline__ void load_gains64(Gains& G, const float* g, int fq) {
#pragma unroll
    for (int bj = 0; bj < 2; ++bj) { G.g[bj][0] = *(const GAS f32x4*)(g + 32 * bj + 8 * fq); G.g[bj][1] = *(const GAS f32x4*)(g + 32 * bj + 8 * fq + 4); } }
template <bool NT = true> __device__ __forceinline__ void head_norm_store(const f32x4 (&a)[2][2], float pre, const Gains& G, float sc, bf16* dst, int fq, int row, size_t pitchB, f32x4 (*colsum)[2] = nullptr) {
    f32x4 v[2][2]; u32x4 w[2];
#pragma unroll
    for (int bj = 0; bj < 2; ++bj) { v[bj][0] = a[bj][0] * pre; v[bj][1] = a[bj][1] * pre; }
    const float ss = red_fq(sumsq8(v[0][0], v[0][1]) + sumsq8(v[1][0], v[1][1])); const float rs = sc * rsq(ss * (1.f / 64.f) + EPS);
#pragma unroll
    for (int bj = 0; bj < 2; ++bj) { const f32x4 y0 = v[bj][0] * rs * G.g[bj][0], y1 = v[bj][1] * rs * G.g[bj][1];
        if (colsum) { colsum[bj][0] += y0; colsum[bj][1] += y1; }
        w[bj] = pk8(y0, y1); }
    store_lines2<NT>((GAS char*)(dst + 8 * fq), pitchB, 64, row, w[0], w[1]);
}
struct EpInE { bf16* Z; const float* ROPE; const float *g_cq, *g_ckv, *g_kr, *g_dq, *g_dk; float* SSQ; float* SSKV;
    __device__ __forceinline__ void gains(Gains& G, int pn, int wc, int fq) const {
        if (pn == 0 || pn == 2) { const float* g = pn ? g_ckv : g_cq;
#pragma unroll
            for (int bj = 0; bj < 2; ++bj) { const int c = bj * 128 + wc * 32 + fq * 8; G.g[bj][0] = *(const GAS f32x4*)(g + c); G.g[bj][1] = *(const GAS f32x4*)(g + c + 4); } }
        else if (pn == 1) { const int c = 256 + wc * 32 + fq * 8; G.g[0][0] = *(const GAS f32x4*)(g_cq + c); G.g[0][1] = *(const GAS f32x4*)(g_cq + c + 4);
            G.g[1][0] = *(const GAS f32x4*)(g_kr + 8 * fq); G.g[1][1] = *(const GAS f32x4*)(g_kr + 8 * fq + 4); }
        else load_gains64(G, (pn >= 5) ? g_dk : g_dq, fq); }
    __device__ __forceinline__ void row(int row, int pn, int wc, int fq, const f32x4 (&a)[2][2], const Gains& G) const { bf16* zr = Z + (size_t)row * E_INP;
        if (pn == 0) { float ss = 0.f;
#pragma unroll
            for (int bj = 0; bj < 2; ++bj) { const int c = bj * 128 + wc * 32 + fq * 8; ss += sumsq8(a[bj][0], a[bj][1]);
                __builtin_nontemporal_store(pk8(a[bj][0] * G.g[bj][0], a[bj][1] * G.g[bj][1]), (GAS u32x4*)(zr + ZC_CQ + c)); }
            ss = red_fq(ss); if (fq == 0) ((GAS float*)SSQ)[(size_t)row * 8 + wc] = ss;
        } else if (pn == 1) {
            { const int c = 256 + wc * 32 + fq * 8; const float ss = red_fq(sumsq8(a[0][0], a[0][1]));
              __builtin_nontemporal_store(pk8(a[0][0] * G.g[0][0], a[0][1] * G.g[0][1]), (GAS u32x4*)(zr + ZC_CQ + c));
              if (fq == 0) ((GAS float*)SSQ)[(size_t)row * 8 + 4 + wc] = ss; }
            if (wc == 0) { const float ss = red_fq(sumsq8(a[1][0], a[1][1])); const float rs = rsq(ss * (1.f / 32.f) + EPS);
                f32x4 y0 = a[1][0] * rs * G.g[1][0], y1 = a[1][1] * rs * G.g[1][1];
                rope8(y0, y1, ROPE, row, fq);
                __builtin_nontemporal_store(pk8(y0, y1), (GAS u32x4*)(zr + ZC_KR + 8 * fq)); }
        } else if (pn == 2) { float ss = 0.f;
#pragma unroll
            for (int bj = 0; bj < 2; ++bj) { const int c = bj * 128 + wc * 32 + fq * 8; ss += sumsq8(a[bj][0], a[bj][1]);
                __builtin_nontemporal_store(pk8(a[bj][0] * G.g[bj][0], a[bj][1] * G.g[bj][1]), (GAS u32x4*)(zr + ZC_CKV + c)); }
            ss = red_fq(ss); if (fq == 0) ((GAS float*)SSKV)[(size_t)row * 4 + wc] = ss;
        } else if (pn < 7) { const int which = (pn >= 5) ? 1 : 0, head = 4 * ((pn - 3) & 1) + wc;
            head_norm_store<false>(a, 1.f, G, which ? 1.f : QS_B, zr + (which ? ZC_KB : ZC_QB) + head * 64, fq, row, (size_t)E_INP * 2);
        } else { const int head = 4 * (pn - 7) + wc;
            store_lines2<false>((GAS char*)(zr + ZC_VB + head * 64 + 8 * fq), (size_t)E_INP * 2, 64, row, pk8(a[0][0], a[0][1]), pk8(a[1][0], a[1][1])); }
    } };
struct EpInE8 { EpInE e;
    __device__ __forceinline__ void gains(Gains& G, int pn, int wc, int fq) const { e.gains(G, 8, wc, fq); }
    __device__ __forceinline__ void row(int row, int pn, int wc, int fq, const f32x4 (&a)[2][2], const Gains& G) const { e.row(row, 8, wc, fq, a, G); } };
struct EpUq { bf16* QA; const float* ROPE; const float *g_qn, *g_qr; const float* SSQ;
    __device__ __forceinline__ float pre(int row, int fq) const { float s = 0.f; if (fq < 2) { const f32x4 t = *(const GAS f32x4*)(SSQ + (size_t)row * 8 + 4 * fq); s = (t[0] + t[1]) + (t[2] + t[3]); } return rsq(red_fq(s) * (1.f / 384.f) + EPS); }
    __device__ __forceinline__ void gains(Gains& G, int pn, int wc, int fq) const {
        if (pn < 2) load_gains64(G, g_qn, fq);
        else { G.g[0][0] = *(const GAS f32x4*)(g_qr + 8 * fq); G.g[0][1] = *(const GAS f32x4*)(g_qr + 8 * fq + 4); G.g[1][0] = G.g[0][0]; G.g[1][1] = G.g[0][1]; } }
    __device__ __forceinline__ void row(int row, int pn, int wc, int fq, const f32x4 (&a)[2][2], float pre, const Gains& G) const { bf16* qr = QA + (size_t)row * QA_N;
        if (pn < 2) head_norm_store(a, pre, G, QS_A, qr + (4 * pn + wc) * 96, fq, row, (size_t)QA_N * 2);
        else {
#pragma unroll
            for (int bj = 0; bj < 2; ++bj) { const f32x4 v0 = a[bj][0] * pre, v1 = a[bj][1] * pre; const float ss = red_fq(sumsq8(v0, v1)); const float rs = rsq(ss * (1.f / 32.f) + EPS);
                f32x4 y0 = v0 * rs * G.g[bj][0], y1 = v1 * rs * G.g[bj][1];
                rope8(y0, y1, ROPE, row, fq);
                __builtin_nontemporal_store(pk8(y0 * QS_A, y1 * QS_A), (GAS u32x4*)(qr + (4 * bj + wc) * 96 + 64 + 8 * fq)); } }
    } };
struct EpUkv { bf16* KVA; const float* g_kn; const float* SSKV;
    __device__ __forceinline__ float pre(int row, int fq) const { return rstd_from(SSKV + (size_t)row * 4, 1, 1.f / 256.f); }
    __device__ __forceinline__ void gains(Gains& G, int pn, int wc, int fq) const { load_gains64(G, g_kn, fq); }
    __device__ __forceinline__ void row(int row, int pn, int wc, int fq, const f32x4 (&a)[2][2], float pre, const Gains& G) const { bf16* kr = KVA + (size_t)row * KVA_N;
        if (pn < 2) head_norm_store(a, pre, G, 1.f, kr + (4 * pn + wc) * 128, fq, row, (size_t)KVA_N * 2);
        else { bf16* vp = kr + (4 * (pn - 2) + wc) * 128 + 64;
            store_lines2<true>((GAS char*)(vp + 8 * fq), (size_t)KVA_N * 2, 64, row, pk8(a[0][0] * pre, a[0][1] * pre), pk8(a[1][0] * pre, a[1][1] * pre)); }
    } };
struct EpInO { bf16* QKV; const float *g_q, *g_k; const float* SS; float* KMEAN;
    struct State { f32x4 cs[2][2]; };
    __device__ __forceinline__ void begin(State& st) const {
#pragma unroll
        for (int bj = 0; bj < 2; ++bj) { st.cs[bj][0] = (f32x4){0.f, 0.f, 0.f, 0.f}; st.cs[bj][1] = (f32x4){0.f, 0.f, 0.f, 0.f}; } }
    __device__ __forceinline__ float pre(int row, int fq) const { const f32x4 t = *(const GAS f32x4*)(SS + (size_t)row * 16 + 4 * fq); return rsq(red_fq((t[0] + t[1]) + (t[2] + t[3])) * (1.f / DM) + EPS); }
    __device__ __forceinline__ void gains(Gains& G, int pn, int wc, int fq) const { load_gains64(G, ((pn >> 2) == 1) ? g_k : g_q, fq); }
    __device__ __forceinline__ void row(int row, int pn, int wc, int fq, const f32x4 (&a)[2][2], State& st, float pre, const Gains& G) const {
        const int sec = pn >> 2, head = 4 * (pn & 3) + wc; bf16* dst = QKV + (size_t)row * QKV_N + sec * 1024 + head * 64;
        if (sec == 0) head_norm_store(a, pre, G, QS_B, dst, fq, row, (size_t)QKV_N * 2);
        else if (sec == 1) head_norm_store(a, pre, G, 1.f, dst, fq, row, (size_t)QKV_N * 2, st.cs);
        else {
            store_lines2<true>((GAS char*)(dst + 8 * fq), (size_t)QKV_N * 2, 64, row, pk8(a[0][0] * pre, a[0][1] * pre), pk8(a[1][0] * pre, a[1][1] * pre)); }
    }
    __device__ __forceinline__ void end(State& st, int pm, int pn, int wc, int fr, int fq) const {
        if ((pn >> 2) != 1) return;
        const int head = 4 * (pn & 3) + wc, b = pm >> 4, n = pm & 15;
        float* km = KMEAN + ((size_t)(b * 16 + head) * 16 + n) * 64;
#pragma unroll
        for (int bj = 0; bj < 2; ++bj)
#pragma unroll
            for (int q = 0; q < 2; ++q)
#pragma unroll
                for (int e = 0; e < 4; ++e) { float s = st.cs[bj][q][e]; s += swz_xor<1>(s); s += swz_xor<2>(s); s += swz_xor<4>(s); s += swz_xor<8>(s);
                    if (fr == 0) atomicAdd(km + 32 * bj + 8 * fq + 4 * q + e, s * (1.f / 256.f)); }
    } };

template <class Inner, class = void> struct HasState { static constexpr bool value = false; };
template <class Inner> struct HasState<Inner, decltype((void)sizeof(typename Inner::State))> { static constexpr bool value = true; };
template <class Inner, class = void> struct HasOps { static constexpr bool value = false; };
template <class Inner> struct HasOps<Inner, decltype((void)sizeof(typename Inner::Ops))> { static constexpr bool value = true; };
template <class Inner, class = void> struct HasGains { static constexpr bool value = false; };
template <class Inner> struct HasGains<Inner, decltype((void)&Inner::gains)> { static constexpr bool value = true; };
template <class Inner, class = void> struct HasPre { static constexpr bool value = false; };
template <class Inner> struct HasPre<Inner, decltype((void)&Inner::pre)> { static constexpr bool value = true; };
template <class Inner> struct EpiRow {
    static constexpr bool PERM = true, AFTER_DRAIN = false; Inner in;
    __device__ __forceinline__ void operator()(const pg8::f32x4 (&acc)[2][2][4][2], const pg8::Unit& u, int wr, int wc, int fr, int fq) const {
        if constexpr (HasState<Inner>::value) {
            typename Inner::State st; in.begin(st); Gains G; in.gains(G, u.pn, wc, fq);
            float rs[8];
#pragma unroll
            for (int g = 0; g < 8; ++g) rs[g] = in.pre(u.pm * 256 + (g >> 2) * 128 + wr * 64 + (g & 3) * 16 + fr, fq);
#pragma unroll
            for (int ai = 0; ai < 2; ++ai)
#pragma unroll
                for (int m = 0; m < 4; ++m) { const int row = u.pm * 256 + ai * 128 + wr * 64 + m * 16 + fr;
                    const f32x4 a[2][2] = {{acc[ai][0][m][0], acc[ai][0][m][1]}, {acc[ai][1][m][0], acc[ai][1][m][1]}};
                    in.row(row, u.pn, wc, fq, a, st, rs[ai * 4 + m], G);
                    asm volatile("" ::: "memory"); }
            in.end(st, u.pm, u.pn, wc, fr, fq);
        } else if constexpr (HasOps<Inner>::value) {
            constexpr int D = Inner::DEPTH; typename Inner::Ops ops[8]; float ssk = 0.f;
#define EPI_ROW(g) (u.pm * 256 + ((g) >> 2) * 128 + wr * 64 + ((g) & 3) * 16 + fr)
#pragma unroll
            for (int g = 0; g < D; ++g) in.load(ops[g], EPI_ROW(g), u.pn, wc, fq);
            asm volatile("" ::: "memory");
#pragma unroll
            for (int g = 0; g < 8; ++g) { const int ai = g >> 2, m = g & 3;
                const f32x4 a[2][2] = {{acc[ai][0][m][0], acc[ai][0][m][1]}, {acc[ai][1][m][0], acc[ai][1][m][1]}};
                float ssg = 0.f; in.fin(EPI_ROW(g), u.pn, wc, fq, a, ops[g], ssg);
                ssk = (fq == (g & 3)) ? ssg : ssk;
                if ((g & 3) == 3) in.ss_out(u.pm * 256 + (g >> 2) * 128 + wr * 64 + 16 * fq + fr, u.pn, wc, ssk);
                if (g + D < 8) in.load(ops[g + D], EPI_ROW(g + D), u.pn, wc, fq);
                asm volatile("" ::: "memory"); }
#undef EPI_ROW
        } else if constexpr (HasPre<Inner>::value) {
            float rs[8]; Gains G; if constexpr (HasGains<Inner>::value) in.gains(G, u.pn, wc, fq);
#pragma unroll
            for (int g = 0; g < 8; ++g) rs[g] = in.pre(u.pm * 256 + (g >> 2) * 128 + wr * 64 + (g & 3) * 16 + fr, fq);
#pragma unroll
            for (int ai = 0; ai < 2; ++ai)
#pragma unroll
                for (int m = 0; m < 4; ++m) { const int row = u.pm * 256 + ai * 128 + wr * 64 + m * 16 + fr;
                    const f32x4 a[2][2] = {{acc[ai][0][m][0], acc[ai][0][m][1]}, {acc[ai][1][m][0], acc[ai][1][m][1]}};
                    if constexpr (HasGains<Inner>::value) in.row(row, u.pn, wc, fq, a, rs[ai * 4 + m], G); else in.row(row, u.pn, wc, fq, a, rs[ai * 4 + m]);
                    asm volatile("" ::: "memory"); }
        } else {
            Gains G; if constexpr (HasGains<Inner>::value) in.gains(G, u.pn, wc, fq);
#pragma unroll
            for (int ai = 0; ai < 2; ++ai)
#pragma unroll
                for (int m = 0; m < 4; ++m) { const int row = u.pm * 256 + ai * 128 + wr * 64 + m * 16 + fr;
                    const f32x4 a[2][2] = {{acc[ai][0][m][0], acc[ai][0][m][1]}, {acc[ai][1][m][0], acc[ai][1][m][1]}};
                    if constexpr (HasGains<Inner>::value) in.row(row, u.pn, wc, fq, a, G); else in.row(row, u.pn, wc, fq, a);
                    asm volatile("" ::: "memory"); }
        }
    }
};
template <class Inner> __device__ __forceinline__ void run_gemm(const Frame& F, const bf16* A, int lda, const bf16* Bt, int N, int K, const Inner& in, int rot = 0) {
    int bid_ = blockIdx.x; asm volatile("" : "+s"(bid_));
    { int c_ = bid_ + rot; if (c_ >= F.G) c_ -= F.G; bid_ = c_; }
    pg8::Gemm g{A, Bt, M, N, K, lda}; pg8::StaticOrder S; S.init(M, N, F.G, bid_);
    EpiRow<Inner> E{in};
    pg8::gemm_phase<EpiRow<Inner>, pg8::StaticOrder, true, GEMM_SP2>(F.lds, g, S, E);
}

__device__ __forceinline__ int head_row(int tile, int h, int d) { return tile * 256 + 32 * (h & 3) + (d & 31) + 128 * (d >> 5); }
__device__ __forceinline__ int perm_ine(int n) {
    if (n < 384) return n;
    if (n < 640) return 512 + (n - 384);
    if (n < 672) return 384 + (n - 640);
    const int x = n - 672, sec = x >> 9, h = (x >> 6) & 7, d = x & 63; return head_row(3 + 2 * sec + (h >> 2), h, d);
}
__device__ __forceinline__ int perm_uq(int n) { const int h = n / 96, r = n - 96 * h; if (r < 64) return head_row(h >> 2, h, r); return 512 + 128 * (h >> 2) + 32 * (h & 3) + (r - 64); }
__device__ __forceinline__ int perm_ukv(int n) { const int h = n >> 7, part = (n >> 6) & 1, d = n & 63; return head_row(2 * part + (h >> 2), h, d); }
__device__ __forceinline__ int perm_ino(int n) { const int sec = n >> 10, h = (n >> 6) & 15, d = n & 63; return head_row(4 * sec + (h >> 2), h, d); }
struct RowId { __device__ __forceinline__ int operator()(int n) const { return n; } };
template <class RowMap> __device__ __forceinline__ void p0_transpose_item(const float* W, int K, int N, bf16* WT, LAS float* scr, int item, int lane, const RowMap& rm, const float* gk = nullptr) {
    const int nblk = N / 32, kb = item / nblk, nb = item % nblk, k0 = 64 * kb, n0 = 32 * nb;
    { const int r8 = lane >> 3, c4 = (lane & 7) * 4; f32x4 v[8]; float gs[8];
#pragma unroll
      for (int i = 0; i < 8; ++i) { const int kk = 8 * i + r8; v[i] = __builtin_nontemporal_load((const GAS f32x4*)((const GAS float*)W + (size_t)(k0 + kk) * N + n0 + c4)); gs[i] = gk ? ((const GAS float*)gk)[k0 + kk] : 1.f; }
#pragma unroll
      for (int i = 0; i < 8; ++i) { LAS float* d = scr + (8 * i + r8) * 33 + c4; d[0] = v[i][0] * gs[i]; d[1] = v[i][1] * gs[i]; d[2] = v[i][2] * gs[i]; d[3] = v[i][3] * gs[i]; } }
    LDS_WAIT(); asm volatile("" ::: "memory");
    const int c = lane & 7;
#pragma unroll
    for (int j = 0; j < 4; ++j) { const int n = (lane >> 3) + 8 * j; const LAS float* s = scr + (8 * c) * 33 + n;
        u32x4 o; o.x = pk2(s[0 * 33], s[1 * 33]); o.y = pk2(s[2 * 33], s[3 * 33]); o.z = pk2(s[4 * 33], s[5 * 33]); o.w = pk2(s[6 * 33], s[7 * 33]);
        *(GAS u32x4*)(WT + (size_t)rm(n0 + n) * K + k0 + 8 * c) = o; }
    LDS_WAIT(); asm volatile("" ::: "memory");
}
template <int NR> __device__ __forceinline__ void rms_rows_1024(const float* x0, size_t rstride, const float* g, bf16* o0, int lane) {
    const GAS f32x4* gr = (const GAS f32x4*)g + lane;
    f32x4 v[NR][4]; float s[NR];
#pragma unroll
    for (int r = 0; r < NR; ++r) { const GAS f32x4* xr = (const GAS f32x4*)(x0 + r * rstride) + lane; s[r] = 0.f;
#pragma unroll
        for (int j = 0; j < 4; ++j) v[r][j] = __builtin_nontemporal_load(xr + 64 * j); }
    f32x4 gg[4];
#pragma unroll
    for (int j = 0; j < 4; ++j) gg[j] = gr[64 * j];
#pragma unroll
    for (int r = 0; r < NR; ++r) {
#pragma unroll
        for (int j = 0; j < 4; ++j) s[r] += (v[r][j].x * v[r][j].x + v[r][j].y * v[r][j].y) + (v[r][j].z * v[r][j].z + v[r][j].w * v[r][j].w);
        const float rstd = rsq(wave_sum(s[r]) * (1.f / DM) + EPS);
        GAS u32x2* o8 = (GAS u32x2*)(o0 + r * rstride) + lane;
#pragma unroll
        for (int j = 0; j < 4; ++j) { u32x2 w; w.x = pk2(v[r][j].x * rstd * gg[j].x, v[r][j].y * rstd * gg[j].y); w.y = pk2(v[r][j].z * rstd * gg[j].z, v[r][j].w * rstd * gg[j].w); o8[64 * j] = w; } }
}
__device__ __forceinline__ void rms_rows_phase(const Frame& F, const float* src, const float* g, bf16* dst) {
    const int gw = F.vcu * NWAVES + F.wave, NGW = F.G * NWAVES;
    int m = gw;
    for (; m + 3 * NGW < M; m += 4 * NGW) rms_rows_1024<4>(src + (size_t)m * DM, (size_t)NGW * DM, g, dst + (size_t)m * DM, F.lane);
    for (; m < M; m += NGW) rms_rows_1024<1>(src + (size_t)m * DM, (size_t)NGW * DM, g, dst + (size_t)m * DM, F.lane);
}
__device__ __forceinline__ void pb_phase(const Frame& F, const float* p, bf16* PB) {
    const size_t n8 = (size_t)M * PLE / 8; const size_t gt = (size_t)F.vcu * NTHR + F.tid, ngt = (size_t)F.G * NTHR;
    for (size_t i = gt; i < n8; i += ngt) { const f32x4 a = ((const GAS f32x4*)p)[2 * i], b = ((const GAS f32x4*)p)[2 * i + 1];
        u32x4 w; w.x = pk2(a.x, a.y); w.y = pk2(a.z, a.w); w.z = pk2(b.x, b.y); w.w = pk2(b.z, b.w); ((GAS u32x4*)PB)[i] = w; }
}
__constant__ double INVF4[4] = {1.0, 0.5623413251903491, 0.31622776601683794, 0.1778279410038923};
__constant__ double INVF10[4] = {1.0, 0.1, 0.01, 0.001};
__constant__ unsigned long long MOBA_OB[16] = {0x5fdc94e12a067b38ull, 0xe3ab421d5f6c9078ull, 0x64f81dc0e352ab79ull, 0xfa2b948ce756d013ull, 0x72cdb63954108feaull, 0xb46a83512cf09de7ull, 0x9bd32e6804ca5f17ull, 0x30186faec5794b2dull,
                                               0x97acdef8465b3012ull, 0xba12d0c5396874feull, 0x7e5c14af3d9b0268ull, 0x6a32450789b1dcefull, 0xfedc9b7864a51230ull, 0x31bfcd24e69a7850ull, 0x73c16b58d042ef9aull, 0x017563c4982fbedaull};

#define WITEMG(IDX, SUB, KK, NN, DST, RM, GK) { constexpr int cnt_ = ((KK) / 64) * ((NN) / 32); if (r < cnt_) { p0_transpose_item(as_global((const float*)AP->in[IDX]) + (SUB), (KK), (NN), Wb + (DST), scr, r, F.lane, RM, GK); continue; } r -= cnt_; }
#define WITEMP(IDX, SUB, KK, NN, DST, RM) WITEMG(IDX, SUB, KK, NN, DST, RM, (const float*)nullptr)
#define WITEM(IDX, SUB, KK, NN, DST) WITEMP(IDX, SUB, KK, NN, DST, RmPlain{})
struct RmPlain { __device__ __forceinline__ int operator()(int n) const { const int c = n & 255; return (n & ~255) + 128 * ((c >> 5) & 1) + 32 * (c >> 6) + (c & 31); } };
struct RmInE { __device__ __forceinline__ int operator()(int n) const { return perm_ine(n); } };
struct RmUq  { __device__ __forceinline__ int operator()(int n) const { return perm_uq(n); } };
struct RmUkv { __device__ __forceinline__ int operator()(int n) const { return perm_ukv(n); } };
struct RmInO { __device__ __forceinline__ int operator()(int n) const { return perm_ino(n); } };
constexpr int WITEMS_P0 = (1024 / 64) * (E_IN / 32) + (384 / 64) * (768 / 32) + (256 / 64) * (1024 / 32);
constexpr int WITEMS_TOTAL = (1024 / 64) * (E_IN / 32) + (384 / 64) * (768 / 32) + (256 / 64) * (1024 / 32) + (1024 / 64) * (1024 / 32) + (1024 / 64) * (3072 / 32) + (1024 / 64) * (1024 / 32)
                           + 2 * (1024 / 64) * (4096 / 32) + 2 * (4096 / 64) * (1024 / 32) + 2 * (1024 / 64) * (1024 / 32) + 2 * (256 / 64) * (1024 / 32);


namespace att {
typedef short bf16x8 __attribute__((ext_vector_type(8)));
typedef short s16x4 __attribute__((ext_vector_type(4)));
typedef float f32x16 __attribute__((ext_vector_type(16)));
typedef float f32x2_t __attribute__((ext_vector_type(2)));
typedef __bf16 bf16x2_t __attribute__((ext_vector_type(2)));
typedef LAS const char* lds_cptr;
constexpr int KSLOT_B = 12288, VSLOT_B = 8192;
constexpr int LDS_K = 0, LDS_V = 4 * KSLOT_B, LDS_WS = LDS_V + 3 * VSLOT_B, LDS_OST = LDS_WS + 8 * 256, LDS_ATT_BYTES = LDS_OST + 8 * 4096;
#define ATT_SBAR() __builtin_amdgcn_sched_barrier(0)
#if ATT_PROBE == 6
#define ATT_WAIT_BAR() asm volatile("s_waitcnt vmcnt(0) lgkmcnt(0)\n\ts_barrier\n\ts_barrier" ::: "memory")
#else
#define ATT_WAIT_BAR() asm volatile("s_waitcnt vmcnt(0) lgkmcnt(0)\n\ts_barrier" ::: "memory")
#endif
__device__ __forceinline__ void wait_bar_n(int n) {
    if (n <= 0)      asm volatile("s_waitcnt vmcnt(0) lgkmcnt(0)\n\ts_barrier" ::: "memory");
    else if (n == 1) asm volatile("s_waitcnt vmcnt(1) lgkmcnt(0)\n\ts_barrier" ::: "memory");
    else if (n == 2) asm volatile("s_waitcnt vmcnt(2) lgkmcnt(0)\n\ts_barrier" ::: "memory");
    else             asm volatile("s_waitcnt vmcnt(3) lgkmcnt(0)\n\ts_barrier" ::: "memory");
}
__device__ __forceinline__ int crow(int r, int hi) { return (r & 3) + 8 * (r >> 2) + 4 * hi; }
__device__ __forceinline__ void glds16(const void* gsrc, unsigned lds_dst) { unsigned keep;
    asm volatile("s_mov_b32 %0, m0\n\ts_mov_b32 m0, %2\n\ts_nop 0\n\tglobal_load_lds_dwordx4 %1, off\n\ts_mov_b32 m0, %0" : "=&s"(keep) : "v"(gsrc), "s"(lds_dst) : "memory"); }
__device__ __forceinline__ unsigned cvtpk(float lo, float hi) { f32x2_t v = {lo, hi}; bf16x2_t b = __builtin_convertvector(v, bf16x2_t); return __builtin_bit_cast(unsigned, b); }

template <int NKS> __device__ __forceinline__ void qk_tile(f32x16& p0, f32x16& p1, lds_cptr kslot, const bf16x8* qr, const f32x16& c0, const f32x16& c1, int r32, int hi) {
    lds_cptr kb = kslot + hi * 1024 + r32 * 16;
#pragma unroll
    for (int d0 = 0; d0 < NKS; ++d0) {
        const bf16x8 b0 = *(const LAS bf16x8*)(kb + d0 * 2048), b1 = *(const LAS bf16x8*)(kb + d0 * 2048 + 512);
        if (d0 == 0) { p0 = __builtin_amdgcn_mfma_f32_32x32x16_bf16(b0, qr[0], c0, 0, 0, 0); p1 = __builtin_amdgcn_mfma_f32_32x32x16_bf16(b1, qr[0], c1, 0, 0, 0); }
        else { p0 = __builtin_amdgcn_mfma_f32_32x32x16_bf16(b0, qr[d0], p0, 0, 0, 0); p1 = __builtin_amdgcn_mfma_f32_32x32x16_bf16(b1, qr[d0], p1, 0, 0, 0); }
#if ATT_PROBE == 2
        { static_assert(NKS >= 4, ""); if (d0 < 4) { f32x16 z0 = __builtin_amdgcn_mfma_f32_32x32x16_bf16(b1, qr[d0], c0, 0, 0, 0), z1 = __builtin_amdgcn_mfma_f32_32x32x16_bf16(b0, qr[d0], c1, 0, 0, 0); asm volatile("" :: "v"(z0), "v"(z1)); } }
#endif
    }
}
__device__ __forceinline__ void exp_pack(f32x16& p0, f32x16& p1, float& lsum, bf16x8 (&pa)[4]) {
    float s0 = 0.f, s1 = 0.f;
#pragma unroll
    for (int r = 0; r < 16; ++r) { p0[r] = __builtin_amdgcn_exp2f(p0[r]); p1[r] = __builtin_amdgcn_exp2f(p1[r]); s0 += p0[r]; s1 += p1[r]; }
    lsum += s0 + s1;
#if ATT_PROBE == 1
    { float dm = 0.f;
#pragma unroll
      for (int r = 0; r < 16; ++r) { dm += __builtin_amdgcn_exp2f(p0[r] * 0.5f); dm += __builtin_amdgcn_exp2f(p1[r] * 0.5f); }
      asm volatile("" :: "v"(dm)); }
#endif
    u32x4 w0, w1, w2, w3;
#pragma unroll
    for (int e = 0; e < 4; ++e) { w0[e] = cvtpk(p0[2 * e], p0[2 * e + 1]); w1[e] = cvtpk(p0[8 + 2 * e], p0[8 + 2 * e + 1]); w2[e] = cvtpk(p1[2 * e], p1[2 * e + 1]); w3[e] = cvtpk(p1[8 + 2 * e], p1[8 + 2 * e + 1]); }
    pa[0] = __builtin_bit_cast(bf16x8, w0); pa[1] = __builtin_bit_cast(bf16x8, w1); pa[2] = __builtin_bit_cast(bf16x8, w2); pa[3] = __builtin_bit_cast(bf16x8, w3);
}
struct VFrag { s16x4 lo[8], hi[8]; };
__device__ __forceinline__ void v_issue(VFrag& f, int vb) {
#pragma unroll
    for (int d0 = 0; d0 < 2; ++d0)
#pragma unroll
        for (int ks = 0; ks < 4; ++ks) {
            asm volatile("ds_read_b64_tr_b16 %0,%1 offset:%c2" : "=&v"(f.lo[d0 * 4 + ks]) : "v"(vb), "i"(d0 * 4096 + ks * 1024) : "memory");
            asm volatile("ds_read_b64_tr_b16 %0,%1 offset:%c2" : "=&v"(f.hi[d0 * 4 + ks]) : "v"(vb), "i"(d0 * 4096 + ks * 1024 + 512) : "memory"); }
}
__device__ __forceinline__ void pv_mfma(f32x16* o, VFrag& f, const bf16x8 (&pa)[4]) {
    asm volatile("s_waitcnt lgkmcnt(0)" : "+v"(f.lo[0]), "+v"(f.lo[1]), "+v"(f.lo[2]), "+v"(f.lo[3]), "+v"(f.lo[4]), "+v"(f.lo[5]), "+v"(f.lo[6]), "+v"(f.lo[7]),
                                          "+v"(f.hi[0]), "+v"(f.hi[1]), "+v"(f.hi[2]), "+v"(f.hi[3]), "+v"(f.hi[4]), "+v"(f.hi[5]), "+v"(f.hi[6]), "+v"(f.hi[7]) :: "memory");
    ATT_SBAR();
#define ATT_PK(k) (bf16x8){f.lo[k][0], f.lo[k][1], f.lo[k][2], f.lo[k][3], f.hi[k][0], f.hi[k][1], f.hi[k][2], f.hi[k][3]}
    __builtin_amdgcn_s_setprio(1);
    o[0] = __builtin_amdgcn_mfma_f32_32x32x16_bf16(pa[0], ATT_PK(0), o[0], 0, 0, 0);
    o[1] = __builtin_amdgcn_mfma_f32_32x32x16_bf16(pa[0], ATT_PK(4), o[1], 0, 0, 0);
    o[0] = __builtin_amdgcn_mfma_f32_32x32x16_bf16(pa[1], ATT_PK(1), o[0], 0, 0, 0);
    o[1] = __builtin_amdgcn_mfma_f32_32x32x16_bf16(pa[1], ATT_PK(5), o[1], 0, 0, 0);
    o[0] = __builtin_amdgcn_mfma_f32_32x32x16_bf16(pa[2], ATT_PK(2), o[0], 0, 0, 0);
    o[1] = __builtin_amdgcn_mfma_f32_32x32x16_bf16(pa[2], ATT_PK(6), o[1], 0, 0, 0);
    o[0] = __builtin_amdgcn_mfma_f32_32x32x16_bf16(pa[3], ATT_PK(3), o[0], 0, 0, 0);
    o[1] = __builtin_amdgcn_mfma_f32_32x32x16_bf16(pa[3], ATT_PK(7), o[1], 0, 0, 0);
    __builtin_amdgcn_s_setprio(0);
#undef ATT_PK
}
__device__ __forceinline__ void cmask(f32x16& p0, f32x16& p1, int kvb, int qrel, int hi) {
#pragma unroll
    for (int r = 0; r < 16; ++r) { const int kv = kvb + crow(r, hi); if (kv > qrel) p0[r] = -INFINITY; if (kv + 32 > qrel) p1[r] = -INFINITY; }
}
__device__ __forceinline__ void bmask(f32x16& p0, f32x16& p1, int kvb, int qrel, int hi) {
#pragma unroll
    for (int r = 0; r < 16; ++r) { const int d = qrel - (kvb + crow(r, hi)); if (d < 0 || d > 128) p0[r] = -INFINITY; if (d - 32 < 0 || d - 32 > 128) p1[r] = -INFINITY; }
}
#define ATT_PIN(x) asm volatile("" : "+v"(x))
__device__ __forceinline__ float pcat(const f32x16& P0, const f32x16& P1, int i) { return (i < 16) ? P0[i] : P1[i - 16]; }
__device__ __forceinline__ s16x4 vtr(lds_cptr p) { return __builtin_bit_cast(s16x4, __builtin_amdgcn_ds_read_tr16_b64_v4i16((LAS s16x4*)p)); }
__device__ __forceinline__ void kload2(bf16x8* kf, lds_cptr kp, int d0) { kf[2 * d0] = *(const LAS bf16x8*)(kp + d0 * 2048); kf[2 * d0 + 1] = *(const LAS bf16x8*)(kp + d0 * 2048 + 512); }
__device__ __forceinline__ void kload2s(bf16x8* kf, lds_cptr kb, const int* koff, int d0) { kf[2 * d0] = *(const LAS bf16x8*)(kb + koff[d0]); kf[2 * d0 + 1] = *(const LAS bf16x8*)(kb + koff[d0] + 4096); }
__device__ __forceinline__ void swz_dma_lane(int wid, int lane, int& row, int& chunk) { row = 8 * wid + (lane >> 3); chunk = (lane & 7) ^ (((lane >> 4) & 3) | ((wid & 1) << 2)); }
__device__ __forceinline__ void swz_koff(int r32, int hi, int (&koff)[4]) { const int t = ((r32 & 7) >> 1) | (((r32 >> 3) & 1) << 2), b = 128 * r32 + 16 * (hi ^ (t & 1)), x = 32 * (t >> 1);
#pragma unroll
    for (int d0 = 0; d0 < 4; ++d0) koff[d0] = b + (x ^ (32 * d0)); }
template <int NKS, bool HASPREV, bool DOQK, bool CZERO, bool MASKED, bool SWZ = false>
__device__ __forceinline__ void att_pa(f32x16& C0, f32x16& C1, const f32x16& P0, const f32x16& P1, float& lsum, bf16x8* kf, lds_cptr kcp, s16x4* vlo, s16x4* vhi, u32x4* pw, lds_cptr vp,
                                       const bf16x8* qr, int jb, int qrel, int hi, const int* roff = nullptr) {
    float sacc = 0.f;
    ATT_SBAR();
#pragma unroll
    for (int i = 0; i < (DOQK ? 2 * NKS : 8); ++i) {
        if constexpr (HASPREV) { if (i < 8) { const int f = (i >> 1) + 4 * (i & 1); vlo[f] = vtr(vp + (f >> 2) * 4096 + (f & 3) * 1024); vhi[f] = vtr(vp + (f >> 2) * 4096 + (f & 3) * 1024 + 512); ATT_SBAR(); } }
        if constexpr (DOQK) { const int d0 = i >> 1;
            if (i >= 4 && i + 4 < 2 * NKS) {
                if constexpr (SWZ) kf[i + 4] = *(const LAS bf16x8*)(kcp + roff[((i + 4) >> 1) - 4] + ((i + 4) & 1) * 2048);
                else kf[i + 4] = *(const LAS bf16x8*)(kcp + ((i + 4) >> 1) * 2048 + ((i + 4) & 1) * 512); }
            if (i & 1) { if (CZERO && d0 == 0) C1 = __builtin_amdgcn_mfma_f32_32x32x16_bf16(kf[i], qr[d0], f32x16{}, 0, 0, 0); else C1 = __builtin_amdgcn_mfma_f32_32x32x16_bf16(kf[i], qr[d0], C1, 0, 0, 0); }
            else         { if (CZERO && d0 == 0) C0 = __builtin_amdgcn_mfma_f32_32x32x16_bf16(kf[i], qr[d0], f32x16{}, 0, 0, 0); else C0 = __builtin_amdgcn_mfma_f32_32x32x16_bf16(kf[i], qr[d0], C0, 0, 0, 0); } }
        if constexpr (HASPREV) { if (i < 8) {
#pragma unroll
            for (int k = 0; k < 4; ++k) sacc += pcat(P0, P1, 4 * i + k);
            ATT_PIN(sacc);
#pragma unroll
            for (int k = 0; k < 2; ++k) { const int j = 2 * i + k; pw[j >> 2][j & 3] = cvtpk(pcat(P0, P1, 2 * j), pcat(P0, P1, 2 * j + 1)); }
            ATT_PIN(pw[(2 * i) >> 2]); } }
        ATT_SBAR();
    }
    lsum += sacc;
    if constexpr (DOQK && MASKED) cmask(C0, C1, 64 * jb, qrel, hi);
    ATT_SBAR();
}
#define ATT_FMK(d, CR, sl, base) asm volatile("v_fmamk_f32 %0, %1, %2, %3" : "=v"(d) : "v"(sl), "n"(__builtin_bit_cast(unsigned, (float)(CR))), "v"(base))
template <int NKS, bool HASPREV, bool DOQK, bool BIASNEXT, bool GL, int I, bool SWZ>
__device__ __forceinline__ void att_pb_gap(f32x16& C0, f32x16& C1, f32x16& P0, f32x16& P1, f32x16* o, bf16x8* kf, const s16x4* vlo, const s16x4* vhi, const u32x4* pw, lds_cptr knp,
                                           float sl, float basen, float base32, const int* koff) {
#define ATT_PK(k) (bf16x8){vlo[k][0], vlo[k][1], vlo[k][2], vlo[k][3], vhi[k][0], vhi[k][1], vhi[k][2], vhi[k][3]}
    constexpr int G0 = 2;
    if constexpr (GL && I >= G0 && I < G0 + 4) { if constexpr (SWZ) kload2s(kf, knp, koff, I - G0); else kload2(kf, knp, I - G0); ATT_SBAR(); }
    if constexpr (HASPREV) { constexpr int ks = I >> 1, d0 = I & 1; o[d0] = __builtin_amdgcn_mfma_f32_32x32x16_bf16(__builtin_bit_cast(bf16x8, pw[ks]), ATT_PK(d0 * 4 + ks), o[d0], 0, 0, 0); }
    if constexpr (DOQK) {
        if constexpr (I < 4) {
#pragma unroll
            for (int k = 0; k < 4; ++k) C0[4 * I + k] = __builtin_amdgcn_exp2f(C0[4 * I + k]);
            ATT_PIN(C0); }
        else {
#pragma unroll
            for (int k = 0; k < 4; ++k) C1[4 * (I - 4) + k] = __builtin_amdgcn_exp2f(C1[4 * (I - 4) + k]);
            ATT_PIN(C1); } }
    if constexpr (BIASNEXT) {
        if constexpr (I < 4) { float d0_, d1_, d2_, d3_;
            ATT_FMK(d0_, 8 * I + 0, sl, basen); ATT_FMK(d1_, 8 * I + 1, sl, basen); ATT_FMK(d2_, 8 * I + 2, sl, basen); ATT_FMK(d3_, 8 * I + 3, sl, basen);
            P0[4 * I + 0] = d0_; P0[4 * I + 1] = d1_; P0[4 * I + 2] = d2_; P0[4 * I + 3] = d3_; ATT_PIN(P0); }
        else { constexpr int J = I - 4; float d0_, d1_, d2_, d3_;
            ATT_FMK(d0_, 8 * J + 0, sl, base32); ATT_FMK(d1_, 8 * J + 1, sl, base32); ATT_FMK(d2_, 8 * J + 2, sl, base32); ATT_FMK(d3_, 8 * J + 3, sl, base32);
            P1[4 * J + 0] = d0_; P1[4 * J + 1] = d1_; P1[4 * J + 2] = d2_; P1[4 * J + 3] = d3_; ATT_PIN(P1); } }
    ATT_SBAR();
#undef ATT_PK
}
template <int NKS, bool HASPREV, bool DOQK, bool BIASNEXT, bool GL, bool SWZ = false>
__device__ __forceinline__ void att_pb(f32x16& C0, f32x16& C1, f32x16& P0, f32x16& P1, f32x16* o, bf16x8* kf, const s16x4* vlo, const s16x4* vhi, const u32x4* pw, lds_cptr knp,
                                       float sl, float basen, float step32, const int* koff = nullptr) {
    const float base32 = basen + step32;
#define ATT_GAPB(I) att_pb_gap<NKS, HASPREV, DOQK, BIASNEXT, GL, I, SWZ>(C0, C1, P0, P1, o, kf, vlo, vhi, pw, knp, sl, basen, base32, koff)
    ATT_GAPB(0); ATT_GAPB(1); ATT_GAPB(2); ATT_GAPB(3); ATT_GAPB(4); ATT_GAPB(5); ATT_GAPB(6); ATT_GAPB(7);
#undef ATT_GAPB
}
#define ATT_WAITN(n) do { if ((n) <= 0) asm volatile("s_waitcnt vmcnt(0) lgkmcnt(0)\n\ts_barrier" ::: "memory"); else if ((n) == 1) asm volatile("s_waitcnt vmcnt(1) lgkmcnt(0)\n\ts_barrier" ::: "memory"); \
        else if ((n) == 2) asm volatile("s_waitcnt vmcnt(2) lgkmcnt(0)\n\ts_barrier" ::: "memory"); else asm volatile("s_waitcnt vmcnt(3) lgkmcnt(0)\n\ts_barrier" ::: "memory"); } while (0)
__device__ __forceinline__ float finish_l(float lsum) { return sum_xor32(lsum); }
template <class RowPtr> __device__ __forceinline__ void store_o2(const f32x16* o, float ltot, LAS unsigned char* wsb, LAS unsigned char* ostb, int wid, int lane, const RowPtr& orow) {
    const int r32 = lane & 31, hi = lane >> 5;
    LAS float* wsf = (LAS float*)wsb + wid * 64;
    if (hi == 0) wsf[r32] = ltot;
    asm volatile("s_waitcnt lgkmcnt(0)" ::: "memory");
    float rli[16];
#pragma unroll
    for (int r = 0; r < 16; ++r) rli[r] = __builtin_amdgcn_rcpf(wsf[crow(r, hi)]);
    LAS bf16* stg = (LAS bf16*)ostb + wid * 2048;
#pragma unroll
    for (int r = 0; r < 16; ++r) { const int orw = crow(r, hi);
#pragma unroll
        for (int d0 = 0; d0 < 2; ++d0) stg[orw * 64 + d0 * 32 + r32] = (bf16)f2bf(o[d0][r] * rli[r]); }
    asm volatile("s_waitcnt lgkmcnt(0)" ::: "memory");
#pragma unroll
    for (int i = 0; i < 4; ++i) { const int row = i * 8 + (lane >> 3), ch = lane & 7; const u32x4 v = *(const LAS u32x4*)(stg + row * 64 + ch * 8); __builtin_nontemporal_store(v, (GAS u32x4*)(orow(row) + ch * 8)); }
}
template <class RowPtr> __device__ __forceinline__ void store_o(const f32x16* o, float ltot, LAS unsigned char* shm, int wid, int lane, const RowPtr& orow) { store_o2(o, ltot, shm + LDS_WS, shm + LDS_OST, wid, lane, orow); }
template <class RowPtrB, class RowPtrO, class RowIdx>
__device__ __forceinline__ void store_merge2(const f32x16* o, float ltot, LAS unsigned char* wsb, LAS unsigned char* ostb, int wid, int lane, const RowPtrB& ob1, const RowPtrB& ob2, const float* l1p, const float* l2p,
                                            const RowIdx& lrow, const RowPtrO& orow) {
    const int r32 = lane & 31, hi = lane >> 5;
    LAS float* wsf = (LAS float*)wsb + wid * 64;
    if (hi == 0) wsf[r32] = ltot;
    LAS float* stg = (LAS float*)ostb + wid * 1024;
#pragma unroll
    for (int d0 = 0; d0 < 2; ++d0) {
#pragma unroll
        for (int r = 0; r < 16; ++r) stg[crow(r, hi) * 32 + r32] = o[d0][r];
        asm volatile("s_waitcnt lgkmcnt(0)" ::: "memory");
#pragma unroll
        for (int i = 0; i < 2; ++i) { const int row = i * 16 + (lane >> 2), ch = lane & 3, col = d0 * 32 + ch * 8;
            const f32x4 a0 = *(const LAS f32x4*)(stg + row * 32 + ch * 8), a1 = *(const LAS f32x4*)(stg + row * 32 + ch * 8 + 4);
            const float l3 = wsf[row], l1 = ((const GAS float*)l1p)[lrow(row)], l2 = ((const GAS float*)l2p)[lrow(row)];
            const u32x4 w1 = *(const GAS u32x4*)(ob1(row) + col), w2 = *(const GAS u32x4*)(ob2(row) + col);
            const float rl = __builtin_amdgcn_rcpf(l1 + l2 + l3); u32x4 ow;
#pragma unroll
            for (int e = 0; e < 4; ++e) { const float x0 = (e < 2 ? a0[2 * e] : a1[2 * e - 4]), x1 = (e < 2 ? a0[2 * e + 1] : a1[2 * e - 3]);
                ow[e] = pk2((l1 * bf_lo(w1[e]) + l2 * bf_lo(w2[e]) + x0) * rl, (l1 * bf_hi(w1[e]) + l2 * bf_hi(w2[e]) + x1) * rl); }
            *(GAS u32x4*)(orow(row) + col) = ow; }
        asm volatile("s_waitcnt lgkmcnt(0)" ::: "memory");
    }
}
struct MergeOps { u32x4 w1[4], w2[4]; float l1[4], l2[4]; };
template <class RowPtrB, class RowIdx>
__device__ __forceinline__ void merge_load(MergeOps& m, int lane, const RowPtrB& ob1, const RowPtrB& ob2, const float* l1p, const float* l2p, const RowIdx& lrow) {
#pragma unroll
    for (int i = 0; i < 4; ++i) { const int row = i * 8 + (lane >> 3), col = (lane & 7) * 8;
        m.l1[i] = ((const GAS float*)l1p)[lrow(row)]; m.l2[i] = ((const GAS float*)l2p)[lrow(row)];
        m.w1[i] = *(const GAS u32x4*)(ob1(row) + col); m.w2[i] = *(const GAS u32x4*)(ob2(row) + col); }
}
template <class RowPtrO>
__device__ __forceinline__ void merge_finish(const f32x16* o, float ltot, LAS unsigned char* wsb, LAS unsigned char* ostb, int wid, int lane, const MergeOps& m, const RowPtrO& orow) {
    const int r32 = lane & 31, hi = lane >> 5;
    LAS float* wsf = (LAS float*)wsb + wid * 64;
    if (hi == 0) wsf[r32] = ltot;
    asm volatile("s_waitcnt lgkmcnt(0)" ::: "memory");
    float rli[16];
#pragma unroll
    for (int r = 0; r < 16; ++r) rli[r] = __builtin_amdgcn_rcpf(wsf[crow(r, hi)]);
    LAS bf16* stg = (LAS bf16*)ostb + wid * 2048;
#pragma unroll
    for (int r = 0; r < 16; ++r) { const int orw = crow(r, hi);
#pragma unroll
        for (int d0 = 0; d0 < 2; ++d0) stg[orw * 64 + d0 * 32 + r32] = (bf16)f2bf(o[d0][r] * rli[r]); }
    asm volatile("s_waitcnt lgkmcnt(0)" ::: "memory");
#pragma unroll
    for (int i = 0; i < 4; ++i) { const int row = i * 8 + (lane >> 3), ch = lane & 7;
        const u32x4 v = *(const LAS u32x4*)(stg + row * 64 + ch * 8); const float l3 = wsf[row], l1 = m.l1[i], l2 = m.l2[i];
        const u32x4 w1 = m.w1[i], w2 = m.w2[i];
        const float rl = __builtin_amdgcn_rcpf(l1 + l2 + l3); u32x4 ow;
#pragma unroll
        for (int e = 0; e < 4; ++e) ow[e] = pk2((l1 * bf_lo(w1[e]) + l2 * bf_lo(w2[e]) + l3 * bf_lo(v[e])) * rl, (l1 * bf_hi(w1[e]) + l2 * bf_hi(w2[e]) + l3 * bf_hi(v[e])) * rl);
        *(GAS u32x4*)(orow(row) + ch * 8) = ow; }
}
template <class RowPtrB, class RowPtrO, class RowIdx>
__device__ __forceinline__ void store_merge(const f32x16* o, float ltot, LAS unsigned char* shm, int wid, int lane, const RowPtrB& ob1, const RowPtrB& ob2, const float* l1p, const float* l2p,
                                            const RowIdx& lrow, const RowPtrO& orow) { store_merge2(o, ltot, shm + LDS_WS, shm + LDS_OST, wid, lane, ob1, ob2, l1p, l2p, lrow, orow); }
}


namespace att {
struct RowLin { bf16* base; size_t pitch; __device__ __forceinline__ bf16* operator()(int i) const { return base + (size_t)i * pitch; } };
#define ATT_RFL(x) ((unsigned)__builtin_amdgcn_readfirstlane((int)(x)))

__device__ __forceinline__ void mla_unit(LAS unsigned char* shm, int b, int h, int qb, const bf16* QA, const bf16* KVA, const bf16* Z, bf16* MIXED, int tid_in) {
    int tid = tid_in; asm volatile("" : "+v"(tid));
    const int lane = tid & 63, r32 = lane & 31, hi = lane >> 5; const int wid = __builtin_amdgcn_readfirstlane(tid >> 6);
    const unsigned lds0 = (unsigned)(uintptr_t)shm;
    const size_t rowbase = (size_t)b * SEQ; const int q0 = qb * 256;
    int dl_row, dl_chunk; swz_dma_lane(wid, lane, dl_row, dl_chunk); int koff[4]; swz_koff(r32, hi, koff);
    int roff[2]; { const int t_ = (r32 >> 2) & 3; roff[0] = 8192 + 64 * r32 + 16 * (hi ^ t_); roff[1] = 8192 + 64 * r32 + 16 * ((2 + hi) ^ t_); }
    const bf16* ksrcN = KVA + (rowbase + dl_row) * KVA_N + h * 128 + dl_chunk * 8;
    const bf16* ksrcR = Z + (rowbase + 16 * (wid & 3) + (lane >> 2)) * E_INP + ZC_KR + ((lane & 3) ^ ((lane >> 4) & 3)) * 8;
    const bf16* vsrc = KVA + (rowbase + 16 * (wid & 3) + (lane >> 2)) * KVA_N + h * 128 + 64 + (wid >> 2) * 32 + (lane & 3) * 8;
#define MLA_DMAK(t, slot) do { glds16(ksrcN + (size_t)(t) * 64 * KVA_N, ATT_RFL(lds0 + LDS_K + (slot) * KSLOT_B + wid * 1024)); \
        if (wid < 4) glds16(ksrcR + (size_t)(t) * 64 * E_INP, ATT_RFL(lds0 + LDS_K + (slot) * KSLOT_B + (8 + wid) * 1024)); } while (0)
#define MLA_DMAV(t, slot) glds16(vsrc + (size_t)(t) * 64 * KVA_N, ATT_RFL(lds0 + LDS_V + (slot) * VSLOT_B + wid * 1024))
    MLA_DMAK(0, 0); MLA_DMAK(1, 1); MLA_DMAV(0, 0); MLA_DMAK(2, 2);
    const bf16* Qw = QA + (rowbase + q0 + wid * 32 + r32) * QA_N + h * 96 + hi * 8;
    bf16x8 qr[6];
#pragma unroll
    for (int d0 = 0; d0 < 6; ++d0) qr[d0] = *(const GAS bf16x8*)(Qw + d0 * 16);
    f32x16 o[2]; o[0] = f32x16{}; o[1] = f32x16{}; float lsum = 0.f;
    const int NT = 4 * qb + 4, qrel = wid * 32 + r32;
    const lds_cptr vp0 = (lds_cptr)(shm + LDS_V) + ((lane >> 4) & 1) * 32 + (lane & 3) * 8 + (4 * hi + ((lane & 15) >> 2)) * 64;
    const lds_cptr ks0 = (lds_cptr)(shm + LDS_K);
    f32x16 pA0, pA1, pB0, pB1; bf16x8 kf[12]; s16x4 vlo[8], vhi[8]; u32x4 pw[4];
    const int kper = (wid < 4) ? 2 : 1;
    int sc = 0, sn = KSLOT_B, sf = 2 * KSLOT_B, sg = 3 * KSLOT_B;
    int vp = 2 * VSLOT_B, vc = 0, vn = VSLOT_B;
    ATT_WAIT_BAR();
#pragma unroll
    for (int d0 = 0; d0 < 4; ++d0) kload2s(kf, ks0, koff, d0);
#define MLA_STEP(C0, C1, P0, P1, t, HP, MSK, GK, GV, GL) do { \
        att_pa<6, HP, true, true, MSK, true>(C0, C1, P0, P1, lsum, kf, ks0 + sc, vlo, vhi, pw, vp0 + vp, qr, (t) - (NT - 4), qrel, hi, roff); \
        if (GK) MLA_DMAK((t) + 3, sg / KSLOT_B); if (GV) MLA_DMAV((t) + 1, vn / VSLOT_B); \
        att_pb<6, HP, true, false, GL, true>(C0, C1, P0, P1, o, kf, vlo, vhi, pw, ks0 + sn, 0.f, 0.f, 0.f, koff); \
        { const int n_ = ((GK) ? kper : 0) + ((GV) ? 1 : 0); ATT_WAITN(n_); } \
        { const int s_ = sc; sc = sn; sn = sf; sf = sg; sg = s_; const int v_ = vp; vp = vc; vc = vn; vn = v_; } } while (0)
    MLA_STEP(pA0, pA1, pB0, pB1, 0, false, true, true, true, true);
    int t = 1;
    for (; t + 5 < NT; t += 2) { MLA_STEP(pB0, pB1, pA0, pA1, t, true, false, true, true, true); MLA_STEP(pA0, pA1, pB0, pB1, t + 1, true, false, true, true, true); }
    for (; t + 1 < NT; t += 2) { MLA_STEP(pB0, pB1, pA0, pA1, t, true, true, (t + 3 < NT), true, true); MLA_STEP(pA0, pA1, pB0, pB1, t + 1, true, true, (t + 4 < NT), true, true); }
    MLA_STEP(pB0, pB1, pA0, pA1, NT - 1, true, true, false, false, false);
    att_pa<6, true, false, true, false, true>(pA0, pA1, pB0, pB1, lsum, kf, ks0 + sc, vlo, vhi, pw, vp0 + vp, qr, -1, qrel, hi, roff);
    att_pb<6, true, false, false, false, true>(pA0, pA1, pB0, pB1, o, kf, vlo, vhi, pw, ks0, 0.f, 0.f, 0.f, koff);
#undef MLA_STEP
#undef MLA_DMAK
#undef MLA_DMAV
    const float ltot = finish_l(lsum);
    store_o(o, ltot, shm, wid, lane, RowLin{MIXED + (rowbase + q0 + wid * 32) * DM + h * 64, (size_t)DM});
    asm volatile("s_waitcnt lgkmcnt(0)\n\ts_barrier" ::: "memory");
}

struct RowCLin { const bf16* base; size_t pitch; __device__ __forceinline__ const bf16* operator()(int i) const { return base + (size_t)i * pitch; } };
struct RowIdxLin { size_t base, pitch; __device__ __forceinline__ size_t operator()(int i) const { return base + (size_t)i * pitch; } };
__device__ __forceinline__ void dil_unit(LAS unsigned char* shm, int b, int h, int br, int rcls, int qb, const bf16* Z, bf16* OB, float* LSE, bf16* MIXED, int tid_in) {
    int tid = tid_in; asm volatile("" : "+v"(tid));
    const int lane = tid & 63, r32 = lane & 31, hi = lane >> 5; const int wid = __builtin_amdgcn_readfirstlane(tid >> 6);
    const unsigned lds0 = (unsigned)(uintptr_t)shm;
    const int dil = 1 << (2 * br);
    const long rowbase = (long)b * SEQ + rcls; const int q0 = qb * 256, kt0 = q0 - 128;
    const bf16* ksrc = Z + (rowbase + (long)dil * (kt0 + lane)) * E_INP + ZC_KB + h * 64 + wid * 8;
    const bf16* vsrc = Z + (rowbase + (long)dil * (kt0 + 16 * (wid & 3) + (lane >> 2))) * E_INP + ZC_VB + h * 64 + (wid >> 2) * 32 + (lane & 3) * 8;
    const long tstep = (long)dil * 64 * E_INP;
#define DIL_DMA(t, slot) do { glds16(ksrc + (long)(t) * tstep, ATT_RFL(lds0 + LDS_K + (slot) * KSLOT_B + wid * 1024)); \
        glds16(vsrc + (long)(t) * tstep, ATT_RFL(lds0 + LDS_V + (slot) * VSLOT_B + wid * 1024)); } while (0)
    const int tstart = (qb == 0) ? 2 : 0;
    DIL_DMA(tstart, tstart & 1);
    const bf16* Qw = Z + (rowbase + (long)dil * (q0 + wid * 32 + r32)) * E_INP + ZC_QB + h * 64 + hi * 8;
    bf16x8 qr[4];
#pragma unroll
    for (int d0 = 0; d0 < 4; ++d0) qr[d0] = *(const GAS bf16x8*)(Qw + d0 * 16);
    f32x16 o[2]; o[0] = f32x16{}; o[1] = f32x16{}; float lsum = 0.f;
    const float sd = __builtin_amdgcn_exp2f(-(float)(h + 1)) * LOG2E * (float)dil;
    f32x16 av;
#pragma unroll
    for (int r = 0; r < 16; ++r) av[r] = sd * (float)crow(r, hi);
    const int qrel = wid * 32 + r32;
    const int vb0 = (int)(lds0 + LDS_V) + ((lane >> 4) & 1) * 32 + (lane & 3) * 8 + (4 * hi + ((lane & 15) >> 2)) * 64;
    for (int t = tstart; t < 6; ++t) {
        ATT_WAIT_BAR();
        if (t + 1 < 6) DIL_DMA(t + 1, (t + 1) & 1);
        const int tl = wid >> 1;
        if (t >= tl && t <= tl + 2) {
            const int kvb = 64 * t - 128; const float base0 = sd * (float)(kvb - qrel);
            f32x16 c0, c1;
#pragma unroll
            for (int r = 0; r < 16; ++r) { c0[r] = av[r] + base0; c1[r] = c0[r] + 32.f * sd; }
            f32x16 p0, p1; qk_tile<4>(p0, p1, (lds_cptr)(shm + LDS_K + (t & 1) * KSLOT_B), qr, c0, c1, r32, hi);
            VFrag vf; v_issue(vf, vb0 + (t & 1) * VSLOT_B);
            bmask(p0, p1, kvb, qrel, hi);
            bf16x8 pa[4]; exp_pack(p0, p1, lsum, pa);
            pv_mfma(o, vf, pa);
        }
    }
#undef DIL_DMA
    const float ltot = finish_l(lsum);
    const long orow0 = rowbase + (long)dil * (q0 + wid * 32);
    if (br < 2) {
        store_o(o, ltot, shm, wid, lane, RowLin{OB + (size_t)br * M * 512 + (size_t)orow0 * 512 + h * 64, (size_t)dil * 512});
        if (hi == 0) ((GAS float*)LSE)[(size_t)br * M * 8 + (size_t)(orow0 + (long)dil * r32) * 8 + h] = ltot;
    } else {
        store_merge(o, ltot, shm, wid, lane, RowCLin{OB + (size_t)orow0 * 512 + h * 64, (size_t)dil * 512}, RowCLin{OB + (size_t)M * 512 + (size_t)orow0 * 512 + h * 64, (size_t)dil * 512},
                    LSE, LSE + (size_t)M * 8, RowIdxLin{(size_t)orow0 * 8 + h, (size_t)dil * 8}, RowLin{MIXED + (size_t)orow0 * DM + 512 + h * 64, (size_t)dil * DM});
    }
    asm volatile("s_waitcnt lgkmcnt(0)\n\ts_barrier" ::: "memory");
}

constexpr int DSLOT_B = 24576, DLDS_OST = 4 * DSLOT_B, DLDS_WS = 135168;
struct DilS { int b, h, br, rcls, R0, R1; };
__device__ __forceinline__ bool dil_get(int list, int u, DilS& d) {
    if (list == 0) { if (u >= 512) return false;
        if (u < 256) { d.b = u >> 5; d.h = (u >> 2) & 7; d.br = 0; d.rcls = 0; d.R0 = 16 * (u & 3); d.R1 = d.R0 + 16; }
        else { const int v = u - 256; d.b = v >> 5; d.h = (v >> 2) & 7; d.br = 1; d.rcls = v & 3; d.R0 = 0; d.R1 = 16; } }
    else { if (u >= 1024) return false; d.b = u >> 7; d.h = (u >> 4) & 7; d.br = 2; d.rcls = u & 15; d.R0 = 0; d.R1 = 4; }
    return true;
}
#define DIL_WAITN(n) do { const int n_ = (n); \
        if (n_ <= 0) asm volatile("s_waitcnt vmcnt(0) lgkmcnt(0)\n\ts_barrier" ::: "memory"); else if (n_ == 1) asm volatile("s_waitcnt vmcnt(1) lgkmcnt(0)\n\ts_barrier" ::: "memory"); \
        else if (n_ == 2) asm volatile("s_waitcnt vmcnt(2) lgkmcnt(0)\n\ts_barrier" ::: "memory"); else if (n_ == 3) asm volatile("s_waitcnt vmcnt(3) lgkmcnt(0)\n\ts_barrier" ::: "memory"); \
        else if (n_ == 4) asm volatile("s_waitcnt vmcnt(4) lgkmcnt(0)\n\ts_barrier" ::: "memory"); else if (n_ == 5) asm volatile("s_waitcnt vmcnt(5) lgkmcnt(0)\n\ts_barrier" ::: "memory"); \
        else asm volatile("s_waitcnt vmcnt(6) lgkmcnt(0)\n\ts_barrier" ::: "memory"); } while (0)
__device__ __forceinline__ void dil_stream(LAS unsigned char* shm, int list, int vcu, int G, const bf16* Z, bf16* OB, float* LSE, bf16* MIXED, int tid_in) {
    int tid = tid_in; asm volatile("" : "+v"(tid));
    const int lane = tid & 63, r32 = lane & 31, hi = lane >> 5; const int wid = __builtin_amdgcn_readfirstlane(tid >> 6);
    const int pr = wid >> 1, sub = wid & 1;
    const unsigned lds0 = (unsigned)(uintptr_t)shm;
    DilS Dp; int kp = 0; bool okp = dil_get(list, vcu, Dp); int Tp = Dp.R0 - 2;
    if (!okp) return;
    DilS Dc = Dp; int kc = 0; bool okc = true; int Tc = Tp;
    const int dl_row = 8 * wid + (lane >> 3), dl_chunk = (lane & 7) ^ (((lane >> 4) & 3) | ((wid & 1) << 2));
    int koff[4];
    { const int t_ = ((r32 & 7) >> 1) | (((r32 >> 3) & 1) << 2), b_ = 128 * r32 + 16 * (hi ^ (t_ & 1)), x_ = 32 * (t_ >> 1);
#pragma unroll
      for (int d0 = 0; d0 < 4; ++d0) koff[d0] = b_ + (x_ ^ (32 * d0)); }
#define DIL_ISSUE(slot_, pcs_) do { pcs_ = 0; if (okp) { const int dil_ = 1 << (2 * Dp.br); const long rb_ = (long)Dp.b * SEQ + Dp.rcls; const unsigned sb_ = lds0 + (slot_) * DSLOT_B + wid * 1024; \
            if (Tp >= 0) { glds16(Z + (rb_ + (long)dil_ * (64 * Tp + dl_row)) * E_INP + ZC_KB + Dp.h * 64 + dl_chunk * 8, ATT_RFL(sb_)); \
                           glds16(Z + (rb_ + (long)dil_ * (64 * Tp + 16 * (wid & 3) + (lane >> 2))) * E_INP + ZC_VB + Dp.h * 64 + (wid >> 2) * 32 + (lane & 3) * 8, ATT_RFL(sb_ + 8192)); pcs_ += 2; } \
            if (Tp + 2 < Dp.R1) { glds16(Z + (rb_ + (long)dil_ * (64 * (Tp + 2) + dl_row)) * E_INP + ZC_QB + Dp.h * 64 + dl_chunk * 8, ATT_RFL(sb_ + 16384)); pcs_ += 1; } \
            if (++Tp >= Dp.R1) { ++kp; okp = dil_get(list, vcu + kp * G, Dp); Tp = Dp.R0 - 2; } } } while (0)
    int pc0, pc1, pc2; DIL_ISSUE(0, pc0); DIL_ISSUE(1, pc1); DIL_ISSUE(2, pc2); (void)pc0;
    bf16x8 qr[4]; f32x16 o[2]; float lsum = 0.f, sd = 0.f;
#pragma unroll
    for (int d0 = 0; d0 < 4; ++d0) qr[d0] = bf16x8{};
    o[0] = f32x16{}; o[1] = f32x16{};
    bool pend = false; int eb = 0, eh = 0, ebr = 0, ercls = 0, eR = 0;
    MergeOps mo;
#pragma unroll
    for (int i = 0; i < 4; ++i) { mo.w1[i] = u32x4{}; mo.w2[i] = u32x4{}; mo.l1[i] = 0.f; mo.l2[i] = 0.f; }
    const int vb0 = (int)lds0 + 8192 + ((lane >> 4) & 1) * 32 + (lane & 3) * 8 + (4 * hi + ((lane & 15) >> 2)) * 64;
#define DIL_EPI() do { const float ltot = finish_l(lsum); const int dil_ = 1 << (2 * ebr); const long orow0 = (long)eb * SEQ + ercls + (long)dil_ * (64 * eR + 32 * sub); \
        if (ebr < 2) { store_o2(o, ltot, shm + DLDS_WS, shm + DLDS_OST, wid, lane, RowLin{OB + (size_t)ebr * M * 512 + (size_t)orow0 * 512 + eh * 64, (size_t)dil_ * 512}); \
            if (hi == 0) ((GAS float*)LSE)[(size_t)ebr * M * 8 + (size_t)(orow0 + (long)dil_ * r32) * 8 + eh] = ltot; } \
        else merge_finish(o, ltot, shm + DLDS_WS, shm + DLDS_OST, wid, lane, mo, RowLin{MIXED + (size_t)orow0 * DM + 512 + eh * 64, (size_t)dil_ * DM}); \
        pend = false; } while (0)
    int slot = 0;
    while (okc) {
        DIL_WAITN(pc1 + pc2);
        const int T = Tc, dd = (pr - T) & 3, R = T + dd;
        const bool act = (dd <= 2) && (R >= Dc.R0) && (R < Dc.R1);
        if (pend && (!act || dd == 2)) { DIL_EPI(); int pc3; DIL_ISSUE((slot + 3) & 3, pc3); pc1 = pc2; pc2 = pc3; }
        else { int pc3; DIL_ISSUE((slot + 3) & 3, pc3); pc1 = pc2; pc2 = pc3; }
        if (act) {
            LAS unsigned char* const sl_ = shm + slot * DSLOT_B;
            if (dd == 2) {
                lds_cptr qp = (lds_cptr)(sl_ + 16384) + 4096 * sub;
#pragma unroll
                for (int d0 = 0; d0 < 4; ++d0) qr[d0] = *(const LAS bf16x8*)(qp + koff[d0]);
                o[0] = f32x16{}; o[1] = f32x16{}; lsum = 0.f;
                sd = __builtin_amdgcn_exp2f(-(float)(Dc.h + 1)) * LOG2E * (float)(1 << (2 * Dc.br)); }
            if (dd == 0 && Dc.br == 2) {
                const int dil_ = 16; const long orow0 = (long)Dc.b * SEQ + Dc.rcls + (long)dil_ * (64 * R + 32 * sub);
                merge_load(mo, lane, RowCLin{OB + (size_t)orow0 * 512 + Dc.h * 64, (size_t)dil_ * 512}, RowCLin{OB + (size_t)M * 512 + (size_t)orow0 * 512 + Dc.h * 64, (size_t)dil_ * 512},
                           LSE, LSE + (size_t)M * 8, RowIdxLin{(size_t)orow0 * 8 + Dc.h, (size_t)dil_ * 8}); }
            if (T >= 0) {
                const int qrel = 64 * dd + 32 * sub + r32; const float base0 = -sd * (float)qrel;
                f32x16 c0, c1;
#pragma unroll
                for (int r = 0; r < 16; ++r) { c0[r] = __builtin_fmaf(sd, (float)crow(r, hi), base0); c1[r] = c0[r] + 32.f * sd; }
                f32x16 p0, p1;
#pragma unroll
                for (int d0 = 0; d0 < 4; ++d0) { const bf16x8 b0 = *(const LAS bf16x8*)((lds_cptr)sl_ + koff[d0]), b1 = *(const LAS bf16x8*)((lds_cptr)sl_ + koff[d0] + 4096);
                    if (d0 == 0) { p0 = __builtin_amdgcn_mfma_f32_32x32x16_bf16(b0, qr[0], c0, 0, 0, 0); p1 = __builtin_amdgcn_mfma_f32_32x32x16_bf16(b1, qr[0], c1, 0, 0, 0); }
                    else { p0 = __builtin_amdgcn_mfma_f32_32x32x16_bf16(b0, qr[d0], p0, 0, 0, 0); p1 = __builtin_amdgcn_mfma_f32_32x32x16_bf16(b1, qr[d0], p1, 0, 0, 0); } }
                VFrag vf; v_issue(vf, vb0 + slot * DSLOT_B);
                if (dd != 1) bmask(p0, p1, 0, qrel, hi);
                bf16x8 pa[4]; exp_pack(p0, p1, lsum, pa);
                pv_mfma(o, vf, pa);
            }
            if (dd == 0) { pend = true; eb = Dc.b; eh = Dc.h; ebr = Dc.br; ercls = Dc.rcls; eR = R; }
        }
        if (++Tc >= Dc.R1) { ++kc; okc = dil_get(list, vcu + kc * G, Dc); Tc = Dc.R0 - 2; }
        slot = (slot + 1) & 3;
    }
    if (pend) DIL_EPI();
    asm volatile("s_waitcnt vmcnt(0) lgkmcnt(0)\n\ts_barrier" ::: "memory");
#undef DIL_ISSUE
#undef DIL_EPI
}

__device__ __forceinline__ float moba_bound(const float* g_q, const float* g_k, int tid) {
    const int lane = tid & 63;
    float gq = __builtin_fabsf(((const GAS float*)g_q)[lane]), gk = __builtin_fabsf(((const GAS float*)g_k)[lane]);
#define MOBA_WMAX(v) do { v = __builtin_fmaxf(v, swz_xor<1>(v)); v = __builtin_fmaxf(v, swz_xor<2>(v)); v = __builtin_fmaxf(v, swz_xor<4>(v)); v = __builtin_fmaxf(v, swz_xor<8>(v)); v = __builtin_fmaxf(v, swz_xor<16>(v)); v = __builtin_fmaxf(v, get_xor32(v, lane < 32)); } while (0)
    MOBA_WMAX(gq); MOBA_WMAX(gk);
#undef MOBA_WMAX
    return 96.f + 2.f * (8.f * gq * gk * LOG2E);
}
__device__ __forceinline__ int moba_ts(int h, int ob, float dnum) {
    const float sl = __builtin_amdgcn_exp2f(-0.5f * (float)(h + 1)) * LOG2E, dskip = dnum / sl;
    const float tf = __builtin_floorf(((float)(256 * ob - 63) - dskip) * (1.f / 64.f)) + 1.f;
    int t0 = (tf > 0.f) ? (int)tf : 0; t0 &= ~1;
#if ATT_PROBE == 7
    t0 = 0;
#endif
    return __builtin_amdgcn_readfirstlane(t0);
}
struct Ring { int sc, sn, sf, sg, vp, vc, vn; };
__device__ __forceinline__ void moba_unit(LAS unsigned char* shm, int b, int h, int ob, const bf16* QKV, const float* KMEAN, bf16* MIXED, float dnum, int tid_in, Ring& rg, bool pre, bool hasn, int nb, int nh, int nob) {
    int tid = tid_in; asm volatile("" : "+v"(tid));
    const int lane = tid & 63, r32 = lane & 31, hi = lane >> 5; const int wid = __builtin_amdgcn_readfirstlane(tid >> 6);
    const unsigned lds0 = (unsigned)(uintptr_t)shm;
    const size_t rowbase = (size_t)b * SEQ; const int q0 = ob * 256;
    int dl_row, dl_chunk; swz_dma_lane(wid, lane, dl_row, dl_chunk); int koff[4]; swz_koff(r32, hi, koff);
    const bf16* ksrc = QKV + (rowbase + dl_row) * QKV_N + 1024 + h * 64 + dl_chunk * 8;
    const bf16* vsrc = QKV + (rowbase + 16 * (wid & 3) + (lane >> 2)) * QKV_N + 2048 + h * 64 + (wid >> 2) * 32 + (lane & 3) * 8;
#if ATT_PROBE == 5
#define MOBA_DMAK(t, slot) do { glds16(ksrc + (size_t)(t) * 64 * QKV_N, ATT_RFL(lds0 + LDS_K + (slot) * KSLOT_B + wid * 1024)); glds16(ksrc + (size_t)(t) * 64 * QKV_N, ATT_RFL(lds0 + LDS_K + (slot) * KSLOT_B + wid * 1024)); } while (0)
#else
#define MOBA_DMAK(t, slot) glds16(ksrc + (size_t)(t) * 64 * QKV_N, ATT_RFL(lds0 + LDS_K + (slot) * KSLOT_B + wid * 1024))
#endif
#define MOBA_DMAV(t, slot) glds16(vsrc + (size_t)(t) * 64 * QKV_N, ATT_RFL(lds0 + LDS_V + (slot) * VSLOT_B + wid * 1024))
    const float sl = __builtin_amdgcn_exp2f(-0.5f * (float)(h + 1)) * LOG2E;
    const int ts = moba_ts(h, ob, dnum);
    int sc, sn, sf, sg, vp, vc, vn;
    if (pre) { sc = rg.sc; sn = rg.sn; sf = rg.sf; sg = rg.sg; vp = rg.vp; vc = rg.vc; vn = rg.vn; }
    else { sc = 0; sn = KSLOT_B; sf = 2 * KSLOT_B; sg = 3 * KSLOT_B; vp = 2 * VSLOT_B; vc = 0; vn = VSLOT_B;
           MOBA_DMAK(ts, 0); MOBA_DMAK(ts + 1, 1); MOBA_DMAV(ts, 0); MOBA_DMAK(ts + 2, 2); }
    const int tsn = hasn ? moba_ts(nh, nob, dnum) : 0;
    const bf16* ksrcn = QKV + ((size_t)nb * SEQ + dl_row) * QKV_N + 1024 + nh * 64 + dl_chunk * 8;
    const bf16* vsrcn = QKV + ((size_t)nb * SEQ + 16 * (wid & 3) + (lane >> 2)) * QKV_N + 2048 + nh * 64 + (wid >> 2) * 32 + (lane & 3) * 8;
#define MOBA_DMAKN(tt, slot) glds16(ksrcn + (size_t)(tt) * 64 * QKV_N, ATT_RFL(lds0 + LDS_K + (slot) * KSLOT_B + wid * 1024))
#define MOBA_DMAVN(tt, slot) glds16(vsrcn + (size_t)(tt) * 64 * QKV_N, ATT_RFL(lds0 + LDS_V + (slot) * VSLOT_B + wid * 1024))
    f32x4 kma[4], kmb[4];
    if (ob > 0) { const float* km = KMEAN + ((size_t)(b * 16 + h) * 16 + (r32 & 15)) * 64 + 8 * hi;
#pragma unroll
        for (int d0 = 0; d0 < 4; ++d0) { kma[d0] = *(const GAS f32x4*)(km + 16 * d0); kmb[d0] = *(const GAS f32x4*)(km + 16 * d0 + 4); } }
    const int qst = (wid < 4) ? (LDS_K + wid * KSLOT_B + 8192) : (LDS_ATT_BYTES + (wid - 4) * 4096);
    bf16x8 qr[4];
    if (pre) { asm volatile("s_waitcnt vmcnt(0)" ::: "memory");
#pragma unroll
        for (int d0 = 0; d0 < 4; ++d0) qr[d0] = *(const LAS bf16x8*)((lds_cptr)shm + qst + koff[d0]); }
    else { const bf16* Qw = QKV + (rowbase + q0 + wid * 32 + r32) * QKV_N + h * 64 + hi * 8;
#pragma unroll
        for (int d0 = 0; d0 < 4; ++d0) qr[d0] = *(const GAS bf16x8*)(Qw + d0 * 16); }
    unsigned selmask = 0u;
#if ATT_PROBE == 8
    for (int rep_ = 0; rep_ < 2; ++rep_)
#endif
    if (ob > 0) {
        f32x16 gt = f32x16{};
#pragma unroll
        for (int d0 = 0; d0 < 4; ++d0) { const f32x4 ka = kma[d0], kb = kmb[d0]; u32x4 wh, wl;
            wh[0] = pk2(ka[0], ka[1]); wh[1] = pk2(ka[2], ka[3]); wh[2] = pk2(kb[0], kb[1]); wh[3] = pk2(kb[2], kb[3]);
            wl[0] = pk2(ka[0] - bf_lo(wh[0]), ka[1] - bf_hi(wh[0])); wl[1] = pk2(ka[2] - bf_lo(wh[1]), ka[3] - bf_hi(wh[1]));
            wl[2] = pk2(kb[0] - bf_lo(wh[2]), kb[1] - bf_hi(wh[2])); wl[3] = pk2(kb[2] - bf_lo(wh[3]), kb[3] - bf_hi(wh[3]));
            gt = __builtin_amdgcn_mfma_f32_32x32x16_bf16(__builtin_bit_cast(bf16x8, wh), qr[d0], gt, 0, 0, 0);
            gt = __builtin_amdgcn_mfma_f32_32x32x16_bf16(__builtin_bit_cast(bf16x8, wl), qr[d0], gt, 0, 0, 0); }
        float G[16];
#pragma unroll
        for (int r = 0; r < 8; ++r) { auto rr = __builtin_amdgcn_permlane32_swap(__float_as_uint(gt[r]), __float_as_uint(gt[r]), false, false);
            G[(r & 3) + 8 * (r >> 2)] = __uint_as_float(rr[0]); G[(r & 3) + 8 * (r >> 2) + 4] = __uint_as_float(rr[1]); }
        float v0 = -INFINITY, v1 = -INFINITY, v2 = -INFINITY; int i0 = -1, i1 = -1, i2 = -1;
#pragma unroll
        for (int n = 0; n < 15; ++n) if (n < ob) { const float g = G[n];
            if (g > v0) { v2 = v1; i2 = i1; v1 = v0; i1 = i0; v0 = g; i0 = n; } else if (g > v1) { v2 = v1; i2 = i1; v1 = g; i1 = n; } else if (g > v2) { v2 = g; i2 = n; } }
        selmask = 0u; if (i0 >= 0) selmask |= 1u << i0; if (i1 >= 0) selmask |= 1u << i1; if (i2 >= 0) selmask |= 1u << i2;
#if ATT_PROBE == 8
        asm volatile("" : "+v"(selmask), "+v"(qr[0]), "+v"(qr[1]), "+v"(qr[2]), "+v"(qr[3]));
#endif
    }
    f32x16 o[2]; o[0] = f32x16{}; o[1] = f32x16{}; float lsum = 0.f;
    const int NT = 4 * ob + 4, qrel = wid * 32 + r32, tq = q0 + qrel;
    const lds_cptr vp0 = (lds_cptr)(shm + LDS_V) + ((lane >> 4) & 1) * 32 + (lane & 3) * 8 + (4 * hi + ((lane & 15) >> 2)) * 64;
    const lds_cptr kp0 = (lds_cptr)(shm + LDS_K) + hi * 1024 + r32 * 16, ks0 = (lds_cptr)(shm + LDS_K);
    f32x16 pA0, pA1, pB0, pB1; bf16x8 kf[8]; s16x4 vlo[8], vhi[8]; u32x4 pw[4];
#define MOBA_BASE(tt) ((((tt) >= NT - 4) || (((selmask >> ((tt) >> 2)) & 1u) != 0u)) ? 0.f : -INFINITY) + sl * (float)(64 * (tt) - tq + 4 * hi)
    { const float b0_ = MOBA_BASE(ts);
#pragma unroll
      for (int r = 0; r < 16; ++r) { pA0[r] = __builtin_fmaf(sl, (float)crow(r, 0), b0_); pA1[r] = pA0[r] + 32.f * sl; } }
    ATT_WAIT_BAR();
#pragma unroll
    for (int d0 = 0; d0 < 4; ++d0) kload2s(kf, ks0 + sc, koff, d0);
#define MOBA_STEP(C0, C1, P0, P1, t, HP, MSK, GK, GV, GL) do { \
        att_pa<4, HP, true, false, MSK>(C0, C1, P0, P1, lsum, kf, kp0 + sc, vlo, vhi, pw, vp0 + vp, qr, (t) - (NT - 4), qrel, hi); \
        int n_ = 0; \
        if (GK) { MOBA_DMAK((t) + 3, sg / KSLOT_B); n_ += 1; } else if (hasn) { MOBA_DMAKN(tsn + ((t) + 3 - NT), sg / KSLOT_B); n_ += 1; } \
        if (GV) { MOBA_DMAV((t) + 1, vn / VSLOT_B); n_ += 1; } else if (hasn) { MOBA_DMAVN(tsn, vn / VSLOT_B); n_ += 1; } \
        { const float bn_ = MOBA_BASE((t) + 1); \
          att_pb<4, HP, true, true, GL, true>(C0, C1, P0, P1, o, kf, vlo, vhi, pw, ks0 + sn, sl, bn_, 32.f * sl, koff); } \
        ATT_WAITN(n_); \
        { const int s_ = sc; sc = sn; sn = sf; sf = sg; sg = s_; const int v_ = vp; vp = vc; vc = vn; vn = v_; } } while (0)
    MOBA_STEP(pA0, pA1, pB0, pB1, ts, false, true, true, true, true);
    int t = ts + 1;
#if ATT_PROBE != 9
    for (; t + 5 < NT; t += 2) { MOBA_STEP(pB0, pB1, pA0, pA1, t, true, false, true, true, true); MOBA_STEP(pA0, pA1, pB0, pB1, t + 1, true, false, true, true, true); }
#endif
    for (; t + 1 < NT; t += 2) { MOBA_STEP(pB0, pB1, pA0, pA1, t, true, true, (t + 3 < NT), true, true); MOBA_STEP(pA0, pA1, pB0, pB1, t + 1, true, true, (t + 4 < NT), true, true); }
    MOBA_STEP(pB0, pB1, pA0, pA1, NT - 1, true, true, false, false, false);
    if (hasn) { const bf16* qn = QKV + ((size_t)nb * SEQ + 256 * nob + wid * 32 + (lane >> 3)) * QKV_N + nh * 64;
#pragma unroll
        for (int j = 0; j < 4; ++j) { const int ch = (lane & 7) ^ (((lane >> 4) & 3) | ((j & 1) << 2)); glds16(qn + (size_t)(8 * j) * QKV_N + ch * 8, ATT_RFL(lds0 + qst + j * 1024)); } }
    att_pa<4, true, false, false, false>(pA0, pA1, pB0, pB1, lsum, kf, kp0 + sc, vlo, vhi, pw, vp0 + vp, qr, -1, qrel, hi);
    att_pb<4, true, false, false, false, true>(pA0, pA1, pB0, pB1, o, kf, vlo, vhi, pw, ks0, 0.f, 0.f, 0.f, koff);
    rg.sc = sc; rg.sn = sn; rg.sf = sf; rg.sg = sg; rg.vp = vp; rg.vc = vc; rg.vn = vn;
#undef MOBA_BASE
#undef MOBA_STEP
#undef MOBA_DMAK
#undef MOBA_DMAV
#undef MOBA_DMAKN
#undef MOBA_DMAVN
    const float ltot = finish_l(lsum);
    store_o(o, ltot, shm, wid, lane, RowLin{MIXED + (rowbase + q0 + wid * 32) * DM + h * 64, (size_t)DM});
    asm volatile("s_waitcnt lgkmcnt(0)\n\ts_barrier" ::: "memory");
}
}

constexpr unsigned PH_ACTIVE = (1u << 0) | (1u << 1) | (1u << 3) | (1u << 5) | (1u << 6) | (1u << 7) | (1u << 9) | (1u << 10) | (1u << 12) | (1u << 14) | (1u << 17) | (1u << 18) | (1u << 20) | (1u << 21) | (1u << 23);
__global__ void __launch_bounds__(NTHR, 2) trunk_fwd(Args args) {
    extern __shared__ __attribute__((aligned(16))) unsigned char lds_raw[];
    Frame F;
    F.lds = (LAS unsigned char*)lds_raw;
    F.tid = threadIdx.x; F.lane = F.tid & 63; F.wave = __builtin_amdgcn_readfirstlane(F.tid >> 6);
    F.G = gridDim.x; { const int bx = blockIdx.x; F.vcu = (F.G % 8 == 0) ? (bx % 8) * (F.G / 8) + bx / 8 : bx; }
    F.ws = args.ws; F.H = args.out;
    gu32* const ctl = (gu32*)(args.ws + WS_CTL);
    volatile LAS unsigned* MISC = (volatile LAS unsigned*)(F.lds + MISC_OFF);
    for (int u = F.tid; u < (LDS_BYTES - LDSCTL_OFF) / 4; u += NTHR) ((LAS unsigned*)(F.lds + LDSCTL_OFF))[u] = 0u;
    __syncthreads();
#if MK_ONE_LAUNCH
    XcdBarrier bar = xcd_barrier_post((unsigned*)ctl + CW_BAR, MISC + 8);
#define GRID_BAR() xcd_barrier(bar)
#else
    (void)MISC; (void)ctl;
#define GRID_BAR() do {} while (0)
#endif
    bool first = true; const int lo = args.ph_lo, hi = args.ph_hi;
#define PHASE_ROOTS \
        { int t_ = threadIdx.x; asm volatile("" : "+v"(t_)); F.tid = t_; F.lane = t_ & 63; F.wave = __builtin_amdgcn_readfirstlane(t_ >> 6); \
          int v_ = F.vcu; asm volatile("" : "+s"(v_)); F.vcu = v_; } \
        const int gw = F.vcu * NWAVES + F.wave, NGW = F.G * NWAVES; \
        typedef const __attribute__((address_space(4))) Args CArgs; CArgs* AP = (CArgs*)__builtin_amdgcn_kernarg_segment_ptr(); asm volatile("" : "+s"(AP)); \
        unsigned char* ws = AP->ws; asm volatile("" : "+s"(ws)); ws = as_global(ws); \
        bf16* const Wb = (bf16*)(ws + WS_W); \
        float* const ROPE = (float*)(ws + WS_ROPE); \
        float* const KMEAN = (float*)(ws + WS_KMEAN); \
        float* const SSA = (float*)(ws + WS_SSA); float* const SSB = (float*)(ws + WS_SSB); \
        float* const SSQ = (float*)(ws + WS_SSQ); float* const SSKV = (float*)(ws + WS_SSKV); \
        bf16* const XNA = (bf16*)(ws + WS_XNA); bf16* const XM1 = (bf16*)(ws + WS_XM1); bf16* const MIXED = (bf16*)(ws + WS_MIXED); \
        bf16* const PB = (bf16*)(ws + WS_PB); bf16* const PP = (bf16*)(ws + WS_PP); \
        bf16* const Z = (bf16*)(ws + WS_Z); bf16* const QA = (bf16*)(ws + WS_QA); bf16* const KVA = (bf16*)(ws + WS_KVA); \
        bf16* const U = (bf16*)(ws + WS_U); bf16* const QKV = (bf16*)(ws + WS_QKV); \
        float* const H = as_global((float*)AP->out); \
        const float* const X = as_global((const float*)AP->in[I_X]);
#if PROBE_MASK
#define PHASE_ENTER(k) if (!first) GRID_BAR(); first = false; for (int rep_ = (((PROBE_MASK >> (k)) & 1u) ? 2 : 1); rep_ > 0; --rep_) { if (rep_ == 1 && ((PROBE_MASK >> (k)) & 1u)) GRID_BAR(); PHASE_ROOTS
#define PHASE_LEAVE }
#else
#define PHASE_ENTER(k) if (!first) GRID_BAR(); first = false; { PHASE_ROOTS
#define PHASE_LEAVE }
#endif
    if (lo <= 0 && 0 < hi) { PHASE_ENTER(0)
        {{
            LAS float* scr = (LAS float*)(F.lds + F.wave * 16384);
            for (int it = gw; it < WITEMS_P0; it += NGW) {
                int r = it;
                WITEMP(I_EWIN, 0, 1024, E_IN, W_INE, RmInE{})
                WITEMP(I_EWUQ, 0, 384, 768, W_UQ, RmUq{})
                WITEMP(I_EWUKV, 0, 256, 1024, W_UKV, RmUkv{})
            }
            { const size_t n16 = (size_t)96 * DM * 2 / 16; GAS u32x4* zp = (GAS u32x4*)(Wb + W_INE + (size_t)416 * DM);
              for (size_t i = (size_t)F.vcu * NTHR + F.tid; i < n16; i += (size_t)F.G * NTHR) zp[i] = (u32x4){0u, 0u, 0u, 0u}; }
            { GAS u32x4* kz = (GAS u32x4*)KMEAN; for (int i = F.vcu * NTHR + F.tid; i < BATCH * 16 * 16 * 64 / 4; i += F.G * NTHR) kz[i] = (u32x4){0u, 0u, 0u, 0u}; }
            { const GAS int* pos = (const GAS int*)AP->in[I_POS];
              for (int i = F.vcu * NTHR + F.tid; i < M * 16; i += F.G * NTHR) { const int m = i >> 4, f = i & 15;
                  const double ang = (double)pos[m] * (INVF10[f >> 2] * INVF4[f & 3]); double rev = ang * 0.15915494309189535; rev -= __builtin_rint(rev);
                  ((GAS f32x2*)ROPE)[i] = (f32x2){__builtin_amdgcn_cosf((float)rev), __builtin_amdgcn_sinf((float)rev)}; } }
            rms_rows_phase(F, X, as_global((const float*)AP->in[I_MIXN]), XNA);
        }}
    PHASE_LEAVE }
    if (lo <= 1 && 1 < hi) { PHASE_ENTER(1)
        {{ run_gemm(F, XNA, DM, Wb + W_INE, E_INP - 256, DM, EpInE{Z, ROPE, as_global((const float*)AP->in[I_ECQN]), as_global((const float*)AP->in[I_ECKVN]), as_global((const float*)AP->in[I_EKNR]),
                                                                     as_global((const float*)AP->in[I_EDQN]), as_global((const float*)AP->in[I_EDKN]), SSQ, SSKV}); }}
    PHASE_LEAVE }
    if (lo <= 3 && 3 < hi) { PHASE_ENTER(3)
        {{ run_gemm(F, Z + ZC_CQ, E_INP, Wb + W_UQ, QA_N, 384, EpUq{QA, ROPE, as_global((const float*)AP->in[I_EQNN]), as_global((const float*)AP->in[I_EQNR]), SSQ});
                  { constexpr int UQ_TILES = (M / 256) * (QA_N / 256);
                    run_gemm(F, XNA, DM, Wb + W_INE + (size_t)(E_INP - 256) * DM, 256, DM, EpInE8{EpInE{Z, ROPE, as_global((const float*)AP->in[I_ECQN]), as_global((const float*)AP->in[I_ECKVN]), as_global((const float*)AP->in[I_EKNR]),
                                                                     as_global((const float*)AP->in[I_EDQN]), as_global((const float*)AP->in[I_EDKN]), SSQ, SSKV}}, (F.G - UQ_TILES % F.G) % F.G); }
                  run_gemm(F, Z + ZC_CKV, E_INP, Wb + W_UKV, KVA_N, 256, EpUkv{KVA, as_global((const float*)AP->in[I_EKNN]), SSKV}); }}
    PHASE_LEAVE }
    if (lo <= 5 && 5 < hi) { PHASE_ENTER(5)
        {{
            bf16* const OB = (bf16*)(ws + WS_OB); float* const LSE = (float*)(ws + WS_LSE);
#if GEMM_PROBE == 7
            for (int su = F.vcu; su < 256; su += F.G) { const int bh = su >> 2, s = su & 3;
                for (int k = 0; k < 4; ++k) { const int qb = (k == 0) ? 15 - s : (k == 1) ? 8 + s : (k == 2) ? 7 - s : s; att::mla_unit(F.lds, bh >> 3, bh & 7, qb, QA, KVA, Z, MIXED, F.tid); } }
#endif
#pragma unroll 1
            for (int s_ = 0; s_ < 2; ++s_) {
                if ((s_ ^ (F.vcu & 1)) == 0) {
                    for (int su = F.vcu; su < 256; su += F.G) { const int bh = su >> 2, s = su & 3;
                        for (int k = 0; k < 4; ++k) { const int qb = (k == 0) ? 15 - s : (k == 1) ? 8 + s : (k == 2) ? 7 - s : s; att::mla_unit(F.lds, bh >> 3, bh & 7, qb, QA, KVA, Z, MIXED, F.tid); } }
                } else {
#if DIL_STREAM
                    att::dil_stream(F.lds, 0, F.vcu, F.G, Z, OB, LSE, MIXED, F.tid);
#else
                    for (int br = 0; br < 2; ++br)
                        for (int u = F.vcu; u < 1024; u += F.G) { const int bh = u >> 4, x = u & 15, dil = 1 << (2 * br); att::dil_unit(F.lds, bh >> 3, bh & 7, br, x & (dil - 1), x >> (2 * br), Z, OB, LSE, MIXED, F.tid); }
#endif
                }
                if (s_ == 0) {
                    LAS float* scr = (LAS float*)(F.lds + F.wave * 16384);
                    for (int it = gw; it < WITEMS_TOTAL - WITEMS_P0; it += NGW) {
                        int r = it;
                    WITEM(I_EWOUT, 0, 1024, 1024, W_OUTE)
                    WITEMG(I_OWIN, 0, 1024, 3072, W_INO, RmInO{}, as_global((const float*)AP->in[I_MIXN]) + DM)
                    WITEM(I_OWOUT, 0, 1024, 1024, W_OUTO)
                    WITEMG(I_WFF1, 0, 1024, 4096, W_FF1, RmPlain{}, as_global((const float*)AP->in[I_FFN]))
                    WITEMG(I_WFF1, (size_t)DM * FF, 1024, 4096, W_FF1 + (size_t)FF * DM, RmPlain{}, as_global((const float*)AP->in[I_FFN]) + DM)
                    WITEM(I_WFF2, 0, 4096, 1024, W_FF2)
                    WITEM(I_WFF2, (size_t)DM * FF, 4096, 1024, W_FF2 + (size_t)FF * DM)
                    WITEMG(I_WG, 0, 1024, 1024, W_G, RmPlain{}, as_global((const float*)AP->in[I_PLEN]))
                    WITEMG(I_WG, (size_t)DM * DM, 1024, 1024, W_G + (size_t)DM * DM, RmPlain{}, as_global((const float*)AP->in[I_PLEN]) + DM)
                    WITEM(I_WP, 0, 256, 1024, W_P)
                    WITEM(I_WP, (size_t)PLE * DM, 256, 1024, W_P + (size_t)PLE * DM)
                    }
                    asm volatile("s_waitcnt vmcnt(0) lgkmcnt(0)\n\ts_barrier" ::: "memory");
                } }
        }}
    PHASE_LEAVE }
    if (lo <= 6 && 6 < hi) { PHASE_ENTER(6)
        {{
            bf16* const OB = (bf16*)(ws + WS_OB); float* const LSE = (float*)(ws + WS_LSE);
#if DIL_STREAM
            att::dil_stream(F.lds, 1, F.vcu, F.G, Z, OB, LSE, MIXED, F.tid);
#else
            for (int u = F.vcu; u < 1024; u += F.G) { const int bh = u >> 4, x = u & 15; att::dil_unit(F.lds, bh >> 3, bh & 7, 2, x, 0, Z, OB, LSE, MIXED, F.tid); }
#endif
        }}
    PHASE_LEAVE }
    if (lo <= 7 && 7 < hi) { PHASE_ENTER(7)
        { {
#if GEMM_PROBE == 3
            run_gemm(F, MIXED, DM, Wb + W_OUTE, DM, DM, EpResNormT<true>{X, nullptr, XM1, SSB}); GRID_BAR();
#elif GEMM_PROBE == 4
            run_gemm(F, MIXED, DM, Wb + W_OUTE, DM, DM, EpNull{}); GRID_BAR();
#endif
#pragma unroll 1
            for (int s_ = 0; s_ < 2; ++s_) {
                if ((s_ ^ (F.vcu & 1)) == 0) run_gemm(F, MIXED, DM, Wb + W_OUTE, DM, DM, EpResNormT<true>{X, nullptr, XNA, SSA});
                else pb_phase(F, as_global((const float*)AP->in[I_P]), PB); } }}
    PHASE_LEAVE }
    if (lo <= 9 && 9 < hi) { PHASE_ENTER(9)
        {{
#if GEMM_PROBE == 1
            run_gemm(F, XNA, DM, Wb + W_FF1, FF, DM, EpRelu2N{U, SSA}); GRID_BAR();
#elif GEMM_PROBE == 2
            run_gemm(F, XNA, DM, Wb + W_FF1, FF, DM, EpNull{}); GRID_BAR();
#endif
            const int L = (9 == 9) ? 0 : 1;
#pragma unroll 1
            for (int s_ = 0; s_ < 2; ++s_) {
                if ((s_ ^ (F.vcu & 1)) == 0) run_gemm(F, XNA, DM, Wb + W_FF1 + (size_t)L * FF * DM, FF, DM, EpRelu2N{U, L ? SSB : SSA});
                else run_gemm(F, PB, PLE, Wb + W_P + (size_t)L * DM * PLE, DM, PLE, EpBf16R{PP, DM}); } }}
    PHASE_LEAVE }
    if (lo <= 10 && 10 < hi) { PHASE_ENTER(10)
        {{ run_gemm(F, U, FF, Wb + W_FF2, DM, FF, EpResNormT<false>{nullptr, XNA, XNA, SSB}); }}
    PHASE_LEAVE }
    if (lo <= 12 && 12 < hi) { PHASE_ENTER(12)
        {{ run_gemm(F, XNA, DM, Wb + W_G, DM, DM, EpPleN{XNA, PP, SSB, XM1, SSA, nullptr}); }}
    PHASE_LEAVE }
    if (lo <= 14 && 14 < hi) { PHASE_ENTER(14)
        {{ run_gemm(F, XM1, DM, Wb + W_INO, QKV_N, DM, EpInO{QKV, as_global((const float*)AP->in[I_OQN]), as_global((const float*)AP->in[I_OKN]), SSA, KMEAN}); }}
    PHASE_LEAVE }
    if (lo <= 17 && 17 < hi) { PHASE_ENTER(17)
        {{
            const float dnum = att::moba_bound(as_global((const float*)AP->in[I_OQN]), as_global((const float*)AP->in[I_OKN]), F.tid);
            att::Ring rg{}; bool pre = false;
            int b, h, ob; bool ok;
#define MOBA_UNIT(k_, b_, h_, ob_, ok_) do { const int su_ = F.vcu + ((k_) >> 3) * F.G; ok_ = su_ < 256; const int i_ = 7 - ((k_) & 7), j_ = su_ & 31, p_ = j_ & 1, jj_ = j_ >> 1; \
                b_ = su_ >> 5; h_ = 2 * i_ + (p_ ^ (i_ & 1)); ob_ = (int)((MOBA_OB[h_] >> (4 * jj_)) & 15ull); } while (0)
            MOBA_UNIT(0, b, h, ob, ok);
            for (int k = 0; ok; ++k) { int nb, nh, nob; bool nok; MOBA_UNIT(k + 1, nb, nh, nob, nok);
                att::moba_unit(F.lds, b, h, ob, QKV, KMEAN, MIXED, dnum, F.tid, rg, pre, nok, nb, nh, nob);
                pre = true; b = nb; h = nh; ob = nob; ok = nok; }
#undef MOBA_UNIT
        }}
    PHASE_LEAVE }
    if (lo <= 18 && 18 < hi) { PHASE_ENTER(18)
        {{
#pragma unroll 1
            for (int s_ = 0; s_ < 2; ++s_) {
                if ((s_ ^ (F.vcu & 1)) == 0) run_gemm(F, MIXED, DM, Wb + W_OUTO, DM, DM, EpResNormT<false>{nullptr, XM1, XNA, SSB});
                else pb_phase(F, as_global((const float*)AP->in[I_P]) + (size_t)M * PLE, PB); } }}
    PHASE_LEAVE }
    if (lo <= 20 && 20 < hi) { PHASE_ENTER(20)
        {{ const int L = (20 == 9) ? 0 : 1;
#pragma unroll 1
            for (int s_ = 0; s_ < 2; ++s_) {
                if ((s_ ^ (F.vcu & 1)) == 0) run_gemm(F, XNA, DM, Wb + W_FF1 + (size_t)L * FF * DM, FF, DM, EpRelu2N{U, L ? SSB : SSA});
                else run_gemm(F, PB, PLE, Wb + W_P + (size_t)L * DM * PLE, DM, PLE, EpBf16R{PP, DM}); } }}
    PHASE_LEAVE }
    if (lo <= 21 && 21 < hi) { PHASE_ENTER(21)
        {{ run_gemm(F, U, FF, Wb + W_FF2 + (size_t)FF * DM, DM, FF, EpResNormT<false>{nullptr, XNA, XNA, SSA}); }}
    PHASE_LEAVE }
    if (lo <= 23 && 23 < hi) { PHASE_ENTER(23)
        {{ run_gemm(F, XNA, DM, Wb + W_G + (size_t)DM * DM, DM, DM, EpPleN{XNA, PP, SSA, nullptr, nullptr, H}); }}
    PHASE_LEAVE }
}

extern "C" void kernel_launch(void* const* d_in, const int* in_sizes, int n_in, void* d_out, int out_size, void* d_ws, size_t ws_size, hipStream_t stream) {
    static int grid = 0;
    if (grid == 0) {
        if (n_in != 26 || out_size != M * DM || ws_size < WS_END) { fprintf(stderr, "kernel_launch: unexpected shapes (n_in %d, out %d, ws %zu); nothing launched\n", n_in, out_size, ws_size); grid = -1; return; }
        int dev = 0, cus = 0;
        if (hipGetDevice(&dev) != hipSuccess || hipDeviceGetAttribute(&cus, hipDeviceAttributeMultiprocessorCount, dev) != hipSuccess) { grid = -1; return; }
        if (hipFuncSetAttribute((const void*)trunk_fwd, hipFuncAttributeMaxDynamicSharedMemorySize, LDS_BYTES) != hipSuccess) { fprintf(stderr, "kernel_launch: hipFuncSetAttribute failed\n"); grid = -1; return; }
        (void)hipGetLastError();
        grid = cus;
    }
    if (grid < 0) return;
    Args a{};
    for (int i = 0; i < 26; ++i) a.in[i] = d_in[i];
    a.out = (float*)d_out; a.ws = (unsigned char*)d_ws;
#if MK_ONE_LAUNCH
    (void)hipMemsetAsync((char*)d_ws + WS_CTL, 0, CTL_ZERO_BYTES, stream);
    a.ph_lo = 0; a.ph_hi = NPH;
    hipLaunchKernelGGL(trunk_fwd, dim3(grid), dim3(NTHR), LDS_BYTES, stream, a);
#else
    for (int ph = 0; ph < NPH; ++ph) { if (!((PH_ACTIVE >> ph) & 1u)) continue; a.ph_lo = ph; a.ph_hi = ph + 1; hipLaunchKernelGGL(trunk_fwd, dim3(grid), dim3(NTHR), LDS_BYTES, stream, a); }
#endif
}
```

```cpp
#include <hip/hip_runtime.h>
#include <cstdio>
#include <cstdint>

#ifndef MK_ONE_LAUNCH
#define MK_ONE_LAUNCH 1
#endif
#ifndef USE_PG8
#define USE_PG8 1
#endif

#ifndef FAST_ATTN
#define FAST_ATTN 1
#endif

#ifndef PROBE_MASK
#define PROBE_MASK 0u
#endif

#ifndef ATT_PROBE
#define ATT_PROBE 0
#endif

#ifndef ATT_NOPRE
#define ATT_NOPRE 0
#endif

#ifndef GEMM_PROBE
#define GEMM_PROBE 0
#endif

#ifndef GEMM_SP2
#define GEMM_SP2 true
#endif

#ifndef DIL_STREAM
#define DIL_STREAM 1
#endif

#define LAS __attribute__((address_space(3)))
#define GAS __attribute__((address_space(1)))
#if USE_PG8
namespace pg8 {
#define PG8_LAS __attribute__((address_space(3)))
typedef unsigned short bf16_t;
typedef short bf16x8 __attribute__((ext_vector_type(8)));
typedef float f32x4 __attribute__((ext_vector_type(4)));
typedef unsigned u32x4 __attribute__((ext_vector_type(4)));
constexpr int BM = 256, BK = 64, HALF = 128, HTB = HALF * BK * 2  , STAGE_BYTES = 8 * HTB, NXCD = 8, WGM = 8;

__host__ __device__ __forceinline__ int lds_byte(int r, int c) { const int st = (r >> 4) * 2 + (c >> 5), rr = r & 15, cc = c & 31, ob = rr * 64 + cc * 2; return st * 1024 + (ob ^ (((ob >> 9) & 1) << 5)); }
__host__ __device__ __forceinline__ void stage_rc(int b, int& R, int& C) { const int st = b / 1024, sb = b % 1024, swz = sb ^ (((sb >> 9) & 1) << 5); R = (st >> 1) * 16 + swz / 64; C = (st & 1) * 32 + (swz % 64) / 2; }
__host__ __device__ __forceinline__ int perm32(int rho) { const int n = rho >> 4, i = rho & 15; return 8 * (i >> 2) + 4 * n + (i & 3); }

struct Unit { int pm, pn; };
struct Gemm { const bf16_t* A; const bf16_t* Bt; int M, N, K, lda, ldb; };

struct StaticOrder {
    int nM, nN, nwg, G, c;
    __host__ __device__ void init(int M, int N, int G_, int c_) { nM = M / BM; nN = N / BM; nwg = nM * nN; G = G_; c = c_; }
    __host__ __device__ bool next(int i, Unit& u) const {
        const long L = (long)i * G + c; if (L >= nwg) return false;
        int wgid = (int)L; { const int q = nwg / NXCD, r = nwg % NXCD, xcd = wgid % NXCD, off = wgid / NXCD; wgid = (xcd < r ? xcd * (q + 1) : r * (q + 1) + (xcd - r) * q) + off; }
        const int nig = WGM * nN, gid = wgid / nig, fm = gid * WGM, gsz = (nM - fm) < WGM ? (nM - fm) : WGM;
        u.pm = fm + ((wgid % nig) % gsz); u.pn = (wgid % nig) / gsz; return true;
    }
    __device__ __forceinline__ void a_ready(const Unit&) const {}
    __device__ __forceinline__ void done(const Unit&) const {}
};

template <class Epi, class Sched, bool ALIGN_EPI = false, bool SP2 = false, bool A_NT = false>
__device__ __forceinline__ void gemm_phase(PG8_LAS unsigned char* lds, const Gemm g, const Sched& S, const Epi& E) {
    int tid_ = threadIdx.x; asm volatile("" : "+v"(tid_));
    const int tid = tid_, wid = __builtin_amdgcn_readfirstlane(tid >> 6), lane = tid & 63, wr = wid >> 2, wc = wid & 3, fr = lane & 15, fq = lane >> 4;
    const int K = g.K, nt = K / BK;
    unsigned voffA[2], voffB[2];
#pragma unroll
    for (int i = 0; i < 2; ++i) { int R, C; stage_rc(tid * 16 + i * 8192, R, C); const int Rb = Epi::PERM ? ((R & ~31) + perm32(R & 31)) : R;
        voffA[i] = (unsigned)(R * g.lda + C) * 2u; voffB[i] = (unsigned)(Rb * g.ldb + C) * 2u; }
    const size_t kstep = (size_t)(BK * 2);
    const size_t hstepA = (size_t)HALF * g.lda * 2, hstepB = (size_t)HALF * g.ldb * 2;
    const size_t tstepA = 2 * hstepA, tstepB = 2 * hstepB;
    const unsigned ldsw = (unsigned)wid * 1024u;
    const int aoff = lds_byte(wr * 64 + fr, fq * 8), boff = lds_byte(wc * 32 + fr, fq * 8);
#define PG8_SA(b, h) (((b) * 2 + (h)) * HTB)
#define PG8_SB(b, h) ((4 + (b) * 2 + (h)) * HTB)
#define PG8_STAGE(bufoff, gbase, voff) do { _Pragma("unroll") for (int _i = 0; _i < 2; ++_i) \
        __builtin_amdgcn_global_load_lds((const unsigned*)((const char*)(gbase) + (voff)[_i]), (PG8_LAS unsigned*)(lds + (bufoff) + ldsw + _i * 8192), 16, 0, 0); } while (0)
#define PG8_STAGEA(bufoff, gbase, voff) do { _Pragma("unroll") for (int _i = 0; _i < 2; ++_i) \
        __builtin_amdgcn_global_load_lds((const unsigned*)((const char*)(gbase) + (voff)[_i]), (PG8_LAS unsigned*)(lds + (bufoff) + ldsw + _i * 8192), 16, 0, A_NT ? 2 : 0); } while (0)
#define PG8_LDA(dst, b, h) do { _Pragma("unroll") for (int m = 0; m < 4; ++m) _Pragma("unroll") for (int k = 0; k < 2; ++k) dst[m][k] = *(const PG8_LAS bf16x8*)(lds + PG8_SA(b, h) + aoff + m * 2048 + k * 1024); } while (0)
#define PG8_LDB(dst, b, h) do { _Pragma("unroll") for (int n = 0; n < 2; ++n) _Pragma("unroll") for (int k = 0; k < 2; ++k) dst[n][k] = *(const PG8_LAS bf16x8*)(lds + PG8_SB(b, h) + boff + n * 2048 + k * 1024); } while (0)
#define PG8_MMA(ai, bj, At, Bt) do { __builtin_amdgcn_s_setprio(1); _Pragma("unroll") for (int m = 0; m < 4; ++m) _Pragma("unroll") for (int n = 0; n < 2; ++n) _Pragma("unroll") for (int k = 0; k < 2; ++k) \
        acc[ai][bj][m][n] = __builtin_amdgcn_mfma_f32_16x16x32_bf16(Bt[n][k], At[m][k], acc[ai][bj][m][n], 0, 0, 0); __builtin_amdgcn_s_setprio(0); } while (0)
#define PG8_WAIT_V(n) asm volatile("s_waitcnt vmcnt(" #n ")" ::: "memory")
#define PG8_WAIT_L(n) asm volatile("s_waitcnt lgkmcnt(" #n ")" ::: "memory")
#define PG8_BAR __builtin_amdgcn_s_barrier()
#define PG8_SCHED __builtin_amdgcn_sched_barrier(0)
    Unit cur, nxt; int ui = 0;
    if (!S.next(0, cur)) return;
    f32x4 acc[2][2][4][2];
#pragma unroll
    for (int a = 0; a < 2; ++a)
#pragma unroll
        for (int b = 0; b < 2; ++b)
#pragma unroll
            for (int m = 0; m < 4; ++m)
#pragma unroll
                for (int n = 0; n < 2; ++n) acc[a][b][m][n] = (f32x4){0.f, 0.f, 0.f, 0.f};
    bf16x8 At[4][2], B0[2][2], B1[2][2];
    const char* cA = (const char*)g.A + (size_t)cur.pm * tstepA; const char* cB = (const char*)g.Bt + (size_t)cur.pn * tstepB;
    S.a_ready(cur);
    if constexpr (SP2) {
        PG8_STAGE(PG8_SB(0, 0), cB, voffB); PG8_STAGE(PG8_SB(0, 1), cB + hstepB, voffB); PG8_STAGEA(PG8_SA(0, 0), cA, voffA); PG8_STAGEA(PG8_SA(0, 1), cA + hstepA, voffA);
        if (wr == 1) PG8_BAR;
        PG8_WAIT_V(2); PG8_BAR;
        PG8_STAGE(PG8_SB(1, 0), cB + kstep, voffB); PG8_STAGEA(PG8_SA(1, 0), cA + kstep, voffA); PG8_STAGE(PG8_SB(1, 1), cB + hstepB + kstep, voffB);
        PG8_WAIT_V(6); PG8_BAR;
    } else {
        PG8_STAGE(PG8_SB(0, 0), cB, voffB); PG8_STAGEA(PG8_SA(0, 0), cA, voffA); PG8_STAGE(PG8_SB(0, 1), cB + hstepB, voffB); PG8_STAGEA(PG8_SA(0, 1), cA + hstepA, voffA);
        if (wr == 1) PG8_BAR;
        PG8_WAIT_V(4); PG8_BAR;
        PG8_STAGE(PG8_SB(1, 0), cB + kstep, voffB); PG8_STAGEA(PG8_SA(1, 0), cA + kstep, voffA); PG8_STAGE(PG8_SB(1, 1), cB + hstepB + kstep, voffB);
        PG8_WAIT_V(6); PG8_BAR;
    }
    for (;;) {
        const bool has_next = S.next(ui + 1, nxt);
        const char* nA = has_next ? (const char*)g.A + (size_t)nxt.pm * tstepA : cA; const char* nB = has_next ? (const char*)g.Bt + (size_t)nxt.pn * tstepB : cB;
#pragma unroll 1
        for (int t = 0; t < nt; t += 2) {
            const bool last = (t == nt - 2);
            const char* a1 = cA + (size_t)(t + 1) * kstep;
            const char* a2 = last ? nA : cA + (size_t)(t + 2) * kstep; const char* b2 = last ? nB : cB + (size_t)(t + 2) * kstep;
            const char* a3 = a2 + kstep; const char* b3 = b2 + kstep;
            if (last && has_next) S.a_ready(nxt);
            if constexpr (SP2) {
            PG8_LDB(B0, 0, 0); PG8_LDB(B1, 0, 1); PG8_SCHED; PG8_LDA(At, 0, 0); PG8_STAGEA(PG8_SA(1, 1), a1 + hstepA, voffA);
            PG8_WAIT_V(8); PG8_WAIT_L(0); PG8_BAR; PG8_MMA(0, 0, At, B0); PG8_MMA(0, 1, At, B1); PG8_BAR; PG8_SCHED;
            PG8_LDA(At, 0, 1); PG8_STAGE(PG8_SB(0, 0), b2, voffB); PG8_STAGE(PG8_SB(0, 1), b2 + hstepB, voffB); PG8_STAGEA(PG8_SA(0, 0), a2, voffA);
            PG8_WAIT_V(8); PG8_WAIT_L(0); PG8_BAR; PG8_MMA(1, 0, At, B0); PG8_MMA(1, 1, At, B1); PG8_BAR; PG8_SCHED;
            PG8_LDB(B0, 1, 0); PG8_LDB(B1, 1, 1); PG8_SCHED; PG8_LDA(At, 1, 0); PG8_STAGEA(PG8_SA(0, 1), a2 + hstepA, voffA);
            PG8_WAIT_V(8); PG8_WAIT_L(0); PG8_BAR; PG8_MMA(0, 0, At, B0); PG8_MMA(0, 1, At, B1); PG8_BAR; PG8_SCHED;
            PG8_LDA(At, 1, 1); PG8_STAGE(PG8_SB(1, 0), b3, voffB); PG8_STAGE(PG8_SB(1, 1), b3 + hstepB, voffB); PG8_STAGEA(PG8_SA(1, 0), a3, voffA);
            PG8_WAIT_V(8); PG8_WAIT_L(0); PG8_BAR; PG8_MMA(1, 0, At, B0); PG8_MMA(1, 1, At, B1); PG8_BAR; PG8_SCHED;
            } else {
            PG8_LDB(B0, 0, 0); PG8_SCHED; PG8_LDA(At, 0, 0); PG8_STAGEA(PG8_SA(1, 1), a1 + hstepA, voffA);
            PG8_WAIT_L(8); PG8_BAR; PG8_WAIT_L(0); PG8_MMA(0, 0, At, B0); PG8_BAR; PG8_SCHED;
            PG8_LDB(B1, 0, 1); PG8_STAGE(PG8_SB(0, 0), b2, voffB);
            PG8_BAR; PG8_WAIT_L(0); PG8_MMA(0, 1, At, B1); PG8_BAR;
            PG8_LDA(At, 0, 1); PG8_STAGEA(PG8_SA(0, 0), a2, voffA);
            PG8_BAR; PG8_WAIT_L(0); PG8_MMA(1, 0, At, B0); PG8_BAR; PG8_SCHED;
            PG8_STAGE(PG8_SB(0, 1), b2 + hstepB, voffB);
            PG8_WAIT_V(6); PG8_BAR; PG8_MMA(1, 1, At, B1); PG8_BAR;
            PG8_LDB(B0, 1, 0); PG8_SCHED; PG8_LDA(At, 1, 0); PG8_STAGEA(PG8_SA(0, 1), a2 + hstepA, voffA);
            PG8_WAIT_L(8); PG8_BAR; PG8_WAIT_L(0); PG8_MMA(0, 0, At, B0); PG8_BAR; PG8_SCHED;
            PG8_LDB(B1, 1, 1); PG8_STAGE(PG8_SB(1, 0), b3, voffB);
            PG8_BAR; PG8_WAIT_L(0); PG8_MMA(0, 1, At, B1); PG8_BAR;
            PG8_LDA(At, 1, 1); PG8_STAGEA(PG8_SA(1, 0), a3, voffA);
            PG8_BAR; PG8_WAIT_L(0); PG8_MMA(1, 0, At, B0); PG8_BAR; PG8_SCHED;
            PG8_STAGE(PG8_SB(1, 1), b3 + hstepB, voffB);
            PG8_WAIT_V(6); PG8_BAR; PG8_MMA(1, 1, At, B1); PG8_BAR;
            }
        }
        if constexpr (ALIGN_EPI) { if (wr == 0) PG8_BAR; }
        if constexpr (!Epi::AFTER_DRAIN) { E(acc, cur, wr, wc, fr, fq); S.done(cur); }
        if (!has_next) break;
#pragma unroll
        for (int a = 0; a < 2; ++a)
#pragma unroll
            for (int b = 0; b < 2; ++b)
#pragma unroll
                for (int m = 0; m < 4; ++m)
#pragma unroll
                    for (int n = 0; n < 2; ++n) acc[a][b][m][n] = (f32x4){0.f, 0.f, 0.f, 0.f};
        cur = nxt; cA = nA; cB = nB; ++ui;
        if constexpr (ALIGN_EPI) { if (wr == 1) PG8_BAR; }
    }
    PG8_WAIT_V(0);
    if constexpr (!ALIGN_EPI) { if (wr == 0) PG8_BAR; }
    PG8_BAR;
    if constexpr (Epi::AFTER_DRAIN) { E.fused(acc, cur, wr, wc, fr, fq, lds, wid, lane); S.done(cur); }
#undef PG8_SA
#undef PG8_SB
#undef PG8_STAGE
#undef PG8_STAGEA
#undef PG8_LDA
#undef PG8_LDB
#undef PG8_MMA
#undef PG8_WAIT_V
#undef PG8_WAIT_L
#undef PG8_BAR
#undef PG8_SCHED
}
}
#endif

constexpr int BATCH = 8, SEQ = 4096, M = BATCH * SEQ, DM = 1024, FF = 4096, PLE = 256;
constexpr int E_IN = 2208, E_INP = 2304;
constexpr int ZC_CQ = 0, ZC_CKV = 384, ZC_KR = 640, ZC_QB = 672, ZC_KB = 1184, ZC_VB = 1696;
constexpr int QA_N = 768, KVA_N = 1024, QKV_N = 3072;
constexpr float EPS = 1e-6f;
constexpr float LOG2E = 1.4426950408889634f;
constexpr float QS_A = 0.10206207261596575f * LOG2E;
constexpr float QS_B = 0.125f * LOG2E;
constexpr int NWAVES = 8, NTHR = 512;
constexpr int NPH = 24;

constexpr size_t MiB = 1u << 20;
constexpr size_t WS_CTL = 0, CTL_ZERO_BYTES = 65536;
constexpr size_t WS_ROPE = 1 * MiB;
constexpr size_t WS_KMEAN = 5 * MiB;
constexpr size_t WS_W = 6 * MiB;
constexpr size_t WS_SSA = 485 * MiB, WS_SSB = 487 * MiB;
constexpr int UP = 4160;
constexpr size_t WS_Z = 64 * MiB, WS_U = 60 * MiB, WS_QKV = 64 * MiB;
constexpr size_t WS_QA = 208 * MiB, WS_KVA = 256 * MiB, WS_XM1 = 256 * MiB;
constexpr size_t WS_OB = 320 * MiB, WS_LSE = 416 * MiB;
constexpr size_t WS_XNA = 320 * MiB, WS_PB = 384 * MiB, WS_PP = 400 * MiB;
constexpr size_t WS_MIXED = 419 * MiB;
constexpr size_t WS_SSQ = 483 * MiB, WS_SSKV = 484 * MiB;
constexpr size_t WS_END = 489 * MiB;
constexpr int W2P = FF + 64;
constexpr size_t W_INE = 0, W_UQ = W_INE + (size_t)E_INP * DM, W_UKV = W_UQ + (size_t)QA_N * 384, W_OUTE = W_UKV + (size_t)KVA_N * 256,
                 W_INO = W_OUTE + (size_t)DM * DM, W_OUTO = W_INO + (size_t)QKV_N * DM, W_FF1 = W_OUTO + (size_t)DM * DM, W_FF2 = W_FF1 + 2 * (size_t)FF * DM,
                 W_G = W_FF2 + 2 * (size_t)DM * W2P, W_P = W_G + 2 * (size_t)DM * DM, W_END = W_P + 2 * (size_t)DM * PLE;
static_assert(WS_W + W_END * 2 <= WS_U, "weights fit"); static_assert(WS_U + (size_t)32768 * UP * 2 <= 320 * MiB, "U fits below XNA");
constexpr int CW_BAR = 4096;

constexpr int RING_BYTES = 131072, LDSCTL_OFF = RING_BYTES, MISC_OFF = LDSCTL_OFF + 320, LDS_BYTES = 147456;

typedef unsigned short bf16;
typedef unsigned u32x2 __attribute__((ext_vector_type(2)));
typedef unsigned u32x4 __attribute__((ext_vector_type(4)));
typedef float f32x4 __attribute__((ext_vector_type(4)));
typedef float f32x2 __attribute__((ext_vector_type(2)));
typedef GAS unsigned gu32;
#define RLX_AGENT __ATOMIC_RELAXED, __HIP_MEMORY_SCOPE_AGENT
#define LDS_WAIT() asm volatile("s_waitcnt lgkmcnt(0)" ::: "memory")
#define VM_WAIT() asm volatile("s_waitcnt vmcnt(0)" ::: "memory")

__device__ __forceinline__ float bf_lo(unsigned w) { return __uint_as_float(w << 16); }
__device__ __forceinline__ float bf_hi(unsigned w) { return __uint_as_float(w & 0xffff0000u); }
__device__ __forceinline__ float bf2f(bf16 h) { return __uint_as_float((unsigned)h << 16); }
typedef __bf16 bf16x2_hw __attribute__((ext_vector_type(2)));
__device__ __forceinline__ unsigned pk2(float lo, float hi) { const f32x2 v = {lo, hi}; return __builtin_bit_cast(unsigned, __builtin_convertvector(v, bf16x2_hw)); }
__device__ __forceinline__ unsigned f2bf(float f) { return pk2(f, 0.f) & 0xffffu; }
__device__ __forceinline__ float rsq(float x) { return __builtin_amdgcn_rsqf(x); }
template <class T> __device__ __forceinline__ T* as_global(T* p) {
#if defined(__HIP_DEVICE_COMPILE__)
    __builtin_assume(!__builtin_amdgcn_is_shared((const __attribute__((address_space(0))) void*)p)); __builtin_assume(!__builtin_amdgcn_is_private((const __attribute__((address_space(0))) void*)p));
#endif
    return p; }
__device__ __forceinline__ float ex2(float x) { return __builtin_amdgcn_exp2f(x); }
template <int XM> __device__ __forceinline__ float swz_xor(float v) { return __builtin_bit_cast(float, __builtin_amdgcn_ds_swizzle(__builtin_bit_cast(int, v), (XM << 10) | 0x1F)); }
__device__ __forceinline__ float sum_xor32(float v) { auto r = __builtin_amdgcn_permlane32_swap(__float_as_uint(v), __float_as_uint(v), false, false); return __uint_as_float(r[0]) + __uint_as_float(r[1]); }
__device__ __forceinline__ float sum_xor16(float v) { auto r = __builtin_amdgcn_permlane16_swap(__float_as_uint(v), __float_as_uint(v), false, false); return __uint_as_float(r[0]) + __uint_as_float(r[1]); }
__device__ __forceinline__ float get_xor32(float v, bool lo) { auto r = __builtin_amdgcn_permlane32_swap(__float_as_uint(v), __float_as_uint(v), false, false); return lo ? __uint_as_float(r[1]) : __uint_as_float(r[0]); }
__device__ __forceinline__ float wave_sum(float v) {
    v += swz_xor<1>(v); v += swz_xor<2>(v); v += swz_xor<4>(v); v += swz_xor<8>(v); v += swz_xor<16>(v);
    return sum_xor32(v);
}

#define XB_TMO      128
#define XB_XCNT(j)  (256  + 64 * (j))
#define XB_XSUB(j)  (1280 + 64 * (j))
#define XB_XGEN(j)  (2304 + 64 * (j))
#define XB_TOP      3328
#define XB_TOPGEN   3392
#define XCD_BAR_WORDS 3456
#define XB_SPIN_CAP (1u << 22)
__device__ __forceinline__ unsigned xb_ld(unsigned* p)              { return __hip_atomic_load(p, __ATOMIC_RELAXED, __HIP_MEMORY_SCOPE_AGENT); }
__device__ __forceinline__ unsigned xb_add(unsigned* p, unsigned v) { return __hip_atomic_fetch_add(p, v, __ATOMIC_RELAXED, __HIP_MEMORY_SCOPE_AGENT); }
__device__ __forceinline__ unsigned xb_xcc_id() { return (unsigned)__builtin_amdgcn_s_getreg((3 << 11) | 20) & 0xFu; }
#define XB_SPIN(cond, bar) do { unsigned _sp = 0; while (cond) { __builtin_amdgcn_s_sleep(1); \
    if ((++_sp & 255u) == 0u) { if (xb_ld(&(bar)[XB_TMO])) break; if (_sp > XB_SPIN_CAP) { atomicAdd(&(bar)[XB_TMO], 1u); break; } } } } while (0)
struct XcdBarrier { unsigned* bar; unsigned x; volatile LAS unsigned* st; };
__device__ __forceinline__ XcdBarrier xcd_barrier_post(unsigned* bar, volatile LAS unsigned* st) {
    XcdBarrier b; b.bar = bar; b.x = xb_xcc_id(); b.st = st;
    if (threadIdx.x == 0) (void)xb_add(&bar[XB_XCNT(b.x)], 1u);
    return b;
}
__device__ __forceinline__ void xcd_barrier_complete(unsigned* bar, unsigned x, unsigned& nloc, unsigned& nx) {
    const unsigned G = gridDim.x * gridDim.y * gridDim.z;
    unsigned sum, cnt, mine, sp = 0u;
    for (;;) {
        sum = 0u; cnt = 0u; mine = 0u;
#pragma unroll
        for (unsigned j = 0; j < 16; ++j) { const unsigned c = xb_ld(&bar[XB_XCNT(j)]); sum += c; cnt += (c > 0u) ? 1u : 0u; mine = (j == x) ? c : mine; }
        if (sum == G) break;
        __builtin_amdgcn_s_sleep(1);
        if ((++sp & 255u) == 0u) { if (xb_ld(&bar[XB_TMO])) break; if (sp > XB_SPIN_CAP) { atomicAdd(&bar[XB_TMO], 1u); break; } }
    }
    nloc = mine > 0u ? mine : 1u; nx = cnt > 0u ? cnt : 1u;
}
__device__ __forceinline__ void xcd_barrier(const XcdBarrier& b) {
    asm volatile("s_waitcnt vmcnt(0)" ::: "memory");
    __syncthreads();
    if (threadIdx.x == 0) {
        unsigned* bar = b.bar;
        __builtin_amdgcn_s_waitcnt(0);
        unsigned nloc = b.st[0], nx = b.st[1];
        if (nloc == 0u) { xcd_barrier_complete(bar, b.x, nloc, nx); b.st[0] = nloc; b.st[1] = nx; }
        const unsigned old = xb_add(&bar[XB_XSUB(b.x)], 1u);
        const unsigned gen = old / nloc;
        if (old + 1u == (gen + 1u) * nloc) {
            __builtin_amdgcn_fence(__ATOMIC_RELEASE, "agent");
            asm volatile("s_waitcnt vmcnt(0)" ::: "memory");
            const unsigned og = xb_add(&bar[XB_TOP], 1u);
            const unsigned tg = og / nx;
            if (og + 1u == (tg + 1u) * nx) xb_add(&bar[XB_TOPGEN], 1u);
            else XB_SPIN(xb_ld(&bar[XB_TOPGEN]) == tg, bar);
            __builtin_amdgcn_fence(__ATOMIC_ACQUIRE, "agent");
            xb_add(&bar[XB_XGEN(b.x)], 1u);
            asm volatile("s_waitcnt vmcnt(0)" ::: "memory");
        } else {
            XB_SPIN(xb_ld(&bar[XB_XGEN(b.x)]) == gen, bar);
            __builtin_amdgcn_fence(__ATOMIC_ACQUIRE, "agent");
            asm volatile("s_waitcnt vmcnt(0)" ::: "memory");
        }
    }
    __syncthreads();
}

struct Args { const void* in[26]; float* out; unsigned char* ws; int ph_lo, ph_hi; };
struct Frame {
    LAS unsigned char* lds; int tid, lane, wave, vcu, G;
    unsigned char* ws; float* H;
};
enum InIdx { I_X = 0, I_P, I_POS, I_EWIN, I_ECQN, I_ECKVN, I_EWUQ, I_EWUKV, I_EQNN, I_EQNR, I_EKNN, I_EKNR, I_EDQN, I_EDKN, I_EWOUT,
             I_OWIN, I_OQN, I_OKN, I_OWOUT, I_MIXN, I_FFN, I_WFF1, I_WFF2, I_PLEN, I_WG, I_WP };

__device__ __forceinline__ float red_fq(float s) { return sum_xor32(sum_xor16(s)); }
__device__ __forceinline__ float sumsq8(const f32x4& a, const f32x4& b) { return ((a[0] * a[0] + a[1] * a[1]) + (a[2] * a[2] + a[3] * a[3])) + ((b[0] * b[0] + b[1] * b[1]) + (b[2] * b[2] + b[3] * b[3])); }
__device__ __forceinline__ u32x4 pk8(const f32x4& a, const f32x4& b) { u32x4 w; w.x = pk2(a[0], a[1]); w.y = pk2(a[2], a[3]); w.z = pk2(b[0], b[1]); w.w = pk2(b[2], b[3]); return w; }
__device__ __forceinline__ float rstd_from(const float* ss, int n4, float inv_n) { f32x4 t = *(const GAS f32x4*)ss;
    for (int i = 1; i < n4; ++i) t += *(const GAS f32x4*)(ss + 4 * i);
    return rsq(((t[0] + t[1]) + (t[2] + t[3])) * inv_n + EPS); }
__device__ __forceinline__ void rope8(f32x4& y0, f32x4& y1, const float* ROPE, int row, int fq) {
    const GAS f32x4* cs = (const GAS f32x4*)(ROPE + ((size_t)row * 16 + 8 * (fq & 1)) * 2);
#pragma unroll
    for (int i = 0; i < 4; ++i) { const f32x4 t = cs[i >> 1]; const float c0 = (i & 1) ? t[2] : t[0], s0 = (i & 1) ? t[3] : t[1];
        const f32x4 u = cs[2 + (i >> 1)]; const float c1 = (i & 1) ? u[2] : u[0], s1 = (i & 1) ? u[3] : u[1];
        const float p0 = get_xor32(y0[i], fq < 2), p1 = get_xor32(y1[i], fq < 2);
        y0[i] = (fq < 2) ? (y0[i] * c0 - p0 * s0) : (p0 * s0 + y0[i] * c0);
        y1[i] = (fq < 2) ? (y1[i] * c1 - p1 * s1) : (p1 * s1 + y1[i] * c1); }
}

__device__ __forceinline__ u32x4 swap_adj(const u32x4 v) { u32x4 r;
#pragma unroll
    for (int e = 0; e < 4; ++e) r[e] = (unsigned)__builtin_amdgcn_mov_dpp((int)v[e], 0xB1, 0xF, 0xF, true);
    return r; }
template <bool NT> __device__ __forceinline__ void store_lines2(GAS char* own, size_t pitchB, int dist, int row, const u32x4 p0, const u32x4 p1) {
    const bool odd = (row & 1) != 0;
    const u32x4 rcv = swap_adj(odd ? p0 : p1);
    const u32x4 a = odd ? rcv : p0, b = odd ? p1 : rcv;
    GAS char* pa = odd ? own - pitchB + dist : own;
    GAS char* pb = odd ? own + dist : own + pitchB;
    if constexpr (NT) { __builtin_nontemporal_store(a, (GAS u32x4*)pa); __builtin_nontemporal_store(b, (GAS u32x4*)pb); }
    else { *(GAS u32x4*)pa = a; *(GAS u32x4*)pb = b; } }
template <bool NT> __device__ __forceinline__ void load_lines2(const GAS char* own, size_t pitchB, int dist, int row, u32x4& la, u32x4& lb) {
    const bool odd = (row & 1) != 0;
    const GAS char* pa = odd ? own - pitchB + dist : own; const GAS char* pb = odd ? own + dist : own + pitchB;
    if constexpr (NT) { la = __builtin_nontemporal_load((const GAS u32x4*)pa); lb = __builtin_nontemporal_load((const GAS u32x4*)pb); }
    else { la = *(const GAS u32x4*)pa; lb = *(const GAS u32x4*)pb; } }
__device__ __forceinline__ void unswap(int row, const u32x4 la, const u32x4 lb, u32x4& p0, u32x4& p1) {
    const bool odd = (row & 1) != 0; const u32x4 rcv = swap_adj(odd ? la : lb); p0 = odd ? rcv : la; p1 = odd ? lb : rcv; }
struct EpBf16R { bf16* O; int ldc;
    __device__ __forceinline__ void row(int row, int pn, int wc, int fq, const f32x4 (&a)[2][2]) const {
        store_lines2<true>((GAS char*)(O + (size_t)row * ldc + pn * 256 + wc * 64 + fq * 8), (size_t)ldc * 2, 64, row, pk8(a[0][0], a[0][1]), pk8(a[1][0], a[1][1])); } };
struct EpNull {
    __device__ __forceinline__ void row(int, int, int, int, const f32x4 (&a)[2][2]) const { asm volatile("" :: "v"(a[0][0]), "v"(a[0][1]), "v"(a[1][0]), "v"(a[1][1])); } };
__device__ __forceinline__ void unpk8(const u32x4 w, f32x4& a, f32x4& b) { a = (f32x4){bf_lo(w.x), bf_hi(w.x), bf_lo(w.y), bf_hi(w.y)}; b = (f32x4){bf_lo(w.z), bf_hi(w.z), bf_lo(w.w), bf_hi(w.w)}; }
template <bool XF> struct EpResNormT { const float* xf; const bf16* hb; bf16* Hb; float* SS;
    static constexpr int DEPTH = 3;
    struct Ops { f32x4 x[2][2]; };
    __device__ __forceinline__ void load(Ops& p, int row, int pn, int wc, int fq) const { const size_t o = (size_t)row * DM + pn * 256 + wc * 64 + fq * 8;
        u32x4 la, lb;
        if constexpr (XF) {
#pragma unroll
            for (int bj = 0; bj < 2; ++bj) { load_lines2<true>((const GAS char*)(xf + o + 32 * bj), (size_t)DM * 4, 16, row, la, lb); p.x[bj][0] = __builtin_bit_cast(f32x4, la); p.x[bj][1] = __builtin_bit_cast(f32x4, lb); } }
        else { load_lines2<false>((const GAS char*)(hb + o), (size_t)DM * 2, 64, row, la, lb); p.x[0][0] = __builtin_bit_cast(f32x4, la); p.x[1][0] = __builtin_bit_cast(f32x4, lb); p.x[0][1] = p.x[0][0]; p.x[1][1] = p.x[1][0]; } }
    __device__ __forceinline__ void fin(int row, int pn, int wc, int fq, const f32x4 (&a)[2][2], const Ops& p, float& ssr) const { float ss = 0.f; u32x4 w[2];
        u32x4 q[2][2];
        if constexpr (XF) {
#pragma unroll
            for (int bj = 0; bj < 2; ++bj) unswap(row, __builtin_bit_cast(u32x4, p.x[bj][0]), __builtin_bit_cast(u32x4, p.x[bj][1]), q[bj][0], q[bj][1]); }
        else { unswap(row, __builtin_bit_cast(u32x4, p.x[0][0]), __builtin_bit_cast(u32x4, p.x[1][0]), q[0][0], q[1][0]); q[0][1] = q[0][0]; q[1][1] = q[1][0]; }
#pragma unroll
        for (int bj = 0; bj < 2; ++bj) {
            f32x4 b0, b1; if constexpr (XF) { b0 = __builtin_bit_cast(f32x4, q[bj][0]); b1 = __builtin_bit_cast(f32x4, q[bj][1]); } else unpk8(q[bj][0], b0, b1);
            const f32x4 h0 = b0 + a[bj][0], h1 = b1 + a[bj][1];
            ss += sumsq8(h0, h1);
            w[bj] = pk8(h0, h1); }
        store_lines2<false>((GAS char*)(Hb + (size_t)row * DM + pn * 256 + wc * 64 + fq * 8), (size_t)DM * 2, 64, row, w[0], w[1]);
        ssr = red_fq(ss); }
    __device__ __forceinline__ void ss_out(int row, int pn, int wc, float v) const { ((GAS float*)SS)[(size_t)row * 16 + pn * 4 + wc] = v; } };
struct EpRelu2N { bf16* U; const float* SS;
    __device__ __forceinline__ float pre(int row, int fq) const { const f32x4 t = *(const GAS f32x4*)(SS + (size_t)row * 16 + 4 * fq); return rsq(red_fq((t[0] + t[1]) + (t[2] + t[3])) * (1.f / DM) + EPS); }
    __device__ __forceinline__ void row(int row, int pn, int wc, int fq, const f32x4 (&a)[2][2], float rs) const {
        u32x4 w[2];
#pragma unroll
        for (int bj = 0; bj < 2; ++bj) { f32x4 r0, r1;
#pragma unroll
            for (int e = 0; e < 4; ++e) { const float t0 = fmaxf(a[bj][0][e] * rs, 0.f), t1 = fmaxf(a[bj][1][e] * rs, 0.f); r0[e] = t0 * t0; r1[e] = t1 * t1; }
            w[bj] = pk8(r0, r1); }
        store_lines2<true>((GAS char*)(U + (size_t)row * UP + pn * 256 + wc * 64 + fq * 8), (size_t)UP * 2, 64, row, w[0], w[1]); } };
struct EpPleN { const bf16* hb; const bf16* PP; const float* SSi; bf16* Hb; float* SSo; float* OUT;
    static constexpr int DEPTH = 3;
    struct Ops { u32x4 pw[2], hw[2]; f32x4 sq; };
    __device__ __forceinline__ void load(Ops& p, int row, int pn, int wc, int fq) const { p.sq = *(const GAS f32x4*)(SSi + (size_t)row * 16 + 4 * fq);
        { const size_t o = (size_t)row * DM + pn * 256 + wc * 64 + fq * 8;
          load_lines2<false>((const GAS char*)(PP + o), (size_t)DM * 2, 64, row, p.pw[0], p.pw[1]); load_lines2<false>((const GAS char*)(hb + o), (size_t)DM * 2, 64, row, p.hw[0], p.hw[1]); } }
    __device__ __forceinline__ void fin(int row, int pn, int wc, int fq, const f32x4 (&a)[2][2], const Ops& p, float& ssr) const {
        const float rs = rsq(red_fq((p.sq[0] + p.sq[1]) + (p.sq[2] + p.sq[3])) * (1.f / DM) + EPS) * LOG2E; float ss = 0.f;
        u32x4 w[2], pwq[2], hwq[2]; unswap(row, p.pw[0], p.pw[1], pwq[0], pwq[1]); unswap(row, p.hw[0], p.hw[1], hwq[0], hwq[1]);
#pragma unroll
        for (int bj = 0; bj < 2; ++bj) { const int c = pn * 256 + wc * 64 + bj * 32 + fq * 8; const size_t o = (size_t)row * DM + c;
            const u32x4 pw = pwq[bj]; f32x4 h0, h1; unpk8(hwq[bj], h0, h1);
#pragma unroll
            for (int e = 0; e < 4; ++e) { const float g0 = __builtin_amdgcn_rcpf(1.f + ex2(-a[bj][0][e] * rs)), g1 = __builtin_amdgcn_rcpf(1.f + ex2(-a[bj][1][e] * rs));
                const unsigned w0 = pw[e >> 1], w1 = pw[2 + (e >> 1)];
                h0[e] += g0 * ((e & 1) ? bf_hi(w0) : bf_lo(w0)); h1[e] += g1 * ((e & 1) ? bf_hi(w1) : bf_lo(w1)); }
            if (OUT) store_lines2<true>((GAS char*)(OUT + o), (size_t)DM * 4, 16, row, __builtin_bit_cast(u32x4, h0), __builtin_bit_cast(u32x4, h1));
            else { ss += sumsq8(h0, h1); w[bj] = pk8(h0, h1); } }
        if (!OUT) { store_lines2<false>((GAS char*)(Hb + (size_t)row * DM + pn * 256 + wc * 64 + fq * 8), (size_t)DM * 2, 64, row, w[0], w[1]); ssr = red_fq(ss); } }
    __device__ __forceinline__ void ss_out(int row, int pn, int wc, float v) const { if (!OUT) ((GAS float*)SSo)[(size_t)row * 16 + pn * 4 + wc] = v; } };
struct Gains { f32x4 g[2][2]; };
__device__ __forceinline__ void load_gains64(Gains& G, const float* g, int fq) {
#pragma unroll
    for (int bj = 0; bj < 2; ++bj) { G.g[bj][0] = *(const GAS f32x4*)(g + 32 * bj + 8 * fq); G.g[bj][1] = *(const GAS f32x4*)(g + 32 * bj + 8 * fq + 4); } }
template <bool NT = true> __device__ __forceinline__ void head_norm_store(const f32x4 (&a)[2][2], float pre, const Gains& G, float sc, bf16* dst, int fq, int row, size_t pitchB, f32x4 (*colsum)[2] = nullptr) {
    f32x4 v[2][2]; u32x4 w[2];
#pragma unroll
    for (int bj = 0; bj < 2; ++bj) { v[bj][0] = a[bj][0] * pre; v[bj][1] = a[bj][1] * pre; }
    const float ss = red_fq(sumsq8(v[0][0], v[0][1]) + sumsq8(v[1][0], v[1][1])); const float rs = sc * rsq(ss * (1.f / 64.f) + EPS);
#pragma unroll
    for (int bj = 0; bj < 2; ++bj) { const f32x4 y0 = v[bj][0] * rs * G.g[bj][0], y1 = v[bj][1] * rs * G.g[bj][1];
        if (colsum) { colsum[bj][0] += y0; colsum[bj][1] += y1; }
        w[bj] = pk8(y0, y1); }
    store_lines2<NT>((GAS char*)(dst + 8 * fq), pitchB, 64, row, w[0], w[1]);
}
struct EpInE { bf16* Z; const float* ROPE; const float *g_cq, *g_ckv, *g_kr, *g_dq, *g_dk; float* SSQ; float* SSKV;
    __device__ __forceinline__ void gains(Gains& G, int pn, int wc, int fq) const {
        if (pn == 0 || pn == 2) { const float* g = pn ? g_ckv : g_cq;
#pragma unroll
            for (int bj = 0; bj < 2; ++bj) { const int c = bj * 128 + wc * 32 + fq * 8; G.g[bj][0] = *(const GAS f32x4*)(g + c); G.g[bj][1] = *(const GAS f32x4*)(g + c + 4); } }
        else if (pn == 1) { const int c = 256 + wc * 32 + fq * 8; G.g[0][0] = *(const GAS f32x4*)(g_cq + c); G.g[0][1] = *(const GAS f32x4*)(g_cq + c + 4);
            G.g[1][0] = *(const GAS f32x4*)(g_kr + 8 * fq); G.g[1][1] = *(const GAS f32x4*)(g_kr + 8 * fq + 4); }
        else load_gains64(G, (pn >= 5) ? g_dk : g_dq, fq); }
    __device__ __forceinline__ void row(int row, int pn, int wc, int fq, const f32x4 (&a)[2][2], const Gains& G) const { bf16* zr = Z + (size_t)row * E_INP;
        if (pn == 0) { float ss = 0.f;
#pragma unroll
            for (int bj = 0; bj < 2; ++bj) { const int c = bj * 128 + wc * 32 + fq * 8; ss += sumsq8(a[bj][0], a[bj][1]);
                __builtin_nontemporal_store(pk8(a[bj][0] * G.g[bj][0], a[bj][1] * G.g[bj][1]), (GAS u32x4*)(zr + ZC_CQ + c)); }
            ss = red_fq(ss); if (fq == 0) ((GAS float*)SSQ)[(size_t)row * 8 + wc] = ss;
        } else if (pn == 1) {
            { const int c = 256 + wc * 32 + fq * 8; const float ss = red_fq(sumsq8(a[0][0], a[0][1]));
              __builtin_nontemporal_store(pk8(a[0][0] * G.g[0][0], a[0][1] * G.g[0][1]), (GAS u32x4*)(zr + ZC_CQ + c));
              if (fq == 0) ((GAS float*)SSQ)[(size_t)row * 8 + 4 + wc] = ss; }
            if (wc == 0) { const float ss = red_fq(sumsq8(a[1][0], a[1][1])); const float rs = rsq(ss * (1.f / 32.f) + EPS);
                f32x4 y0 = a[1][0] * rs * G.g[1][0], y1 = a[1][1] * rs * G.g[1][1];
                rope8(y0, y1, ROPE, row, fq);
                __builtin_nontemporal_store(pk8(y0, y1), (GAS u32x4*)(zr + ZC_KR + 8 * fq)); }
        } else if (pn == 2) { float ss = 0.f;
#pragma unroll
            for (int bj = 0; bj < 2; ++bj) { const int c = bj * 128 + wc * 32 + fq * 8; ss += sumsq8(a[bj][0], a[bj][1]);
                __builtin_nontemporal_store(pk8(a[bj][0] * G.g[bj][0], a[bj][1] * G.g[bj][1]), (GAS u32x4*)(zr + ZC_CKV + c)); }
            ss = red_fq(ss); if (fq == 0) ((GAS float*)SSKV)[(size_t)row * 4 + wc] = ss;
        } else if (pn < 7) { const int which = (pn >= 5) ? 1 : 0, head = 4 * ((pn - 3) & 1) + wc;
            head_norm_store<false>(a, 1.f, G, which ? 1.f : QS_B, zr + (which ? ZC_KB : ZC_QB) + head * 64, fq, row, (size_t)E_INP * 2);
        } else { const int head = 4 * (pn - 7) + wc;
            store_lines2<false>((GAS char*)(zr + ZC_VB + head * 64 + 8 * fq), (size_t)E_INP * 2, 64, row, pk8(a[0][0], a[0][1]), pk8(a[1][0], a[1][1])); }
    } };
struct EpInE8 { EpInE e;
    __device__ __forceinline__ void gains(Gains& G, int pn, int wc, int fq) const { e.gains(G, 8, wc, fq); }
    __device__ __forceinline__ void row(int row, int pn, int wc, int fq, const f32x4 (&a)[2][2], const Gains& G) const { e.row(row, 8, wc, fq, a, G); } };
struct EpUq { bf16* QA; const float* ROPE; const float *g_qn, *g_qr; const float* SSQ;
    __device__ __forceinline__ float pre(int row, int fq) const { float s = 0.f; if (fq < 2) { const f32x4 t = *(const GAS f32x4*)(SSQ + (size_t)row * 8 + 4 * fq); s = (t[0] + t[1]) + (t[2] + t[3]); } return rsq(red_fq(s) * (1.f / 384.f) + EPS); }
    __device__ __forceinline__ void gains(Gains& G, int pn, int wc, int fq) const {
        if (pn < 2) load_gains64(G, g_qn, fq);
        else { G.g[0][0] = *(const GAS f32x4*)(g_qr + 8 * fq); G.g[0][1] = *(const GAS f32x4*)(g_qr + 8 * fq + 4); G.g[1][0] = G.g[0][0]; G.g[1][1] = G.g[0][1]; } }
    __device__ __forceinline__ void row(int row, int pn, int wc, int fq, const f32x4 (&a)[2][2], float pre, const Gains& G) const { bf16* qr = QA + (size_t)row * QA_N;
        if (pn < 2) head_norm_store(a, pre, G, QS_A, qr + (4 * pn + wc) * 96, fq, row, (size_t)QA_N * 2);
        else {
#pragma unroll
            for (int bj = 0; bj < 2; ++bj) { const f32x4 v0 = a[bj][0] * pre, v1 = a[bj][1] * pre; const float ss = red_fq(sumsq8(v0, v1)); const float rs = rsq(ss * (1.f / 32.f) + EPS);
                f32x4 y0 = v0 * rs * G.g[bj][0], y1 = v1 * rs * G.g[bj][1];
                rope8(y0, y1, ROPE, row, fq);
                __builtin_nontemporal_store(pk8(y0 * QS_A, y1 * QS_A), (GAS u32x4*)(qr + (4 * bj + wc) * 96 + 64 + 8 * fq)); } }
    } };
struct EpUkv { bf16* KVA; const float* g_kn; const float* SSKV;
    __device__ __forceinline__ float pre(int row, int fq) const { return rstd_from(SSKV + (size_t)row * 4, 1, 1.f / 256.f); }
    __device__ __forceinline__ void gains(Gains& G, int pn, int wc, int fq) const { load_gains64(G, g_kn, fq); }
    __device__ __forceinline__ void row(int row, int pn, int wc, int fq, const f32x4 (&a)[2][2], float pre, const Gains& G) const { bf16* kr = KVA + (size_t)row * KVA_N;
        if (pn < 2) head_norm_store(a, pre, G, 1.f, kr + (4 * pn + wc) * 128, fq, row, (size_t)KVA_N * 2);
        else { bf16* vp = kr + (4 * (pn - 2) + wc) * 128 + 64;
            store_lines2<true>((GAS char*)(vp + 8 * fq), (size_t)KVA_N * 2, 64, row, pk8(a[0][0] * pre, a[0][1] * pre), pk8(a[1][0] * pre, a[1][1] * pre)); }
    } };
struct EpInO { bf16* QKV; const float *g_q, *g_k; const float* SS; float* KMEAN;
    struct State { f32x4 cs[2][2]; };
    __device__ __forceinline__ void begin(State& st) const {
#pragma unroll
        for (int bj = 0; bj < 2; ++bj) { st.cs[bj][0] = (f32x4){0.f, 0.f, 0.f, 0.f}; st.cs[bj][1] = (f32x4){0.f, 0.f, 0.f, 0.f}; } }
    __device__ __forceinline__ float pre(int row, int fq) const { const f32x4 t = *(const GAS f32x4*)(SS + (size_t)row * 16 + 4 * fq); return rsq(red_fq((t[0] + t[1]) + (t[2] + t[3])) * (1.f / DM) + EPS); }
    __device__ __forceinline__ void gains(Gains& G, int pn, int wc, int fq) const { load_gains64(G, ((pn >> 2) == 1) ? g_k : g_q, fq); }
    __device__ __forceinline__ void row(int row, int pn, int wc, int fq, const f32x4 (&a)[2][2], State& st, float pre, const Gains& G) const {
        const int sec = pn >> 2, head = 4 * (pn & 3) + wc; bf16* dst = QKV + (size_t)row * QKV_N + sec * 1024 + head * 64;
        if (sec == 0) head_norm_store(a, pre, G, QS_B, dst, fq, row, (size_t)QKV_N * 2);
        else if (sec == 1) head_norm_store(a, pre, G, 1.f, dst, fq, row, (size_t)QKV_N * 2, st.cs);
        else {
            store_lines2<true>((GAS char*)(dst + 8 * fq), (size_t)QKV_N * 2, 64, row, pk8(a[0][0] * pre, a[0][1] * pre), pk8(a[1][0] * pre, a[1][1] * pre)); }
    }
    __device__ __forceinline__ void end(State& st, int pm, int pn, int wc, int fr, int fq) const {
        if ((pn >> 2) != 1) return;
        const int head = 4 * (pn & 3) + wc, b = pm >> 4, n = pm & 15;
        float* km = KMEAN + ((size_t)(b * 16 + head) * 16 + n) * 64;
#pragma unroll
        for (int bj = 0; bj < 2; ++bj)
#pragma unroll
            for (int q = 0; q < 2; ++q)
#pragma unroll
                for (int e = 0; e < 4; ++e) { float s = st.cs[bj][q][e]; s += swz_xor<1>(s); s += swz_xor<2>(s); s += swz_xor<4>(s); s += swz_xor<8>(s);
                    if (fr == 0) atomicAdd(km + 32 * bj + 8 * fq + 4 * q + e, s * (1.f / 256.f)); }
    } };

template <class Inner, class = void> struct HasState { static constexpr bool value = false; };
template <class Inner> struct HasState<Inner, decltype((void)sizeof(typename Inner::State))> { static constexpr bool value = true; };
template <class Inner, class = void> struct HasOps { static constexpr bool value = false; };
template <class Inner> struct HasOps<Inner, decltype((void)sizeof(typename Inner::Ops))> { static constexpr bool value = true; };
template <class Inner, class = void> struct HasGains { static constexpr bool value = false; };
template <class Inner> struct HasGains<Inner, decltype((void)&Inner::gains)> { static constexpr bool value = true; };
template <class Inner, class = void> struct HasPre { static constexpr bool value = false; };
template <class Inner> struct HasPre<Inner, decltype((void)&Inner::pre)> { static constexpr bool value = true; };
template <class Inner> struct EpiRow {
    static constexpr bool PERM = true, AFTER_DRAIN = false; Inner in;
    __device__ __forceinline__ void operator()(const pg8::f32x4 (&acc)[2][2][4][2], const pg8::Unit& u, int wr, int wc, int fr, int fq) const {
        if constexpr (HasState<Inner>::value) {
            typename Inner::State st; in.begin(st); Gains G; in.gains(G, u.pn, wc, fq);
            float rs[8];
#pragma unroll
            for (int g = 0; g < 8; ++g) rs[g] = in.pre(u.pm * 256 + (g >> 2) * 128 + wr * 64 + (g & 3) * 16 + fr, fq);
#pragma unroll
            for (int ai = 0; ai < 2; ++ai)
#pragma unroll
                for (int m = 0; m < 4; ++m) { const int row = u.pm * 256 + ai * 128 + wr * 64 + m * 16 + fr;
                    const f32x4 a[2][2] = {{acc[ai][0][m][0], acc[ai][0][m][1]}, {acc[ai][1][m][0], acc[ai][1][m][1]}};
                    in.row(row, u.pn, wc, fq, a, st, rs[ai * 4 + m], G);
                    asm volatile("" ::: "memory"); }
            in.end(st, u.pm, u.pn, wc, fr, fq);
        } else if constexpr (HasOps<Inner>::value) {
            constexpr int D = Inner::DEPTH; typename Inner::Ops ops[8]; float ssk = 0.f;
#define EPI_ROW(g) (u.pm * 256 + ((g) >> 2) * 128 + wr * 64 + ((g) & 3) * 16 + fr)
#pragma unroll
            for (int g = 0; g < D; ++g) in.load(ops[g], EPI_ROW(g), u.pn, wc, fq);
            asm volatile("" ::: "memory");
#pragma unroll
            for (int g = 0; g < 8; ++g) { const int ai = g >> 2, m = g & 3;
                const f32x4 a[2][2] = {{acc[ai][0][m][0], acc[ai][0][m][1]}, {acc[ai][1][m][0], acc[ai][1][m][1]}};
                float ssg = 0.f; in.fin(EPI_ROW(g), u.pn, wc, fq, a, ops[g], ssg);
                ssk = (fq == (g & 3)) ? ssg : ssk;
                if ((g & 3) == 3) in.ss_out(u.pm * 256 + (g >> 2) * 128 + wr * 64 + 16 * fq + fr, u.pn, wc, ssk);
                if (g + D < 8) in.load(ops[g + D], EPI_ROW(g + D), u.pn, wc, fq);
                asm volatile("" ::: "memory"); }
#undef EPI_ROW
        } else if constexpr (HasPre<Inner>::value) {
            float rs[8]; Gains G; if constexpr (HasGains<Inner>::value) in.gains(G, u.pn, wc, fq);
#pragma unroll
            for (int g = 0; g < 8; ++g) rs[g] = in.pre(u.pm * 256 + (g >> 2) * 128 + wr * 64 + (g & 3) * 16 + fr, fq);
#pragma unroll
            for (int ai = 0; ai < 2; ++ai)
#pragma unroll
                for (int m = 0; m < 4; ++m) { const int row = u.pm * 256 + ai * 128 + wr * 64 + m * 16 + fr;
                    const f32x4 a[2][2] = {{acc[ai][0][m][0], acc[ai][0][m][1]}, {acc[ai][1][m][0], acc[ai][1][m][1]}};
                    if constexpr (HasGains<Inner>::value) in.row(row, u.pn, wc, fq, a, rs[ai * 4 + m], G); else in.row(row, u.pn, wc, fq, a, rs[ai * 4 + m]);
                    asm volatile("" ::: "memory"); }
        } else {
            Gains G; if constexpr (HasGains<Inner>::value) in.gains(G, u.pn, wc, fq);
#pragma unroll
            for (int ai = 0; ai < 2; ++ai)
#pragma unroll
                for (int m = 0; m < 4; ++m) { const int row = u.pm * 256 + ai * 128 + wr * 64 + m * 16 + fr;
                    const f32x4 a[2][2] = {{acc[ai][0][m][0], acc[ai][0][m][1]}, {acc[ai][1][m][0], acc[ai][1][m][1]}};
                    if constexpr (HasGains<Inner>::value) in.row(row, u.pn, wc, fq, a, G); else in.row(row, u.pn, wc, fq, a);
                    asm volatile("" ::: "memory"); }
        }
    }
};
template <class Inner, bool A_NT = false> __device__ __forceinline__ void run_gemm(const Frame& F, const bf16* A, int lda, const bf16* Bt, int N, int K, const Inner& in, int rot = 0, int ldb = 0) {
    int bid_ = blockIdx.x; asm volatile("" : "+s"(bid_));
    { int c_ = bid_ + rot; if (c_ >= F.G) c_ -= F.G; bid_ = c_; }
    pg8::Gemm g{A, Bt, M, N, K, lda, ldb ? ldb : K}; pg8::StaticOrder S; S.init(M, N, F.G, bid_);
    EpiRow<Inner> E{in};
    pg8::gemm_phase<EpiRow<Inner>, pg8::StaticOrder, true, GEMM_SP2, A_NT>(F.lds, g, S, E);
}

__device__ __forceinline__ int head_row(int tile, int h, int d) { return tile * 256 + 32 * (h & 3) + (d & 31) + 128 * (d >> 5); }
__device__ __forceinline__ int perm_ine(int n) {
    if (n < 384) return n;
    if (n < 640) return 512 + (n - 384);
    if (n < 672) return 384 + (n - 640);
    const int x = n - 672, sec = x >> 9, h = (x >> 6) & 7, d = x & 63; return head_row(3 + 2 * sec + (h >> 2), h, d);
}
__device__ __forceinline__ int perm_uq(int n) { const int h = n / 96, r = n - 96 * h; if (r < 64) return head_row(h >> 2, h, r); return 512 + 128 * (h >> 2) + 32 * (h & 3) + (r - 64); }
__device__ __forceinline__ int perm_ukv(int n) { const int h = n >> 7, part = (n >> 6) & 1, d = n & 63; return head_row(2 * part + (h >> 2), h, d); }
__device__ __forceinline__ int perm_ino(int n) { const int sec = n >> 10, h = (n >> 6) & 15, d = n & 63; return head_row(4 * sec + (h >> 2), h, d); }
struct RowId { __device__ __forceinline__ int operator()(int n) const { return n; } };
template <class RowMap> __device__ __forceinline__ void p0_transpose_item(const float* W, int K, int N, bf16* WT, LAS float* scr, int item, int lane, const RowMap& rm, const float* gk = nullptr, int ldw = 0) {
    if (ldw == 0) ldw = K;
    const int nblk = N / 32, kb = item / nblk, nb = item % nblk, k0 = 64 * kb, n0 = 32 * nb;
    { const int r8 = lane >> 3, c4 = (lane & 7) * 4; f32x4 v[8]; float gs[8];
#pragma unroll
      for (int i = 0; i < 8; ++i) { const int kk = 8 * i + r8; v[i] = __builtin_nontemporal_load((const GAS f32x4*)((const GAS float*)W + (size_t)(k0 + kk) * N + n0 + c4)); gs[i] = gk ? ((const GAS float*)gk)[k0 + kk] : 1.f; }
#pragma unroll
      for (int i = 0; i < 8; ++i) { LAS float* d = scr + (8 * i + r8) * 33 + c4; d[0] = v[i][0] * gs[i]; d[1] = v[i][1] * gs[i]; d[2] = v[i][2] * gs[i]; d[3] = v[i][3] * gs[i]; } }
    LDS_WAIT(); asm volatile("" ::: "memory");
    const int c = lane & 7;
#pragma unroll
    for (int j = 0; j < 4; ++j) { const int n = (lane >> 3) + 8 * j; const LAS float* s = scr + (8 * c) * 33 + n;
        u32x4 o; o.x = pk2(s[0 * 33], s[1 * 33]); o.y = pk2(s[2 * 33], s[3 * 33]); o.z = pk2(s[4 * 33], s[5 * 33]); o.w = pk2(s[6 * 33], s[7 * 33]);
        *(GAS u32x4*)(WT + (size_t)rm(n0 + n) * ldw + k0 + 8 * c) = o; }
    LDS_WAIT(); asm volatile("" ::: "memory");
}
template <int NR> __device__ __forceinline__ void rms_rows_1024(const float* x0, size_t rstride, const float* g, bf16* o0, int lane) {
    const GAS f32x4* gr = (const GAS f32x4*)g + lane;
    f32x4 v[NR][4]; float s[NR];
#pragma unroll
    for (int r = 0; r < NR; ++r) { const GAS f32x4* xr = (const GAS f32x4*)(x0 + r * rstride) + lane; s[r] = 0.f;
#pragma unroll
        for (int j = 0; j < 4; ++j) v[r][j] = __builtin_nontemporal_load(xr + 64 * j); }
    f32x4 gg[4];
#pragma unroll
    for (int j = 0; j < 4; ++j) gg[j] = gr[64 * j];
#pragma unroll
    for (int r = 0; r < NR; ++r) {
#pragma unroll
        for (int j = 0; j < 4; ++j) s[r] += (v[r][j].x * v[r][j].x + v[r][j].y * v[r][j].y) + (v[r][j].z * v[r][j].z + v[r][j].w * v[r][j].w);
        const float rstd = rsq(wave_sum(s[r]) * (1.f / DM) + EPS);
        GAS u32x2* o8 = (GAS u32x2*)(o0 + r * rstride) + lane;
#pragma unroll
        for (int j = 0; j < 4; ++j) { u32x2 w; w.x = pk2(v[r][j].x * rstd * gg[j].x, v[r][j].y * rstd * gg[j].y); w.y = pk2(v[r][j].z * rstd * gg[j].z, v[r][j].w * rstd * gg[j].w); o8[64 * j] = w; } }
}
__device__ __forceinline__ void rms_rows_phase(const Frame& F, const float* src, const float* g, bf16* dst) {
    const int gw = F.vcu * NWAVES + F.wave, NGW = F.G * NWAVES;
    int m = gw;
    for (; m + 3 * NGW < M; m += 4 * NGW) rms_rows_1024<4>(src + (size_t)m * DM, (size_t)NGW * DM, g, dst + (size_t)m * DM, F.lane);
    for (; m < M; m += NGW) rms_rows_1024<1>(src + (size_t)m * DM, (size_t)NGW * DM, g, dst + (size_t)m * DM, F.lane);
}
__device__ __forceinline__ void pb_phase(const Frame& F, const float* p, bf16* PB) {
    const size_t n8 = (size_t)M * PLE / 8; const size_t gt = (size_t)F.vcu * NTHR + F.tid, ngt = (size_t)F.G * NTHR;
    for (size_t i = gt; i < n8; i += ngt) { const f32x4 a = __builtin_nontemporal_load((const GAS f32x4*)p + 2 * i), b = __builtin_nontemporal_load((const GAS f32x4*)p + 2 * i + 1);
        u32x4 w; w.x = pk2(a.x, a.y); w.y = pk2(a.z, a.w); w.z = pk2(b.x, b.y); w.w = pk2(b.z, b.w); ((GAS u32x4*)PB)[i] = w; }
}
__constant__ double INVF4[4] = {1.0, 0.5623413251903491, 0.31622776601683794, 0.1778279410038923};
__constant__ double INVF10[4] = {1.0, 0.1, 0.01, 0.001};
__constant__ unsigned long long MOBA_OB[16] = {0x5fdc94e12a067b38ull, 0xe3ab421d5f6c9078ull, 0x64f81dc0e352ab79ull, 0xfa2b948ce756d013ull, 0x72cdb63954108feaull, 0xb46a83512cf09de7ull, 0x9bd32e6804ca5f17ull, 0x30186faec5794b2dull,
                                               0x97acdef8465b3012ull, 0xba12d0c5396874feull, 0x7e5c14af3d9b0268ull, 0x6a32450789b1dcefull, 0xfedc9b7864a51230ull, 0x31bfcd24e69a7850ull, 0x73c16b58d042ef9aull, 0x017563c4982fbedaull};

#define WITEMG(IDX, SUB, KK, NN, DST, RM, GK) { constexpr int cnt_ = ((KK) / 64) * ((NN) / 32); if (r < cnt_) { p0_transpose_item(as_global((const float*)AP->in[IDX]) + (SUB), (KK), (NN), Wb + (DST), scr, r, F.lane, RM, GK); continue; } r -= cnt_; }
#define WITEMP(IDX, SUB, KK, NN, DST, RM) WITEMG(IDX, SUB, KK, NN, DST, RM, (const float*)nullptr)
#define WITEM(IDX, SUB, KK, NN, DST) WITEMP(IDX, SUB, KK, NN, DST, RmPlain{})
#define WITEML(IDX, SUB, KK, NN, DST, LDW) { constexpr int cnt_ = ((KK) / 64) * ((NN) / 32); if (r < cnt_) { p0_transpose_item(as_global((const float*)AP->in[IDX]) + (SUB), (KK), (NN), Wb + (DST), scr, r, F.lane, RmPlain{}, (const float*)nullptr, (LDW)); continue; } r -= cnt_; }
struct RmPlain { __device__ __forceinline__ int operator()(int n) const { const int c = n & 255; return (n & ~255) + 128 * ((c >> 5) & 1) + 32 * (c >> 6) + (c & 31); } };
struct RmInE { __device__ __forceinline__ int operator()(int n) const { return perm_ine(n); } };
struct RmUq  { __device__ __forceinline__ int operator()(int n) const { return perm_uq(n); } };
struct RmUkv { __device__ __forceinline__ int operator()(int n) const { return perm_ukv(n); } };
struct RmInO { __device__ __forceinline__ int operator()(int n) const { return perm_ino(n); } };
constexpr int WITEMS_P0 = (1024 / 64) * (E_IN / 32) + (384 / 64) * (768 / 32) + (256 / 64) * (1024 / 32);
constexpr int WITEMS_TOTAL = (1024 / 64) * (E_IN / 32) + (384 / 64) * (768 / 32) + (256 / 64) * (1024 / 32) + (1024 / 64) * (1024 / 32) + (1024 / 64) * (3072 / 32) + (1024 / 64) * (1024 / 32)
                           + 2 * (1024 / 64) * (4096 / 32) + 2 * (4096 / 64) * (1024 / 32) + 2 * (1024 / 64) * (1024 / 32) + 2 * (256 / 64) * (1024 / 32);


namespace att {
typedef short bf16x8 __attribute__((ext_vector_type(8)));
typedef short s16x4 __attribute__((ext_vector_type(4)));
typedef float f32x16 __attribute__((ext_vector_type(16)));
typedef float f32x2_t __attribute__((ext_vector_type(2)));
typedef __bf16 bf16x2_t __attribute__((ext_vector_type(2)));
typedef LAS const char* lds_cptr;
constexpr int KSLOT_B = 12288, VSLOT_B = 8192;
constexpr int LDS_K = 0, LDS_V = 4 * KSLOT_B, LDS_WS = LDS_V + 3 * VSLOT_B, LDS_OST = LDS_WS + 8 * 256, LDS_ATT_BYTES = LDS_OST + 8 * 4096;
#define ATT_SBAR() __builtin_amdgcn_sched_barrier(0)
#if ATT_PROBE == 6
#define ATT_WAIT_BAR() asm volatile("s_waitcnt vmcnt(0) lgkmcnt(0)\n\ts_barrier\n\ts_barrier" ::: "memory")
#else
#define ATT_WAIT_BAR() asm volatile("s_waitcnt vmcnt(0) lgkmcnt(0)\n\ts_barrier" ::: "memory")
#endif
__device__ __forceinline__ void wait_bar_n(int n) {
    if (n <= 0)      asm volatile("s_waitcnt vmcnt(0) lgkmcnt(0)\n\ts_barrier" ::: "memory");
    else if (n == 1) asm volatile("s_waitcnt vmcnt(1) lgkmcnt(0)\n\ts_barrier" ::: "memory");
    else if (n == 2) asm volatile("s_waitcnt vmcnt(2) lgkmcnt(0)\n\ts_barrier" ::: "memory");
    else             asm volatile("s_waitcnt vmcnt(3) lgkmcnt(0)\n\ts_barrier" ::: "memory");
}
__device__ __forceinline__ int crow(int r, int hi) { return (r & 3) + 8 * (r >> 2) + 4 * hi; }
__device__ __forceinline__ void glds16(const void* gsrc, unsigned lds_dst) { unsigned keep;
    asm volatile("s_mov_b32 %0, m0\n\ts_mov_b32 m0, %2\n\ts_nop 0\n\tglobal_load_lds_dwordx4 %1, off\n\ts_mov_b32 m0, %0" : "=&s"(keep) : "v"(gsrc), "s"(lds_dst) : "memory"); }
__device__ __forceinline__ unsigned cvtpk(float lo, float hi) { f32x2_t v = {lo, hi}; bf16x2_t b = __builtin_convertvector(v, bf16x2_t); return __builtin_bit_cast(unsigned, b); }

template <int NKS> __device__ __forceinline__ void qk_tile(f32x16& p0, f32x16& p1, lds_cptr kslot, const bf16x8* qr, const f32x16& c0, const f32x16& c1, int r32, int hi) {
    lds_cptr kb = kslot + hi * 1024 + r32 * 16;
#pragma unroll
    for (int d0 = 0; d0 < NKS; ++d0) {
        const bf16x8 b0 = *(const LAS bf16x8*)(kb + d0 * 2048), b1 = *(const LAS bf16x8*)(kb + d0 * 2048 + 512);
        if (d0 == 0) { p0 = __builtin_amdgcn_mfma_f32_32x32x16_bf16(b0, qr[0], c0, 0, 0, 0); p1 = __builtin_amdgcn_mfma_f32_32x32x16_bf16(b1, qr[0], c1, 0, 0, 0); }
        else { p0 = __builtin_amdgcn_mfma_f32_32x32x16_bf16(b0, qr[d0], p0, 0, 0, 0); p1 = __builtin_amdgcn_mfma_f32_32x32x16_bf16(b1, qr[d0], p1, 0, 0, 0); }
#if ATT_PROBE == 2
        { static_assert(NKS >= 4, ""); if (d0 < 4) { f32x16 z0 = __builtin_amdgcn_mfma_f32_32x32x16_bf16(b1, qr[d0], c0, 0, 0, 0), z1 = __builtin_amdgcn_mfma_f32_32x32x16_bf16(b0, qr[d0], c1, 0, 0, 0); asm volatile("" :: "v"(z0), "v"(z1)); } }
#endif
    }
}
__device__ __forceinline__ void exp_pack(f32x16& p0, f32x16& p1, float& lsum, bf16x8 (&pa)[4]) {
    float s0 = 0.f, s1 = 0.f;
#pragma unroll
    for (int r = 0; r < 16; ++r) { p0[r] = __builtin_amdgcn_exp2f(p0[r]); p1[r] = __builtin_amdgcn_exp2f(p1[r]); s0 += p0[r]; s1 += p1[r]; }
    lsum += s0 + s1;
#if ATT_PROBE == 1
    { float dm = 0.f;
#pragma unroll
      for (int r = 0; r < 16; ++r) { dm += __builtin_amdgcn_exp2f(p0[r] * 0.5f); dm += __builtin_amdgcn_exp2f(p1[r] * 0.5f); }
      asm volatile("" :: "v"(dm)); }
#endif
    u32x4 w0, w1, w2, w3;
#pragma unroll
    for (int e = 0; e < 4; ++e) { w0[e] = cvtpk(p0[2 * e], p0[2 * e + 1]); w1[e] = cvtpk(p0[8 + 2 * e], p0[8 + 2 * e + 1]); w2[e] = cvtpk(p1[2 * e], p1[2 * e + 1]); w3[e] = cvtpk(p1[8 + 2 * e], p1[8 + 2 * e + 1]); }
    pa[0] = __builtin_bit_cast(bf16x8, w0); pa[1] = __builtin_bit_cast(bf16x8, w1); pa[2] = __builtin_bit_cast(bf16x8, w2); pa[3] = __builtin_bit_cast(bf16x8, w3);
}
struct VFrag { s16x4 lo[8], hi[8]; };
__device__ __forceinline__ void v_issue(VFrag& f, int vb) {
#pragma unroll
    for (int d0 = 0; d0 < 2; ++d0)
#pragma unroll
        for (int ks = 0; ks < 4; ++ks) {
            asm volatile("ds_read_b64_tr_b16 %0,%1 offset:%c2" : "=&v"(f.lo[d0 * 4 + ks]) : "v"(vb), "i"(d0 * 4096 + ks * 1024) : "memory");
            asm volatile("ds_read_b64_tr_b16 %0,%1 offset:%c2" : "=&v"(f.hi[d0 * 4 + ks]) : "v"(vb), "i"(d0 * 4096 + ks * 1024 + 512) : "memory"); }
}
__device__ __forceinline__ void pv_mfma(f32x16* o, VFrag& f, const bf16x8 (&pa)[4]) {
    asm volatile("s_waitcnt lgkmcnt(0)" : "+v"(f.lo[0]), "+v"(f.lo[1]), "+v"(f.lo[2]), "+v"(f.lo[3]), "+v"(f.lo[4]), "+v"(f.lo[5]), "+v"(f.lo[6]), "+v"(f.lo[7]),
                                          "+v"(f.hi[0]), "+v"(f.hi[1]), "+v"(f.hi[2]), "+v"(f.hi[3]), "+v"(f.hi[4]), "+v"(f.hi[5]), "+v"(f.hi[6]), "+v"(f.hi[7]) :: "memory");
    ATT_SBAR();
#define ATT_PK(k) (bf16x8){f.lo[k][0], f.lo[k][1], f.lo[k][2], f.lo[k][3], f.hi[k][0], f.hi[k][1], f.hi[k][2], f.hi[k][3]}
    __builtin_amdgcn_s_setprio(1);
    o[0] = __builtin_amdgcn_mfma_f32_32x32x16_bf16(pa[0], ATT_PK(0), o[0], 0, 0, 0);
    o[1] = __builtin_amdgcn_mfma_f32_32x32x16_bf16(pa[0], ATT_PK(4), o[1], 0, 0, 0);
    o[0] = __builtin_amdgcn_mfma_f32_32x32x16_bf16(pa[1], ATT_PK(1), o[0], 0, 0, 0);
    o[1] = __builtin_amdgcn_mfma_f32_32x32x16_bf16(pa[1], ATT_PK(5), o[1], 0, 0, 0);
    o[0] = __builtin_amdgcn_mfma_f32_32x32x16_bf16(pa[2], ATT_PK(2), o[0], 0, 0, 0);
    o[1] = __builtin_amdgcn_mfma_f32_32x32x16_bf16(pa[2], ATT_PK(6), o[1], 0, 0, 0);
    o[0] = __builtin_amdgcn_mfma_f32_32x32x16_bf16(pa[3], ATT_PK(3), o[0], 0, 0, 0);
    o[1] = __builtin_amdgcn_mfma_f32_32x32x16_bf16(pa[3], ATT_PK(7), o[1], 0, 0, 0);
    __builtin_amdgcn_s_setprio(0);
#undef ATT_PK
}
__device__ __forceinline__ void cmask(f32x16& p0, f32x16& p1, int kvb, int qrel, int hi) {
#pragma unroll
    for (int r = 0; r < 16; ++r) { const int kv = kvb + crow(r, hi); if (kv > qrel) p0[r] = -INFINITY; if (kv + 32 > qrel) p1[r] = -INFINITY; }
}
__device__ __forceinline__ void bmask(f32x16& p0, f32x16& p1, int kvb, int qrel, int hi) {
#pragma unroll
    for (int r = 0; r < 16; ++r) { const int d = qrel - (kvb + crow(r, hi)); if (d < 0 || d > 128) p0[r] = -INFINITY; if (d - 32 < 0 || d - 32 > 128) p1[r] = -INFINITY; }
}
#define ATT_PIN(x) asm volatile("" : "+v"(x))
__device__ __forceinline__ float pcat(const f32x16& P0, const f32x16& P1, int i) { return (i < 16) ? P0[i] : P1[i - 16]; }
__device__ __forceinline__ s16x4 vtr(lds_cptr p) { return __builtin_bit_cast(s16x4, __builtin_amdgcn_ds_read_tr16_b64_v4i16((LAS s16x4*)p)); }
__device__ __forceinline__ void kload2(bf16x8* kf, lds_cptr kp, int d0) { kf[2 * d0] = *(const LAS bf16x8*)(kp + d0 * 2048); kf[2 * d0 + 1] = *(const LAS bf16x8*)(kp + d0 * 2048 + 512); }
__device__ __forceinline__ void kload2s(bf16x8* kf, lds_cptr kb, const int* koff, int d0) { kf[2 * d0] = *(const LAS bf16x8*)(kb + koff[d0]); kf[2 * d0 + 1] = *(const LAS bf16x8*)(kb + koff[d0] + 4096); }
__device__ __forceinline__ void swz_dma_lane(int wid, int lane, int& row, int& chunk) { row = 8 * wid + (lane >> 3); chunk = (lane & 7) ^ (((lane >> 4) & 3) | ((wid & 1) << 2)); }
__device__ __forceinline__ void swz_koff(int r32, int hi, int (&koff)[4]) { const int t = ((r32 & 7) >> 1) | (((r32 >> 3) & 1) << 2), b = 128 * r32 + 16 * (hi ^ (t & 1)), x = 32 * (t >> 1);
#pragma unroll
    for (int d0 = 0; d0 < 4; ++d0) koff[d0] = b + (x ^ (32 * d0)); }
template <int NKS, bool HASPREV, bool DOQK, bool CZERO, bool MASKED, bool SWZ = false>
__device__ __forceinline__ void att_pa(f32x16& C0, f32x16& C1, const f32x16& P0, const f32x16& P1, float& lsum, bf16x8* kf, lds_cptr kcp, s16x4* vlo, s16x4* vhi, u32x4* pw, lds_cptr vp,
                                       const bf16x8* qr, int jb, int qrel, int hi, const int* roff = nullptr) {
    float sacc = 0.f;
    ATT_SBAR();
#pragma unroll
    for (int i = 0; i < (DOQK ? 2 * NKS : 8); ++i) {
        if constexpr (HASPREV) { if (i < 8) { const int f = (i >> 1) + 4 * (i & 1); vlo[f] = vtr(vp + (f >> 2) * 4096 + (f & 3) * 1024); vhi[f] = vtr(vp + (f >> 2) * 4096 + (f & 3) * 1024 + 512); ATT_SBAR(); } }
        if constexpr (DOQK) { const int d0 = i >> 1;
            if (i >= 4 && i + 4 < 2 * NKS) {
                if constexpr (SWZ) kf[i + 4] = *(const LAS bf16x8*)(kcp + roff[((i + 4) >> 1) - 4] + ((i + 4) & 1) * 2048);
                else kf[i + 4] = *(const LAS bf16x8*)(kcp + ((i + 4) >> 1) * 2048 + ((i + 4) & 1) * 512); }
            if (i & 1) { if (CZERO && d0 == 0) C1 = __builtin_amdgcn_mfma_f32_32x32x16_bf16(kf[i], qr[d0], f32x16{}, 0, 0, 0); else C1 = __builtin_amdgcn_mfma_f32_32x32x16_bf16(kf[i], qr[d0], C1, 0, 0, 0); }
            else         { if (CZERO && d0 == 0) C0 = __builtin_amdgcn_mfma_f32_32x32x16_bf16(kf[i], qr[d0], f32x16{}, 0, 0, 0); else C0 = __builtin_amdgcn_mfma_f32_32x32x16_bf16(kf[i], qr[d0], C0, 0, 0, 0); } }
        if constexpr (HASPREV) { if (i < 8) {
#pragma unroll
            for (int k = 0; k < 4; ++k) sacc += pcat(P0, P1, 4 * i + k);
            ATT_PIN(sacc);
#pragma unroll
            for (int k = 0; k < 2; ++k) { const int j = 2 * i + k; pw[j >> 2][j & 3] = cvtpk(pcat(P0, P1, 2 * j), pcat(P0, P1, 2 * j + 1)); }
            ATT_PIN(pw[(2 * i) >> 2]); } }
        ATT_SBAR();
    }
    lsum += sacc;
    if constexpr (DOQK && MASKED) cmask(C0, C1, 64 * jb, qrel, hi);
    ATT_SBAR();
}
#define ATT_FMK(d, CR, sl, base) asm volatile("v_fmamk_f32 %0, %1, %2, %3" : "=v"(d) : "v"(sl), "n"(__builtin_bit_cast(unsigned, (float)(CR))), "v"(base))
template <int NKS, bool HASPREV, bool DOQK, bool BIASNEXT, bool GL, int I, bool SWZ>
__device__ __forceinline__ void att_pb_gap(f32x16& C0, f32x16& C1, f32x16& P0, f32x16& P1, f32x16* o, bf16x8* kf, const s16x4* vlo, const s16x4* vhi, const u32x4* pw, lds_cptr knp,
                                           float sl, float basen, float base32, const int* koff) {
#define ATT_PK(k) (bf16x8){vlo[k][0], vlo[k][1], vlo[k][2], vlo[k][3], vhi[k][0], vhi[k][1], vhi[k][2], vhi[k][3]}
    constexpr int G0 = 2;
    if constexpr (GL && I >= G0 && I < G0 + 4) { if constexpr (SWZ) kload2s(kf, knp, koff, I - G0); else kload2(kf, knp, I - G0); ATT_SBAR(); }
    if constexpr (HASPREV) { constexpr int ks = I >> 1, d0 = I & 1; o[d0] = __builtin_amdgcn_mfma_f32_32x32x16_bf16(__builtin_bit_cast(bf16x8, pw[ks]), ATT_PK(d0 * 4 + ks), o[d0], 0, 0, 0); }
    if constexpr (DOQK) {
        if constexpr (I < 4) {
#pragma unroll
            for (int k = 0; k < 4; ++k) C0[4 * I + k] = __builtin_amdgcn_exp2f(C0[4 * I + k]);
            ATT_PIN(C0); }
        else {
#pragma unroll
            for (int k = 0; k < 4; ++k) C1[4 * (I - 4) + k] = __builtin_amdgcn_exp2f(C1[4 * (I - 4) + k]);
            ATT_PIN(C1); } }
    if constexpr (BIASNEXT) {
        if constexpr (I < 4) { float d0_, d1_, d2_, d3_;
            ATT_FMK(d0_, 8 * I + 0, sl, basen); ATT_FMK(d1_, 8 * I + 1, sl, basen); ATT_FMK(d2_, 8 * I + 2, sl, basen); ATT_FMK(d3_, 8 * I + 3, sl, basen);
            P0[4 * I + 0] = d0_; P0[4 * I + 1] = d1_; P0[4 * I + 2] = d2_; P0[4 * I + 3] = d3_; ATT_PIN(P0); }
        else { constexpr int J = I - 4; float d0_, d1_, d2_, d3_;
            ATT_FMK(d0_, 8 * J + 0, sl, base32); ATT_FMK(d1_, 8 * J + 1, sl, base32); ATT_FMK(d2_, 8 * J + 2, sl, base32); ATT_FMK(d3_, 8 * J + 3, sl, base32);
            P1[4 * J + 0] = d0_; P1[4 * J + 1] = d1_; P1[4 * J + 2] = d2_; P1[4 * J + 3] = d3_; ATT_PIN(P1); } }
    ATT_SBAR();
#undef ATT_PK
}
template <int NKS, bool HASPREV, bool DOQK, bool BIASNEXT, bool GL, bool SWZ = false>
__device__ __forceinline__ void att_pb(f32x16& C0, f32x16& C1, f32x16& P0, f32x16& P1, f32x16* o, bf16x8* kf, const s16x4* vlo, const s16x4* vhi, const u32x4* pw, lds_cptr knp,
                                       float sl, float basen, float step32, const int* koff = nullptr) {
    const float base32 = basen + step32;
#define ATT_GAPB(I) att_pb_gap<NKS, HASPREV, DOQK, BIASNEXT, GL, I, SWZ>(C0, C1, P0, P1, o, kf, vlo, vhi, pw, knp, sl, basen, base32, koff)
    ATT_GAPB(0); ATT_GAPB(1); ATT_GAPB(2); ATT_GAPB(3); ATT_GAPB(4); ATT_GAPB(5); ATT_GAPB(6); ATT_GAPB(7);
#undef ATT_GAPB
}
#define ATT_WAITN(n) do { if ((n) <= 0) asm volatile("s_waitcnt vmcnt(0) lgkmcnt(0)\n\ts_barrier" ::: "memory"); else if ((n) == 1) asm volatile("s_waitcnt vmcnt(1) lgkmcnt(0)\n\ts_barrier" ::: "memory"); \
        else if ((n) == 2) asm volatile("s_waitcnt vmcnt(2) lgkmcnt(0)\n\ts_barrier" ::: "memory"); else asm volatile("s_waitcnt vmcnt(3) lgkmcnt(0)\n\ts_barrier" ::: "memory"); } while (0)
__device__ __forceinline__ float finish_l(float lsum) { return sum_xor32(lsum); }
template <class RowPtr> __device__ __forceinline__ void store_o2(const f32x16* o, float ltot, LAS unsigned char* wsb, LAS unsigned char* ostb, int wid, int lane, const RowPtr& orow) {
    const int r32 = lane & 31, hi = lane >> 5;
    LAS float* wsf = (LAS float*)wsb + wid * 64;
    if (hi == 0) wsf[r32] = ltot;
    asm volatile("s_waitcnt lgkmcnt(0)" ::: "memory");
    float rli[16];
#pragma unroll
    for (int r = 0; r < 16; ++r) rli[r] = __builtin_amdgcn_rcpf(wsf[crow(r, hi)]);
    LAS bf16* stg = (LAS bf16*)ostb + wid * 2048;
#pragma unroll
    for (int r = 0; r < 16; ++r) { const int orw = crow(r, hi);
#pragma unroll
        for (int d0 = 0; d0 < 2; ++d0) stg[orw * 64 + d0 * 32 + r32] = (bf16)f2bf(o[d0][r] * rli[r]); }
    asm volatile("s_waitcnt lgkmcnt(0)" ::: "memory");
#pragma unroll
    for (int i = 0; i < 4; ++i) { const int row = i * 8 + (lane >> 3), ch = lane & 7; const u32x4 v = *(const LAS u32x4*)(stg + row * 64 + ch * 8); __builtin_nontemporal_store(v, (GAS u32x4*)(orow(row) + ch * 8)); }
}
template <class RowPtr> __device__ __forceinline__ void store_o(const f32x16* o, float ltot, LAS unsigned char* shm, int wid, int lane, const RowPtr& orow) { store_o2(o, ltot, shm + LDS_WS, shm + LDS_OST, wid, lane, orow); }
template <class RowPtrB, class RowPtrO, class RowIdx>
__device__ __forceinline__ void store_merge2(const f32x16* o, float ltot, LAS unsigned char* wsb, LAS unsigned char* ostb, int wid, int lane, const RowPtrB& ob1, const RowPtrB& ob2, const float* l1p, const float* l2p,
                                            const RowIdx& lrow, const RowPtrO& orow) {
    const int r32 = lane & 31, hi = lane >> 5;
    LAS float* wsf = (LAS float*)wsb + wid * 64;
    if (hi == 0) wsf[r32] = ltot;
    LAS float* stg = (LAS float*)ostb + wid * 1024;
#pragma unroll
    for (int d0 = 0; d0 < 2; ++d0) {
#pragma unroll
        for (int r = 0; r < 16; ++r) stg[crow(r, hi) * 32 + r32] = o[d0][r];
        asm volatile("s_waitcnt lgkmcnt(0)" ::: "memory");
#pragma unroll
        for (int i = 0; i < 2; ++i) { const int row = i * 16 + (lane >> 2), ch = lane & 3, col = d0 * 32 + ch * 8;
            const f32x4 a0 = *(const LAS f32x4*)(stg + row * 32 + ch * 8), a1 = *(const LAS f32x4*)(stg + row * 32 + ch * 8 + 4);
            const float l3 = wsf[row], l1 = ((const GAS float*)l1p)[lrow(row)], l2 = ((const GAS float*)l2p)[lrow(row)];
            const u32x4 w1 = *(const GAS u32x4*)(ob1(row) + col), w2 = *(const GAS u32x4*)(ob2(row) + col);
            const float rl = __builtin_amdgcn_rcpf(l1 + l2 + l3); u32x4 ow;
#pragma unroll
            for (int e = 0; e < 4; ++e) { const float x0 = (e < 2 ? a0[2 * e] : a1[2 * e - 4]), x1 = (e < 2 ? a0[2 * e + 1] : a1[2 * e - 3]);
                ow[e] = pk2((l1 * bf_lo(w1[e]) + l2 * bf_lo(w2[e]) + x0) * rl, (l1 * bf_hi(w1[e]) + l2 * bf_hi(w2[e]) + x1) * rl); }
            *(GAS u32x4*)(orow(row) + col) = ow; }
        asm volatile("s_waitcnt lgkmcnt(0)" ::: "memory");
    }
}
struct MergeOps { u32x4 w1[4], w2[4]; float l1[4], l2[4]; };
template <class RowPtrB, class RowIdx>
__device__ __forceinline__ void merge_load(MergeOps& m, int lane, const RowPtrB& ob1, const RowPtrB& ob2, const float* l1p, const float* l2p, const RowIdx& lrow) {
#pragma unroll
    for (int i = 0; i < 4; ++i) { const int row = i * 8 + (lane >> 3), col = (lane & 7) * 8;
        m.l1[i] = ((const GAS float*)l1p)[lrow(row)]; m.l2[i] = ((const GAS float*)l2p)[lrow(row)];
        m.w1[i] = *(const GAS u32x4*)(ob1(row) + col); m.w2[i] = *(const GAS u32x4*)(ob2(row) + col); }
}
template <class RowPtrO>
__device__ __forceinline__ void merge_finish(const f32x16* o, float ltot, LAS unsigned char* wsb, LAS unsigned char* ostb, int wid, int lane, const MergeOps& m, const RowPtrO& orow) {
    const int r32 = lane & 31, hi = lane >> 5;
    LAS float* wsf = (LAS float*)wsb + wid * 64;
    if (hi == 0) wsf[r32] = ltot;
    asm volatile("s_waitcnt lgkmcnt(0)" ::: "memory");
    float rli[16];
#pragma unroll
    for (int r = 0; r < 16; ++r) rli[r] = __builtin_amdgcn_rcpf(wsf[crow(r, hi)]);
    LAS bf16* stg = (LAS bf16*)ostb + wid * 2048;
#pragma unroll
    for (int r = 0; r < 16; ++r) { const int orw = crow(r, hi);
#pragma unroll
        for (int d0 = 0; d0 < 2; ++d0) stg[orw * 64 + d0 * 32 + r32] = (bf16)f2bf(o[d0][r] * rli[r]); }
    asm volatile("s_waitcnt lgkmcnt(0)" ::: "memory");
#pragma unroll
    for (int i = 0; i < 4; ++i) { const int row = i * 8 + (lane >> 3), ch = lane & 7;
        const u32x4 v = *(const LAS u32x4*)(stg + row * 64 + ch * 8); const float l3 = wsf[row], l1 = m.l1[i], l2 = m.l2[i];
        const u32x4 w1 = m.w1[i], w2 = m.w2[i];
        const float rl = __builtin_amdgcn_rcpf(l1 + l2 + l3); u32x4 ow;
#pragma unroll
        for (int e = 0; e < 4; ++e) ow[e] = pk2((l1 * bf_lo(w1[e]) + l2 * bf_lo(w2[e]) + l3 * bf_lo(v[e])) * rl, (l1 * bf_hi(w1[e]) + l2 * bf_hi(w2[e]) + l3 * bf_hi(v[e])) * rl);
        *(GAS u32x4*)(orow(row) + ch * 8) = ow; }
}
template <class RowPtrB, class RowPtrO, class RowIdx>
__device__ __forceinline__ void store_merge(const f32x16* o, float ltot, LAS unsigned char* shm, int wid, int lane, const RowPtrB& ob1, const RowPtrB& ob2, const float* l1p, const float* l2p,
                                            const RowIdx& lrow, const RowPtrO& orow) { store_merge2(o, ltot, shm + LDS_WS, shm + LDS_OST, wid, lane, ob1, ob2, l1p, l2p, lrow, orow); }
}


namespace att {
struct RowLin { bf16* base; size_t pitch; __device__ __forceinline__ bf16* operator()(int i) const { return base + (size_t)i * pitch; } };
#define ATT_RFL(x) ((unsigned)__builtin_amdgcn_readfirstlane((int)(x)))

__device__ __forceinline__ void mla_unit(LAS unsigned char* shm, int b, int h, int qb, const bf16* QA, const bf16* KVA, const bf16* Z, bf16* MIXED, int tid_in) {
    int tid = tid_in; asm volatile("" : "+v"(tid));
    const int lane = tid & 63, r32 = lane & 31, hi = lane >> 5; const int wid = __builtin_amdgcn_readfirstlane(tid >> 6);
    const unsigned lds0 = (unsigned)(uintptr_t)shm;
    const size_t rowbase = (size_t)b * SEQ; const int q0 = qb * 256;
    int dl_row, dl_chunk; swz_dma_lane(wid, lane, dl_row, dl_chunk); int koff[4]; swz_koff(r32, hi, koff);
    int roff[2]; { const int t_ = (r32 >> 2) & 3; roff[0] = 8192 + 64 * r32 + 16 * (hi ^ t_); roff[1] = 8192 + 64 * r32 + 16 * ((2 + hi) ^ t_); }
    const bf16* ksrcN = KVA + (rowbase + dl_row) * KVA_N + h * 128 + dl_chunk * 8;
    const bf16* ksrcR = Z + (rowbase + 16 * (wid & 3) + (lane >> 2)) * E_INP + ZC_KR + ((lane & 3) ^ ((lane >> 4) & 3)) * 8;
    const bf16* vsrc = KVA + (rowbase + 16 * (wid & 3) + (lane >> 2)) * KVA_N + h * 128 + 64 + (wid >> 2) * 32 + (lane & 3) * 8;
#define MLA_DMAK(t, slot) do { glds16(ksrcN + (size_t)(t) * 64 * KVA_N, ATT_RFL(lds0 + LDS_K + (slot) * KSLOT_B + wid * 1024)); \
        if (wid < 4) glds16(ksrcR + (size_t)(t) * 64 * E_INP, ATT_RFL(lds0 + LDS_K + (slot) * KSLOT_B + (8 + wid) * 1024)); } while (0)
#define MLA_DMAV(t, slot) glds16(vsrc + (size_t)(t) * 64 * KVA_N, ATT_RFL(lds0 + LDS_V + (slot) * VSLOT_B + wid * 1024))
    MLA_DMAK(0, 0); MLA_DMAK(1, 1); MLA_DMAV(0, 0); MLA_DMAK(2, 2);
    const bf16* Qw = QA + (rowbase + q0 + wid * 32 + r32) * QA_N + h * 96 + hi * 8;
    bf16x8 qr[6];
#pragma unroll
    for (int d0 = 0; d0 < 6; ++d0) qr[d0] = *(const GAS bf16x8*)(Qw + d0 * 16);
    f32x16 o[2]; o[0] = f32x16{}; o[1] = f32x16{}; float lsum = 0.f;
    const int NT = 4 * qb + 4, qrel = wid * 32 + r32;
    const lds_cptr vp0 = (lds_cptr)(shm + LDS_V) + ((lane >> 4) & 1) * 32 + (lane & 3) * 8 + (4 * hi + ((lane & 15) >> 2)) * 64;
    const lds_cptr ks0 = (lds_cptr)(shm + LDS_K);
    f32x16 pA0, pA1, pB0, pB1; bf16x8 kf[12]; s16x4 vlo[8], vhi[8]; u32x4 pw[4];
    const int kper = (wid < 4) ? 2 : 1;
    int sc = 0, sn = KSLOT_B, sf = 2 * KSLOT_B, sg = 3 * KSLOT_B;
    int vp = 2 * VSLOT_B, vc = 0, vn = VSLOT_B;
    ATT_WAIT_BAR();
#pragma unroll
    for (int d0 = 0; d0 < 4; ++d0) kload2s(kf, ks0, koff, d0);
#define MLA_STEP(C0, C1, P0, P1, t, HP, MSK, GK, GV, GL) do { \
        att_pa<6, HP, true, true, MSK, true>(C0, C1, P0, P1, lsum, kf, ks0 + sc, vlo, vhi, pw, vp0 + vp, qr, (t) - (NT - 4), qrel, hi, roff); \
        if (GK) MLA_DMAK((t) + 3, sg / KSLOT_B); if (GV) MLA_DMAV((t) + 1, vn / VSLOT_B); \
        att_pb<6, HP, true, false, GL, true>(C0, C1, P0, P1, o, kf, vlo, vhi, pw, ks0 + sn, 0.f, 0.f, 0.f, koff); \
        { const int n_ = ((GK) ? kper : 0) + ((GV) ? 1 : 0); ATT_WAITN(n_); } \
        { const int s_ = sc; sc = sn; sn = sf; sf = sg; sg = s_; const int v_ = vp; vp = vc; vc = vn; vn = v_; } } while (0)
    MLA_STEP(pA0, pA1, pB0, pB1, 0, false, true, true, true, true);
    int t = 1;
    for (; t + 5 < NT; t += 2) { MLA_STEP(pB0, pB1, pA0, pA1, t, true, false, true, true, true); MLA_STEP(pA0, pA1, pB0, pB1, t + 1, true, false, true, true, true); }
    for (; t + 1 < NT; t += 2) { MLA_STEP(pB0, pB1, pA0, pA1, t, true, true, (t + 3 < NT), true, true); MLA_STEP(pA0, pA1, pB0, pB1, t + 1, true, true, (t + 4 < NT), true, true); }
    MLA_STEP(pB0, pB1, pA0, pA1, NT - 1, true, true, false, false, false);
    att_pa<6, true, false, true, false, true>(pA0, pA1, pB0, pB1, lsum, kf, ks0 + sc, vlo, vhi, pw, vp0 + vp, qr, -1, qrel, hi, roff);
    att_pb<6, true, false, false, false, true>(pA0, pA1, pB0, pB1, o, kf, vlo, vhi, pw, ks0, 0.f, 0.f, 0.f, koff);
#undef MLA_STEP
#undef MLA_DMAK
#undef MLA_DMAV
    const float ltot = finish_l(lsum);
    store_o(o, ltot, shm, wid, lane, RowLin{MIXED + (rowbase + q0 + wid * 32) * DM + h * 64, (size_t)DM});
    asm volatile("s_waitcnt lgkmcnt(0)\n\ts_barrier" ::: "memory");
}

struct RowCLin { const bf16* base; size_t pitch; __device__ __forceinline__ const bf16* operator()(int i) const { return base + (size_t)i * pitch; } };
struct RowIdxLin { size_t base, pitch; __device__ __forceinline__ size_t operator()(int i) const { return base + (size_t)i * pitch; } };
__device__ __forceinline__ void dil_unit(LAS unsigned char* shm, int b, int h, int br, int rcls, int qb, const bf16* Z, bf16* OB, float* LSE, bf16* MIXED, int tid_in) {
    int tid = tid_in; asm volatile("" : "+v"(tid));
    const int lane = tid & 63, r32 = lane & 31, hi = lane >> 5; const int wid = __builtin_amdgcn_readfirstlane(tid >> 6);
    const unsigned lds0 = (unsigned)(uintptr_t)shm;
    const int dil = 1 << (2 * br);
    const long rowbase = (long)b * SEQ + rcls; const int q0 = qb * 256, kt0 = q0 - 128;
    const bf16* ksrc = Z + (rowbase + (long)dil * (kt0 + lane)) * E_INP + ZC_KB + h * 64 + wid * 8;
    const bf16* vsrc = Z + (rowbase + (long)dil * (kt0 + 16 * (wid & 3) + (lane >> 2))) * E_INP + ZC_VB + h * 64 + (wid >> 2) * 32 + (lane & 3) * 8;
    const long tstep = (long)dil * 64 * E_INP;
#define DIL_DMA(t, slot) do { glds16(ksrc + (long)(t) * tstep, ATT_RFL(lds0 + LDS_K + (slot) * KSLOT_B + wid * 1024)); \
        glds16(vsrc + (long)(t) * tstep, ATT_RFL(lds0 + LDS_V + (slot) * VSLOT_B + wid * 1024)); } while (0)
    const int tstart = (qb == 0) ? 2 : 0;
    DIL_DMA(tstart, tstart & 1);
    const bf16* Qw = Z + (rowbase + (long)dil * (q0 + wid * 32 + r32)) * E_INP + ZC_QB + h * 64 + hi * 8;
    bf16x8 qr[4];
#pragma unroll
    for (int d0 = 0; d0 < 4; ++d0) qr[d0] = *(const GAS bf16x8*)(Qw + d0 * 16);
    f32x16 o[2]; o[0] = f32x16{}; o[1] = f32x16{}; float lsum = 0.f;
    const float sd = __builtin_amdgcn_exp2f(-(float)(h + 1)) * LOG2E * (float)dil;
    f32x16 av;
#pragma unroll
    for (int r = 0; r < 16; ++r) av[r] = sd * (float)crow(r, hi);
    const int qrel = wid * 32 + r32;
    const int vb0 = (int)(lds0 + LDS_V) + ((lane >> 4) & 1) * 32 + (lane & 3) * 8 + (4 * hi + ((lane & 15) >> 2)) * 64;
    for (int t = tstart; t < 6; ++t) {
        ATT_WAIT_BAR();
        if (t + 1 < 6) DIL_DMA(t + 1, (t + 1) & 1);
        const int tl = wid >> 1;
        if (t >= tl && t <= tl + 2) {
            const int kvb = 64 * t - 128; const float base0 = sd * (float)(kvb - qrel);
            f32x16 c0, c1;
#pragma unroll
            for (int r = 0; r < 16; ++r) { c0[r] = av[r] + base0; c1[r] = c0[r] + 32.f * sd; }
            f32x16 p0, p1; qk_tile<4>(p0, p1, (lds_cptr)(shm + LDS_K + (t & 1) * KSLOT_B), qr, c0, c1, r32, hi);
            VFrag vf; v_issue(vf, vb0 + (t & 1) * VSLOT_B);
            bmask(p0, p1, kvb, qrel, hi);
            bf16x8 pa[4]; exp_pack(p0, p1, lsum, pa);
            pv_mfma(o, vf, pa);
        }
    }
#undef DIL_DMA
    const float ltot = finish_l(lsum);
    const long orow0 = rowbase + (long)dil * (q0 + wid * 32);
    if (br < 2) {
        store_o(o, ltot, shm, wid, lane, RowLin{OB + (size_t)br * M * 512 + (size_t)orow0 * 512 + h * 64, (size_t)dil * 512});
        if (hi == 0) ((GAS float*)LSE)[(size_t)br * M * 8 + (size_t)(orow0 + (long)dil * r32) * 8 + h] = ltot;
    } else {
        store_merge(o, ltot, shm, wid, lane, RowCLin{OB + (size_t)orow0 * 512 + h * 64, (size_t)dil * 512}, RowCLin{OB + (size_t)M * 512 + (size_t)orow0 * 512 + h * 64, (size_t)dil * 512},
                    LSE, LSE + (size_t)M * 8, RowIdxLin{(size_t)orow0 * 8 + h, (size_t)dil * 8}, RowLin{MIXED + (size_t)orow0 * DM + 512 + h * 64, (size_t)dil * DM});
    }
    asm volatile("s_waitcnt lgkmcnt(0)\n\ts_barrier" ::: "memory");
}

constexpr int DSLOT_B = 24576, DLDS_OST = 4 * DSLOT_B, DLDS_WS = 135168;
struct DilS { int b, h, br, rcls, R0, R1; };
__device__ __forceinline__ bool dil_get(int list, int u, DilS& d) {
    if (list == 0) { if (u >= 512) return false;
        if (u < 256) { d.b = u >> 5; d.h = (u >> 2) & 7; d.br = 0; d.rcls = 0; d.R0 = 16 * (u & 3); d.R1 = d.R0 + 16; }
        else { const int v = u - 256; d.b = v >> 5; d.h = (v >> 2) & 7; d.br = 1; d.rcls = v & 3; d.R0 = 0; d.R1 = 16; } }
    else { if (u >= 1024) return false; d.b = u >> 7; d.h = (u >> 4) & 7; d.br = 2; d.rcls = u & 15; d.R0 = 0; d.R1 = 4; }
    return true;
}
#define DIL_WAITN(n) do { const int n_ = (n); \
        if (n_ <= 0) asm volatile("s_waitcnt vmcnt(0) lgkmcnt(0)\n\ts_barrier" ::: "memory"); else if (n_ == 1) asm volatile("s_waitcnt vmcnt(1) lgkmcnt(0)\n\ts_barrier" ::: "memory"); \
        else if (n_ == 2) asm volatile("s_waitcnt vmcnt(2) lgkmcnt(0)\n\ts_barrier" ::: "memory"); else if (n_ == 3) asm volatile("s_waitcnt vmcnt(3) lgkmcnt(0)\n\ts_barrier" ::: "memory"); \
        else if (n_ == 4) asm volatile("s_waitcnt vmcnt(4) lgkmcnt(0)\n\ts_barrier" ::: "memory"); else if (n_ == 5) asm volatile("s_waitcnt vmcnt(5) lgkmcnt(0)\n\ts_barrier" ::: "memory"); \
        else asm volatile("s_waitcnt vmcnt(6) lgkmcnt(0)\n\ts_barrier" ::: "memory"); } while (0)
__device__ __forceinline__ void dil_stream(LAS unsigned char* shm, int list, int vcu, int G, const bf16* Z, bf16* OB, float* LSE, bf16* MIXED, int tid_in) {
    int tid = tid_in; asm volatile("" : "+v"(tid));
    const int lane = tid & 63, r32 = lane & 31, hi = lane >> 5; const int wid = __builtin_amdgcn_readfirstlane(tid >> 6);
    const int pr = wid >> 1, sub = wid & 1;
    const unsigned lds0 = (unsigned)(uintptr_t)shm;
    DilS Dp; int kp = 0; bool okp = dil_get(list, vcu, Dp); int Tp = Dp.R0 - 2;
    if (!okp) return;
    DilS Dc = Dp; int kc = 0; bool okc = true; int Tc = Tp;
    const int dl_row = 8 * wid + (lane >> 3), dl_chunk = (lane & 7) ^ (((lane >> 4) & 3) | ((wid & 1) << 2));
    int koff[4];
    { const int t_ = ((r32 & 7) >> 1) | (((r32 >> 3) & 1) << 2), b_ = 128 * r32 + 16 * (hi ^ (t_ & 1)), x_ = 32 * (t_ >> 1);
#pragma unroll
      for (int d0 = 0; d0 < 4; ++d0) koff[d0] = b_ + (x_ ^ (32 * d0)); }
#define DIL_ISSUE(slot_, pcs_) do { pcs_ = 0; if (okp) { const int dil_ = 1 << (2 * Dp.br); const long rb_ = (long)Dp.b * SEQ + Dp.rcls; const unsigned sb_ = lds0 + (slot_) * DSLOT_B + wid * 1024; \
            if (Tp >= 0) { glds16(Z + (rb_ + (long)dil_ * (64 * Tp + dl_row)) * E_INP + ZC_KB + Dp.h * 64 + dl_chunk * 8, ATT_RFL(sb_)); \
                           glds16(Z + (rb_ + (long)dil_ * (64 * Tp + 16 * (wid & 3) + (lane >> 2))) * E_INP + ZC_VB + Dp.h * 64 + (wid >> 2) * 32 + (lane & 3) * 8, ATT_RFL(sb_ + 8192)); pcs_ += 2; } \
            if (Tp + 2 < Dp.R1) { glds16(Z + (rb_ + (long)dil_ * (64 * (Tp + 2) + dl_row)) * E_INP + ZC_QB + Dp.h * 64 + dl_chunk * 8, ATT_RFL(sb_ + 16384)); pcs_ += 1; } \
            if (++Tp >= Dp.R1) { ++kp; okp = dil_get(list, vcu + kp * G, Dp); Tp = Dp.R0 - 2; } } } while (0)
    int pc0, pc1, pc2; DIL_ISSUE(0, pc0); DIL_ISSUE(1, pc1); DIL_ISSUE(2, pc2); (void)pc0;
    bf16x8 qr[4]; f32x16 o[2]; float lsum = 0.f, sd = 0.f;
#pragma unroll
    for (int d0 = 0; d0 < 4; ++d0) qr[d0] = bf16x8{};
    o[0] = f32x16{}; o[1] = f32x16{};
    bool pend = false; int eb = 0, eh = 0, ebr = 0, ercls = 0, eR = 0;
    MergeOps mo;
#pragma unroll
    for (int i = 0; i < 4; ++i) { mo.w1[i] = u32x4{}; mo.w2[i] = u32x4{}; mo.l1[i] = 0.f; mo.l2[i] = 0.f; }
    const int vb0 = (int)lds0 + 8192 + ((lane >> 4) & 1) * 32 + (lane & 3) * 8 + (4 * hi + ((lane & 15) >> 2)) * 64;
#define DIL_EPI() do { const float ltot = finish_l(lsum); const int dil_ = 1 << (2 * ebr); const long orow0 = (long)eb * SEQ + ercls + (long)dil_ * (64 * eR + 32 * sub); \
        if (ebr < 2) { store_o2(o, ltot, shm + DLDS_WS, shm + DLDS_OST, wid, lane, RowLin{OB + (size_t)ebr * M * 512 + (size_t)orow0 * 512 + eh * 64, (size_t)dil_ * 512}); \
            if (hi == 0) ((GAS float*)LSE)[(size_t)ebr * M * 8 + (size_t)(orow0 + (long)dil_ * r32) * 8 + eh] = ltot; } \
        else merge_finish(o, ltot, shm + DLDS_WS, shm + DLDS_OST, wid, lane, mo, RowLin{MIXED + (size_t)orow0 * DM + 512 + eh * 64, (size_t)dil_ * DM}); \
        pend = false; } while (0)
    int slot = 0;
    while (okc) {
        DIL_WAITN(pc1 + pc2);
        const int T = Tc, dd = (pr - T) & 3, R = T + dd;
        const bool act = (dd <= 2) && (R >= Dc.R0) && (R < Dc.R1);
        if (pend && (!act || dd == 2)) { DIL_EPI(); int pc3; DIL_ISSUE((slot + 3) & 3, pc3); pc1 = pc2; pc2 = pc3; }
        else { int pc3; DIL_ISSUE((slot + 3) & 3, pc3); pc1 = pc2; pc2 = pc3; }
        if (act) {
            LAS unsigned char* const sl_ = shm + slot * DSLOT_B;
            if (dd == 2) {
                lds_cptr qp = (lds_cptr)(sl_ + 16384) + 4096 * sub;
#pragma unroll
                for (int d0 = 0; d0 < 4; ++d0) qr[d0] = *(const LAS bf16x8*)(qp + koff[d0]);
                o[0] = f32x16{}; o[1] = f32x16{}; lsum = 0.f;
                sd = __builtin_amdgcn_exp2f(-(float)(Dc.h + 1)) * LOG2E * (float)(1 << (2 * Dc.br)); }
            if (dd == 0 && Dc.br == 2) {
                const int dil_ = 16; const long orow0 = (long)Dc.b * SEQ + Dc.rcls + (long)dil_ * (64 * R + 32 * sub);
                merge_load(mo, lane, RowCLin{OB + (size_t)orow0 * 512 + Dc.h * 64, (size_t)dil_ * 512}, RowCLin{OB + (size_t)M * 512 + (size_t)orow0 * 512 + Dc.h * 64, (size_t)dil_ * 512},
                           LSE, LSE + (size_t)M * 8, RowIdxLin{(size_t)orow0 * 8 + Dc.h, (size_t)dil_ * 8}); }
            if (T >= 0) {
                const int qrel = 64 * dd + 32 * sub + r32; const float base0 = -sd * (float)qrel;
                f32x16 c0, c1;
#pragma unroll
                for (int r = 0; r < 16; ++r) { c0[r] = __builtin_fmaf(sd, (float)crow(r, hi), base0); c1[r] = c0[r] + 32.f * sd; }
                f32x16 p0, p1;
#pragma unroll
                for (int d0 = 0; d0 < 4; ++d0) { const bf16x8 b0 = *(const LAS bf16x8*)((lds_cptr)sl_ + koff[d0]), b1 = *(const LAS bf16x8*)((lds_cptr)sl_ + koff[d0] + 4096);
                    if (d0 == 0) { p0 = __builtin_amdgcn_mfma_f32_32x32x16_bf16(b0, qr[0], c0, 0, 0, 0); p1 = __builtin_amdgcn_mfma_f32_32x32x16_bf16(b1, qr[0], c1, 0, 0, 0); }
                    else { p0 = __builtin_amdgcn_mfma_f32_32x32x16_bf16(b0, qr[d0], p0, 0, 0, 0); p1 = __builtin_amdgcn_mfma_f32_32x32x16_bf16(b1, qr[d0], p1, 0, 0, 0); } }
                VFrag vf; v_issue(vf, vb0 + slot * DSLOT_B);
                if (dd != 1) bmask(p0, p1, 0, qrel, hi);
                bf16x8 pa[4]; exp_pack(p0, p1, lsum, pa);
                pv_mfma(o, vf, pa);
            }
            if (dd == 0) { pend = true; eb = Dc.b; eh = Dc.h; ebr = Dc.br; ercls = Dc.rcls; eR = R; }
        }
        if (++Tc >= Dc.R1) { ++kc; okc = dil_get(list, vcu + kc * G, Dc); Tc = Dc.R0 - 2; }
        slot = (slot + 1) & 3;
    }
    if (pend) DIL_EPI();
    asm volatile("s_waitcnt vmcnt(0) lgkmcnt(0)\n\ts_barrier" ::: "memory");
#undef DIL_ISSUE
#undef DIL_EPI
}

__device__ __forceinline__ float moba_bound(const float* g_q, const float* g_k, int tid) {
    const int lane = tid & 63;
    float gq = __builtin_fabsf(((const GAS float*)g_q)[lane]), gk = __builtin_fabsf(((const GAS float*)g_k)[lane]);
#define MOBA_WMAX(v) do { v = __builtin_fmaxf(v, swz_xor<1>(v)); v = __builtin_fmaxf(v, swz_xor<2>(v)); v = __builtin_fmaxf(v, swz_xor<4>(v)); v = __builtin_fmaxf(v, swz_xor<8>(v)); v = __builtin_fmaxf(v, swz_xor<16>(v)); v = __builtin_fmaxf(v, get_xor32(v, lane < 32)); } while (0)
    MOBA_WMAX(gq); MOBA_WMAX(gk);
#undef MOBA_WMAX
    return 96.f + 2.f * (8.f * gq * gk * LOG2E);
}
__device__ __forceinline__ int moba_ts(int h, int ob, float dnum) {
    const float sl = __builtin_amdgcn_exp2f(-0.5f * (float)(h + 1)) * LOG2E, dskip = dnum / sl;
    const float tf = __builtin_floorf(((float)(256 * ob - 63) - dskip) * (1.f / 64.f)) + 1.f;
    int t0 = (tf > 0.f) ? (int)tf : 0; t0 &= ~1;
#if ATT_PROBE == 7
    t0 = 0;
#endif
    return __builtin_amdgcn_readfirstlane(t0);
}
struct Ring { int sc, sn, sf, sg, vp, vc, vn; };
__device__ __forceinline__ void moba_unit(LAS unsigned char* shm, int b, int h, int ob, const bf16* QKV, const float* KMEAN, bf16* MIXED, float dnum, int tid_in, Ring& rg, bool pre, bool hasn, int nb, int nh, int nob) {
    int tid = tid_in; asm volatile("" : "+v"(tid));
    const int lane = tid & 63, r32 = lane & 31, hi = lane >> 5; const int wid = __builtin_amdgcn_readfirstlane(tid >> 6);
    const unsigned lds0 = (unsigned)(uintptr_t)shm;
    const size_t rowbase = (size_t)b * SEQ; const int q0 = ob * 256;
    int dl_row, dl_chunk; swz_dma_lane(wid, lane, dl_row, dl_chunk); int koff[4]; swz_koff(r32, hi, koff);
    const bf16* ksrc = QKV + (rowbase + dl_row) * QKV_N + 1024 + h * 64 + dl_chunk * 8;
    const bf16* vsrc = QKV + (rowbase + 16 * (wid & 3) + (lane >> 2)) * QKV_N + 2048 + h * 64 + (wid >> 2) * 32 + (lane & 3) * 8;
#if ATT_PROBE == 5
#define MOBA_DMAK(t, slot) do { glds16(ksrc + (size_t)(t) * 64 * QKV_N, ATT_RFL(lds0 + LDS_K + (slot) * KSLOT_B + wid * 1024)); glds16(ksrc + (size_t)(t) * 64 * QKV_N, ATT_RFL(lds0 + LDS_K + (slot) * KSLOT_B + wid * 1024)); } while (0)
#else
#define MOBA_DMAK(t, slot) glds16(ksrc + (size_t)(t) * 64 * QKV_N, ATT_RFL(lds0 + LDS_K + (slot) * KSLOT_B + wid * 1024))
#endif
#define MOBA_DMAV(t, slot) glds16(vsrc + (size_t)(t) * 64 * QKV_N, ATT_RFL(lds0 + LDS_V + (slot) * VSLOT_B + wid * 1024))
    const float sl = __builtin_amdgcn_exp2f(-0.5f * (float)(h + 1)) * LOG2E;
    const int ts = moba_ts(h, ob, dnum);
    int sc, sn, sf, sg, vp, vc, vn;
    if (pre) { sc = rg.sc; sn = rg.sn; sf = rg.sf; sg = rg.sg; vp = rg.vp; vc = rg.vc; vn = rg.vn; }
    else { sc = 0; sn = KSLOT_B; sf = 2 * KSLOT_B; sg = 3 * KSLOT_B; vp = 2 * VSLOT_B; vc = 0; vn = VSLOT_B;
           MOBA_DMAK(ts, 0); MOBA_DMAK(ts + 1, 1); MOBA_DMAV(ts, 0); MOBA_DMAK(ts + 2, 2); }
    const int tsn = hasn ? moba_ts(nh, nob, dnum) : 0;
    const bf16* ksrcn = QKV + ((size_t)nb * SEQ + dl_row) * QKV_N + 1024 + nh * 64 + dl_chunk * 8;
    const bf16* vsrcn = QKV + ((size_t)nb * SEQ + 16 * (wid & 3) + (lane >> 2)) * QKV_N + 2048 + nh * 64 + (wid >> 2) * 32 + (lane & 3) * 8;
#define MOBA_DMAKN(tt, slot) glds16(ksrcn + (size_t)(tt) * 64 * QKV_N, ATT_RFL(lds0 + LDS_K + (slot) * KSLOT_B + wid * 1024))
#define MOBA_DMAVN(tt, slot) glds16(vsrcn + (size_t)(tt) * 64 * QKV_N, ATT_RFL(lds0 + LDS_V + (slot) * VSLOT_B + wid * 1024))
    f32x4 kma[4], kmb[4];
    if (ob > 0) { const float* km = KMEAN + ((size_t)(b * 16 + h) * 16 + (r32 & 15)) * 64 + 8 * hi;
#pragma unroll
        for (int d0 = 0; d0 < 4; ++d0) { kma[d0] = *(const GAS f32x4*)(km + 16 * d0); kmb[d0] = *(const GAS f32x4*)(km + 16 * d0 + 4); } }
    const int qst = (wid < 4) ? (LDS_K + wid * KSLOT_B + 8192) : (LDS_ATT_BYTES + (wid - 4) * 4096);
    bf16x8 qr[4];
    if (pre) { asm volatile("s_waitcnt vmcnt(0)" ::: "memory");
#pragma unroll
        for (int d0 = 0; d0 < 4; ++d0) qr[d0] = *(const LAS bf16x8*)((lds_cptr)shm + qst + koff[d0]); }
    else { const bf16* Qw = QKV + (rowbase + q0 + wid * 32 + r32) * QKV_N + h * 64 + hi * 8;
#pragma unroll
        for (int d0 = 0; d0 < 4; ++d0) qr[d0] = *(const GAS bf16x8*)(Qw + d0 * 16); }
    unsigned selmask = 0u;
#if ATT_PROBE == 8
    for (int rep_ = 0; rep_ < 2; ++rep_)
#endif
    if (ob > 0) {
        f32x16 gt = f32x16{};
#pragma unroll
        for (int d0 = 0; d0 < 4; ++d0) { const f32x4 ka = kma[d0], kb = kmb[d0]; u32x4 wh, wl;
            wh[0] = pk2(ka[0], ka[1]); wh[1] = pk2(ka[2], ka[3]); wh[2] = pk2(kb[0], kb[1]); wh[3] = pk2(kb[2], kb[3]);
            wl[0] = pk2(ka[0] - bf_lo(wh[0]), ka[1] - bf_hi(wh[0])); wl[1] = pk2(ka[2] - bf_lo(wh[1]), ka[3] - bf_hi(wh[1]));
            wl[2] = pk2(kb[0] - bf_lo(wh[2]), kb[1] - bf_hi(wh[2])); wl[3] = pk2(kb[2] - bf_lo(wh[3]), kb[3] - bf_hi(wh[3]));
            gt = __builtin_amdgcn_mfma_f32_32x32x16_bf16(__builtin_bit_cast(bf16x8, wh), qr[d0], gt, 0, 0, 0);
            gt = __builtin_amdgcn_mfma_f32_32x32x16_bf16(__builtin_bit_cast(bf16x8, wl), qr[d0], gt, 0, 0, 0); }
        float G[16];
#pragma unroll
        for (int r = 0; r < 8; ++r) { auto rr = __builtin_amdgcn_permlane32_swap(__float_as_uint(gt[r]), __float_as_uint(gt[r]), false, false);
            G[(r & 3) + 8 * (r >> 2)] = __uint_as_float(rr[0]); G[(r & 3) + 8 * (r >> 2) + 4] = __uint_as_float(rr[1]); }
        float v0 = -INFINITY, v1 = -INFINITY, v2 = -INFINITY; int i0 = -1, i1 = -1, i2 = -1;
#pragma unroll
        for (int n = 0; n < 15; ++n) if (n < ob) { const float g = G[n];
            if (g > v0) { v2 = v1; i2 = i1; v1 = v0; i1 = i0; v0 = g; i0 = n; } else if (g > v1) { v2 = v1; i2 = i1; v1 = g; i1 = n; } else if (g > v2) { v2 = g; i2 = n; } }
        selmask = 0u; if (i0 >= 0) selmask |= 1u << i0; if (i1 >= 0) selmask |= 1u << i1; if (i2 >= 0) selmask |= 1u << i2;
#if ATT_PROBE == 8
        asm volatile("" : "+v"(selmask), "+v"(qr[0]), "+v"(qr[1]), "+v"(qr[2]), "+v"(qr[3]));
#endif
    }
    f32x16 o[2]; o[0] = f32x16{}; o[1] = f32x16{}; float lsum = 0.f;
    const int NT = 4 * ob + 4, qrel = wid * 32 + r32, tq = q0 + qrel;
    const lds_cptr vp0 = (lds_cptr)(shm + LDS_V) + ((lane >> 4) & 1) * 32 + (lane & 3) * 8 + (4 * hi + ((lane & 15) >> 2)) * 64;
    const lds_cptr kp0 = (lds_cptr)(shm + LDS_K) + hi * 1024 + r32 * 16, ks0 = (lds_cptr)(shm + LDS_K);
    f32x16 pA0, pA1, pB0, pB1; bf16x8 kf[8]; s16x4 vlo[8], vhi[8]; u32x4 pw[4];
#define MOBA_BASE(tt) ((((tt) >= NT - 4) || (((selmask >> ((tt) >> 2)) & 1u) != 0u)) ? 0.f : -INFINITY) + sl * (float)(64 * (tt) - tq + 4 * hi)
    { const float b0_ = MOBA_BASE(ts);
#pragma unroll
      for (int r = 0; r < 16; ++r) { pA0[r] = __builtin_fmaf(sl, (float)crow(r, 0), b0_); pA1[r] = pA0[r] + 32.f * sl; } }
    ATT_WAIT_BAR();
#pragma unroll
    for (int d0 = 0; d0 < 4; ++d0) kload2s(kf, ks0 + sc, koff, d0);
#define MOBA_STEP(C0, C1, P0, P1, t, HP, MSK, GK, GV, GL) do { \
        att_pa<4, HP, true, false, MSK>(C0, C1, P0, P1, lsum, kf, kp0 + sc, vlo, vhi, pw, vp0 + vp, qr, (t) - (NT - 4), qrel, hi); \
        int n_ = 0; \
        if (GK) { MOBA_DMAK((t) + 3, sg / KSLOT_B); n_ += 1; } else if (hasn) { MOBA_DMAKN(tsn + ((t) + 3 - NT), sg / KSLOT_B); n_ += 1; } \
        if (GV) { MOBA_DMAV((t) + 1, vn / VSLOT_B); n_ += 1; } else if (hasn) { MOBA_DMAVN(tsn, vn / VSLOT_B); n_ += 1; } \
        { const float bn_ = MOBA_BASE((t) + 1); \
          att_pb<4, HP, true, true, GL, true>(C0, C1, P0, P1, o, kf, vlo, vhi, pw, ks0 + sn, sl, bn_, 32.f * sl, koff); } \
        ATT_WAITN(n_); \
        { const int s_ = sc; sc = sn; sn = sf; sf = sg; sg = s_; const int v_ = vp; vp = vc; vc = vn; vn = v_; } } while (0)
    MOBA_STEP(pA0, pA1, pB0, pB1, ts, false, true, true, true, true);
    int t = ts + 1;
#if ATT_PROBE != 9
    for (; t + 5 < NT; t += 2) { MOBA_STEP(pB0, pB1, pA0, pA1, t, true, false, true, true, true); MOBA_STEP(pA0, pA1, pB0, pB1, t + 1, true, false, true, true, true); }
#endif
    for (; t + 1 < NT; t += 2) { MOBA_STEP(pB0, pB1, pA0, pA1, t, true, true, (t + 3 < NT), true, true); MOBA_STEP(pA0, pA1, pB0, pB1, t + 1, true, true, (t + 4 < NT), true, true); }
    MOBA_STEP(pB0, pB1, pA0, pA1, NT - 1, true, true, false, false, false);
    if (hasn) { const bf16* qn = QKV + ((size_t)nb * SEQ + 256 * nob + wid * 32 + (lane >> 3)) * QKV_N + nh * 64;
#pragma unroll
        for (int j = 0; j < 4; ++j) { const int ch = (lane & 7) ^ (((lane >> 4) & 3) | ((j & 1) << 2)); glds16(qn + (size_t)(8 * j) * QKV_N + ch * 8, ATT_RFL(lds0 + qst + j * 1024)); } }
    att_pa<4, true, false, false, false>(pA0, pA1, pB0, pB1, lsum, kf, kp0 + sc, vlo, vhi, pw, vp0 + vp, qr, -1, qrel, hi);
    att_pb<4, true, false, false, false, true>(pA0, pA1, pB0, pB1, o, kf, vlo, vhi, pw, ks0, 0.f, 0.f, 0.f, koff);
    rg.sc = sc; rg.sn = sn; rg.sf = sf; rg.sg = sg; rg.vp = vp; rg.vc = vc; rg.vn = vn;
#undef MOBA_BASE
#undef MOBA_STEP
#undef MOBA_DMAK
#undef MOBA_DMAV
#undef MOBA_DMAKN
#undef MOBA_DMAVN
    const float ltot = finish_l(lsum);
    store_o(o, ltot, shm, wid, lane, RowLin{MIXED + (rowbase + q0 + wid * 32) * DM + h * 64, (size_t)DM});
    asm volatile("s_waitcnt lgkmcnt(0)\n\ts_barrier" ::: "memory");
}
}

constexpr unsigned PH_ACTIVE = (1u << 0) | (1u << 1) | (1u << 3) | (1u << 5) | (1u << 6) | (1u << 7) | (1u << 9) | (1u << 10) | (1u << 12) | (1u << 14) | (1u << 17) | (1u << 18) | (1u << 20) | (1u << 21) | (1u << 23);
__global__ void __launch_bounds__(NTHR, 2) trunk_fwd(Args args) {
    extern __shared__ __attribute__((aligned(16))) unsigned char lds_raw[];
    Frame F;
    F.lds = (LAS unsigned char*)lds_raw;
    F.tid = threadIdx.x; F.lane = F.tid & 63; F.wave = __builtin_amdgcn_readfirstlane(F.tid >> 6);
    F.G = gridDim.x; { const int bx = blockIdx.x; F.vcu = (F.G % 8 == 0) ? (bx % 8) * (F.G / 8) + bx / 8 : bx; }
    F.ws = args.ws; F.H = args.out;
    gu32* const ctl = (gu32*)(args.ws + WS_CTL);
    volatile LAS unsigned* MISC = (volatile LAS unsigned*)(F.lds + MISC_OFF);
    for (int u = F.tid; u < (LDS_BYTES - LDSCTL_OFF) / 4; u += NTHR) ((LAS unsigned*)(F.lds + LDSCTL_OFF))[u] = 0u;
    __syncthreads();
#if MK_ONE_LAUNCH
    XcdBarrier bar = xcd_barrier_post((unsigned*)ctl + CW_BAR, MISC + 8);
#define GRID_BAR() xcd_barrier(bar)
#else
    (void)MISC; (void)ctl;
#define GRID_BAR() do {} while (0)
#endif
    bool first = true; const int lo = args.ph_lo, hi = args.ph_hi;
#define PHASE_ROOTS \
        { int t_ = threadIdx.x; asm volatile("" : "+v"(t_)); F.tid = t_; F.lane = t_ & 63; F.wave = __builtin_amdgcn_readfirstlane(t_ >> 6); \
          int v_ = F.vcu; asm volatile("" : "+s"(v_)); F.vcu = v_; } \
        const int gw = F.vcu * NWAVES + F.wave, NGW = F.G * NWAVES; \
        typedef const __attribute__((address_space(4))) Args CArgs; CArgs* AP = (CArgs*)__builtin_amdgcn_kernarg_segment_ptr(); asm volatile("" : "+s"(AP)); \
        unsigned char* ws = AP->ws; asm volatile("" : "+s"(ws)); ws = as_global(ws); \
        bf16* const Wb = (bf16*)(ws + WS_W); \
        float* const ROPE = (float*)(ws + WS_ROPE); \
        float* const KMEAN = (float*)(ws + WS_KMEAN); \
        float* const SSA = (float*)(ws + WS_SSA); float* const SSB = (float*)(ws + WS_SSB); \
        float* const SSQ = (float*)(ws + WS_SSQ); float* const SSKV = (float*)(ws + WS_SSKV); \
        bf16* const XNA = (bf16*)(ws + WS_XNA); bf16* const XM1 = (bf16*)(ws + WS_XM1); bf16* const MIXED = (bf16*)(ws + WS_MIXED); \
        bf16* const PB = (bf16*)(ws + WS_PB); bf16* const PP = (bf16*)(ws + WS_PP); \
        bf16* const Z = (bf16*)(ws + WS_Z); bf16* const QA = (bf16*)(ws + WS_QA); bf16* const KVA = (bf16*)(ws + WS_KVA); \
        bf16* const U = (bf16*)(ws + WS_U); bf16* const QKV = (bf16*)(ws + WS_QKV); \
        float* const H = as_global((float*)AP->out); \
        const float* const X = as_global((const float*)AP->in[I_X]);
#if PROBE_MASK
#define PHASE_ENTER(k) if (!first) GRID_BAR(); first = false; for (int rep_ = (((PROBE_MASK >> (k)) & 1u) ? 2 : 1); rep_ > 0; --rep_) { if (rep_ == 1 && ((PROBE_MASK >> (k)) & 1u)) GRID_BAR(); PHASE_ROOTS
#define PHASE_LEAVE }
#else
#define PHASE_ENTER(k) if (!first) GRID_BAR(); first = false; { PHASE_ROOTS
#define PHASE_LEAVE }
#endif
    if (lo <= 0 && 0 < hi) { PHASE_ENTER(0)
        {{
            LAS float* scr = (LAS float*)(F.lds + F.wave * 16384);
            for (int it = gw; it < WITEMS_P0; it += NGW) {
                int r = it;
                WITEMP(I_EWIN, 0, 1024, E_IN, W_INE, RmInE{})
                WITEMP(I_EWUQ, 0, 384, 768, W_UQ, RmUq{})
                WITEMP(I_EWUKV, 0, 256, 1024, W_UKV, RmUkv{})
            }
            { const size_t n16 = (size_t)96 * DM * 2 / 16; GAS u32x4* zp = (GAS u32x4*)(Wb + W_INE + (size_t)416 * DM);
              for (size_t i = (size_t)F.vcu * NTHR + F.tid; i < n16; i += (size_t)F.G * NTHR) zp[i] = (u32x4){0u, 0u, 0u, 0u}; }
            { GAS u32x4* kz = (GAS u32x4*)KMEAN; for (int i = F.vcu * NTHR + F.tid; i < BATCH * 16 * 16 * 64 / 4; i += F.G * NTHR) kz[i] = (u32x4){0u, 0u, 0u, 0u}; }
            { const GAS int* pos = (const GAS int*)AP->in[I_POS];
              for (int i = F.vcu * NTHR + F.tid; i < M * 16; i += F.G * NTHR) { const int m = i >> 4, f = i & 15;
                  const double ang = (double)pos[m] * (INVF10[f >> 2] * INVF4[f & 3]); double rev = ang * 0.15915494309189535; rev -= __builtin_rint(rev);
                  ((GAS f32x2*)ROPE)[i] = (f32x2){__builtin_amdgcn_cosf((float)rev), __builtin_amdgcn_sinf((float)rev)}; } }
            rms_rows_phase(F, X, as_global((const float*)AP->in[I_MIXN]), XNA);
        }}
    PHASE_LEAVE }
    if (lo <= 1 && 1 < hi) { PHASE_ENTER(1)
        {{ run_gemm(F, XNA, DM, Wb + W_INE, E_INP - 256, DM, EpInE{Z, ROPE, as_global((const float*)AP->in[I_ECQN]), as_global((const float*)AP->in[I_ECKVN]), as_global((const float*)AP->in[I_EKNR]),
                                                                     as_global((const float*)AP->in[I_EDQN]), as_global((const float*)AP->in[I_EDKN]), SSQ, SSKV}); }}
    PHASE_LEAVE }
    if (lo <= 3 && 3 < hi) { PHASE_ENTER(3)
        {{ run_gemm(F, Z + ZC_CQ, E_INP, Wb + W_UQ, QA_N, 384, EpUq{QA, ROPE, as_global((const float*)AP->in[I_EQNN]), as_global((const float*)AP->in[I_EQNR]), SSQ});
                  { constexpr int UQ_TILES = (M / 256) * (QA_N / 256);
                    run_gemm(F, XNA, DM, Wb + W_INE + (size_t)(E_INP - 256) * DM, 256, DM, EpInE8{EpInE{Z, ROPE, as_global((const float*)AP->in[I_ECQN]), as_global((const float*)AP->in[I_ECKVN]), as_global((const float*)AP->in[I_EKNR]),
                                                                     as_global((const float*)AP->in[I_EDQN]), as_global((const float*)AP->in[I_EDKN]), SSQ, SSKV}}, (F.G - UQ_TILES % F.G) % F.G); }
                  run_gemm(F, Z + ZC_CKV, E_INP, Wb + W_UKV, KVA_N, 256, EpUkv{KVA, as_global((const float*)AP->in[I_EKNN]), SSKV}); }}
    PHASE_LEAVE }
    if (lo <= 5 && 5 < hi) { PHASE_ENTER(5)
        {{
            bf16* const OB = (bf16*)(ws + WS_OB); float* const LSE = (float*)(ws + WS_LSE);
#if GEMM_PROBE == 7
            for (int su = F.vcu; su < 256; su += F.G) { const int bh = su >> 2, s = su & 3;
                for (int k = 0; k < 4; ++k) { const int qb = (k == 0) ? 15 - s : (k == 1) ? 8 + s : (k == 2) ? 7 - s : s; att::mla_unit(F.lds, bh >> 3, bh & 7, qb, QA, KVA, Z, MIXED, F.tid); } }
#endif
#pragma unroll 1
            for (int s_ = 0; s_ < 2; ++s_) {
                if ((s_ ^ (F.vcu & 1)) == 0) {
                    for (int su = F.vcu; su < 256; su += F.G) { const int bh = su >> 2, s = su & 3;
                        for (int k = 0; k < 4; ++k) { const int qb = (k == 0) ? 15 - s : (k == 1) ? 8 + s : (k == 2) ? 7 - s : s; att::mla_unit(F.lds, bh >> 3, bh & 7, qb, QA, KVA, Z, MIXED, F.tid); } }
                } else {
#if DIL_STREAM
                    att::dil_stream(F.lds, 0, F.vcu, F.G, Z, OB, LSE, MIXED, F.tid);
#else
                    for (int br = 0; br < 2; ++br)
                        for (int u = F.vcu; u < 1024; u += F.G) { const int bh = u >> 4, x = u & 15, dil = 1 << (2 * br); att::dil_unit(F.lds, bh >> 3, bh & 7, br, x & (dil - 1), x >> (2 * br), Z, OB, LSE, MIXED, F.tid); }
#endif
                }
                if (s_ == 0) {
                    LAS float* scr = (LAS float*)(F.lds + F.wave * 16384);
                    for (int it = gw; it < WITEMS_TOTAL - WITEMS_P0; it += NGW) {
                        int r = it;
                    WITEM(I_EWOUT, 0, 1024, 1024, W_OUTE)
                    WITEMG(I_OWIN, 0, 1024, 3072, W_INO, RmInO{}, as_global((const float*)AP->in[I_MIXN]) + DM)
                    WITEM(I_OWOUT, 0, 1024, 1024, W_OUTO)
                    WITEMG(I_WFF1, 0, 1024, 4096, W_FF1, RmPlain{}, as_global((const float*)AP->in[I_FFN]))
                    WITEMG(I_WFF1, (size_t)DM * FF, 1024, 4096, W_FF1 + (size_t)FF * DM, RmPlain{}, as_global((const float*)AP->in[I_FFN]) + DM)
                    WITEML(I_WFF2, 0, 4096, 1024, W_FF2, W2P)
                    WITEML(I_WFF2, (size_t)DM * FF, 4096, 1024, W_FF2 + (size_t)DM * W2P, W2P)
                    WITEMG(I_WG, 0, 1024, 1024, W_G, RmPlain{}, as_global((const float*)AP->in[I_PLEN]))
                    WITEMG(I_WG, (size_t)DM * DM, 1024, 1024, W_G + (size_t)DM * DM, RmPlain{}, as_global((const float*)AP->in[I_PLEN]) + DM)
                    WITEM(I_WP, 0, 256, 1024, W_P)
                    WITEM(I_WP, (size_t)PLE * DM, 256, 1024, W_P + (size_t)PLE * DM)
                    }
                    asm volatile("s_waitcnt vmcnt(0) lgkmcnt(0)\n\ts_barrier" ::: "memory");
                } }
        }}
    PHASE_LEAVE }
    if (lo <= 6 && 6 < hi) { PHASE_ENTER(6)
        {{
            bf16* const OB = (bf16*)(ws + WS_OB); float* const LSE = (float*)(ws + WS_LSE);
#if DIL_STREAM
            att::dil_stream(F.lds, 1, F.vcu, F.G, Z, OB, LSE, MIXED, F.tid);
#else
            for (int u = F.vcu; u < 1024; u += F.G) { const int bh = u >> 4, x = u & 15; att::dil_unit(F.lds, bh >> 3, bh & 7, 2, x, 0, Z, OB, LSE, MIXED, F.tid); }
#endif
        }}
    PHASE_LEAVE }
    if (lo <= 7 && 7 < hi) { PHASE_ENTER(7)
        { {
#if GEMM_PROBE == 3
            run_gemm(F, MIXED, DM, Wb + W_OUTE, DM, DM, EpResNormT<true>{X, nullptr, XM1, SSB}); GRID_BAR();
#elif GEMM_PROBE == 4
            run_gemm(F, MIXED, DM, Wb + W_OUTE, DM, DM, EpNull{}); GRID_BAR();
#endif
#pragma unroll 1
            for (int s_ = 0; s_ < 2; ++s_) {
                if ((s_ ^ (F.vcu & 1)) == 0) run_gemm(F, MIXED, DM, Wb + W_OUTE, DM, DM, EpResNormT<true>{X, nullptr, XNA, SSA});
                else pb_phase(F, as_global((const float*)AP->in[I_P]), PB); } }}
    PHASE_LEAVE }
    if (lo <= 9 && 9 < hi) { PHASE_ENTER(9)
        {{
#if GEMM_PROBE == 1
            run_gemm(F, XNA, DM, Wb + W_FF1, FF, DM, EpRelu2N{U, SSA}); GRID_BAR();
#elif GEMM_PROBE == 2
            run_gemm(F, XNA, DM, Wb + W_FF1, FF, DM, EpNull{}); GRID_BAR();
#endif
            const int L = (9 == 9) ? 0 : 1;
#pragma unroll 1
            for (int s_ = 0; s_ < 2; ++s_) {
                if ((s_ ^ (F.vcu & 1)) == 0) run_gemm(F, XNA, DM, Wb + W_FF1 + (size_t)L * FF * DM, FF, DM, EpRelu2N{U, L ? SSB : SSA});
                else run_gemm(F, PB, PLE, Wb + W_P + (size_t)L * DM * PLE, DM, PLE, EpBf16R{PP, DM}); } }}
    PHASE_LEAVE }
    if (lo <= 10 && 10 < hi) { PHASE_ENTER(10)
        {{ run_gemm(F, U, UP, Wb + W_FF2, DM, FF, EpResNormT<false>{nullptr, XNA, XNA, SSB}, 0, W2P); }}
    PHASE_LEAVE }
    if (lo <= 12 && 12 < hi) { PHASE_ENTER(12)
        {{ run_gemm(F, XNA, DM, Wb + W_G, DM, DM, EpPleN{XNA, PP, SSB, XM1, SSA, nullptr}); }}
    PHASE_LEAVE }
    if (lo <= 14 && 14 < hi) { PHASE_ENTER(14)
        {{ run_gemm(F, XM1, DM, Wb + W_INO, QKV_N, DM, EpInO{QKV, as_global((const float*)AP->in[I_OQN]), as_global((const float*)AP->in[I_OKN]), SSA, KMEAN}); }}
    PHASE_LEAVE }
    if (lo <= 17 && 17 < hi) { PHASE_ENTER(17)
        {{
            const float dnum = att::moba_bound(as_global((const float*)AP->in[I_OQN]), as_global((const float*)AP->in[I_OKN]), F.tid);
            att::Ring rg{}; bool pre = false;
            int b, h, ob; bool ok;
#define MOBA_UNIT(k_, b_, h_, ob_, ok_) do { const int su_ = F.vcu + ((k_) >> 3) * F.G; ok_ = su_ < 256; const int i_ = 7 - ((k_) & 7), j_ = su_ & 31, p_ = j_ & 1, jj_ = j_ >> 1; \
                b_ = su_ >> 5; h_ = 2 * i_ + (p_ ^ (i_ & 1)); ob_ = (int)((MOBA_OB[h_] >> (4 * jj_)) & 15ull); } while (0)
            MOBA_UNIT(0, b, h, ob, ok);
            for (int k = 0; ok; ++k) { int nb, nh, nob; bool nok; MOBA_UNIT(k + 1, nb, nh, nob, nok);
                att::moba_unit(F.lds, b, h, ob, QKV, KMEAN, MIXED, dnum, F.tid, rg, pre, nok, nb, nh, nob);
                pre = true; b = nb; h = nh; ob = nob; ok = nok; }
#undef MOBA_UNIT
        }}
    PHASE_LEAVE }
    if (lo <= 18 && 18 < hi) { PHASE_ENTER(18)
        {{
#pragma unroll 1
            for (int s_ = 0; s_ < 2; ++s_) {
                if ((s_ ^ (F.vcu & 1)) == 0) run_gemm(F, MIXED, DM, Wb + W_OUTO, DM, DM, EpResNormT<false>{nullptr, XM1, XNA, SSB});
                else pb_phase(F, as_global((const float*)AP->in[I_P]) + (size_t)M * PLE, PB); } }}
    PHASE_LEAVE }
    if (lo <= 20 && 20 < hi) { PHASE_ENTER(20)
        {{ const int L = (20 == 9) ? 0 : 1;
#pragma unroll 1
            for (int s_ = 0; s_ < 2; ++s_) {
                if ((s_ ^ (F.vcu & 1)) == 0) run_gemm(F, XNA, DM, Wb + W_FF1 + (size_t)L * FF * DM, FF, DM, EpRelu2N{U, L ? SSB : SSA});
                else run_gemm(F, PB, PLE, Wb + W_P + (size_t)L * DM * PLE, DM, PLE, EpBf16R{PP, DM}); } }}
    PHASE_LEAVE }
    if (lo <= 21 && 21 < hi) { PHASE_ENTER(21)
        {{ run_gemm(F, U, UP, Wb + W_FF2 + (size_t)DM * W2P, DM, FF, EpResNormT<false>{nullptr, XNA, XNA, SSA}, 0, W2P); }}
    PHASE_LEAVE }
    if (lo <= 23 && 23 < hi) { PHASE_ENTER(23)
        {{ run_gemm(F, XNA, DM, Wb + W_G + (size_t)DM * DM, DM, DM, EpPleN{XNA, PP, SSA, nullptr, nullptr, H}); }}
    PHASE_LEAVE }
}

extern "C" void kernel_launch(void* const* d_in, const int* in_sizes, int n_in, void* d_out, int out_size, void* d_ws, size_t ws_size, hipStream_t stream) {
    static int grid = 0;
    if (grid == 0) {
        if (n_in != 26 || out_size != M * DM || ws_size < WS_END) { fprintf(stderr, "kernel_launch: unexpected shapes (n_in %d, out %d, ws %zu); nothing launched\n", n_in, out_size, ws_size); grid = -1; return; }
        int dev = 0, cus = 0;
        if (hipGetDevice(&dev) != hipSuccess || hipDeviceGetAttribute(&cus, hipDeviceAttributeMultiprocessorCount, dev) != hipSuccess) { grid = -1; return; }
        if (hipFuncSetAttribute((const void*)trunk_fwd, hipFuncAttributeMaxDynamicSharedMemorySize, LDS_BYTES) != hipSuccess) { fprintf(stderr, "kernel_launch: hipFuncSetAttribute failed\n"); grid = -1; return; }
        (void)hipGetLastError();
        grid = cus;
    }
    if (grid < 0) return;
    Args a{};
    for (int i = 0; i < 26; ++i) a.in[i] = d_in[i];
    a.out = (float*)d_out; a.ws = (unsigned char*)d_ws;
#if MK_ONE_LAUNCH
    (void)hipMemsetAsync((char*)d_ws + WS_CTL, 0, CTL_ZERO_BYTES, stream);
    a.ph_lo = 0; a.ph_hi = NPH;
    hipLaunchKernelGGL(trunk_fwd, dim3(grid), dim3(NTHR), LDS_BYTES, stream, a);
#else
    for (int ph = 0; ph < NPH; ++ph) { if (!((PH_ACTIVE >> ph) & 1u)) continue; a.ph_lo = ph; a.ph_hi = ph + 1; hipLaunchKernelGGL(trunk_fwd, dim3(grid), dim3(NTHR), LDS_BYTES, stream, a); }
#endif
}
```
